# Optimizing an MI355X kernel written in HIP

```python
import math
import jax, jax.numpy as jnp
from jax import lax
import numpy as np

D_MODEL = 2048
BATCH = 1
SEQ = 8192
DEPTH = 4

N_MIXERS = 2
GRID_W = 64
HEAD_DIM = 128
N_HEADS = D_MODEL // HEAD_DIM
N_KV_HEADS = 4
GROUP = N_HEADS // N_KV_HEADS
Q_DIM = N_HEADS * HEAD_DIM
KV_DIM = N_KV_HEADS * HEAD_DIM
QKV_DIM = Q_DIM + 2 * KV_DIM
Q_BLOCK = 128
ROPE_THETA = 10000.0
ROPE_FREQS = HEAD_DIM // 4
D_RNN = D_MODEL
RNN_BLOCK = 128
N_RNN_BLOCKS = D_RNN // RNN_BLOCK
CONV_W = 4
CONV_PAD_L = 2
C_DECAY = 8.0
D_FF = 5632
NORM_EPS = 1e-6

kernel_name = "hybrid_gqa2drope_bidir_rglru_macaron"


def rms_norm(x, g):
    xf = x.astype(jnp.float32)
    y = xf * lax.rsqrt(jnp.mean(xf * xf, axis=-1, keepdims=True) + NORM_EPS)
    return (y * g.astype(jnp.float32)).astype(x.dtype)


def swiglu(xn, w_gu, w_down):
    gu = xn @ w_gu
    g, u = jnp.split(gu, 2, axis=-1)
    return (jax.nn.silu(g) * u) @ w_down


def axial_angles(S):
    rows_n = S // GRID_W
    rows = jnp.repeat(jnp.arange(rows_n, dtype=jnp.float32), GRID_W)
    cols = jnp.tile(jnp.arange(GRID_W, dtype=jnp.float32), rows_n)
    inv_freq = ROPE_THETA ** (-jnp.arange(ROPE_FREQS, dtype=jnp.float32) / ROPE_FREQS)
    return rows[:, None] * inv_freq[None, :], cols[:, None] * inv_freq[None, :]


def rope_half(xh, ang):
    x1, x2 = jnp.split(xh, 2, axis=-1)
    c, s = jnp.cos(ang), jnp.sin(ang)
    return jnp.concatenate([x1 * c - x2 * s, x2 * c + x1 * s], axis=-1)


def axial_rope(x, ang_row, ang_col):
    xf = x.astype(jnp.float32)
    xr, xc = jnp.split(xf, 2, axis=-1)
    out = jnp.concatenate([rope_half(xr, ang_row), rope_half(xc, ang_col)], axis=-1)
    return out.astype(x.dtype)


def attention_mixer(xn, w_qkv, q_gain, k_gain, w_o):
    B, S, _ = xn.shape
    qkv = xn @ w_qkv
    q = qkv[..., :Q_DIM].reshape(B, S, N_KV_HEADS, GROUP, HEAD_DIM)
    k = qkv[..., Q_DIM:Q_DIM + KV_DIM].reshape(B, S, N_KV_HEADS, HEAD_DIM)
    v = qkv[..., Q_DIM + KV_DIM:].reshape(B, S, N_KV_HEADS, HEAD_DIM)
    q = rms_norm(q, q_gain)
    k = rms_norm(k, k_gain)
    ang_row, ang_col = axial_angles(S)
    q = axial_rope(q, ang_row[None, :, None, None, :], ang_col[None, :, None, None, :])
    k = axial_rope(k, ang_row[None, :, None, :], ang_col[None, :, None, :])
    scale = HEAD_DIM ** -0.5
    n_qb = S // Q_BLOCK
    qb = q.reshape(B, n_qb, Q_BLOCK, N_KV_HEADS, GROUP, HEAD_DIM).swapaxes(0, 1)

    def one_block(q_blk):
        s = jnp.einsum('bqkgd,bskd->bkgqs', q_blk, k).astype(jnp.float32) * scale
        p = jax.nn.softmax(s, axis=-1).astype(v.dtype)
        return jnp.einsum('bkgqs,bskd->bqkgd', p, v)

    o = lax.map(one_block, qb)
    o = o.swapaxes(0, 1).reshape(B, S, Q_DIM)
    return o @ w_o


def centred_depthwise_conv(x, w, b):
    S = x.shape[1]
    xp = jnp.pad(x, ((0, 0), (CONV_PAD_L, CONV_W - 1 - CONV_PAD_L), (0, 0)))
    y = b
    for tap in range(CONV_W):
        y = y + xp[:, tap:tap + S, :] * w[tap]
    return y


def _lin_combine(e1, e2):
    a1, b1 = e1
    a2, b2 = e2
    return a1 * a2, a2 * b1 + b2


def rg_lru(xc, gate_w, gate_b, lam, reverse):
    B, S, _ = xc.shape
    xf = xc.astype(jnp.float32)
    xb = xf.reshape(B, S, N_RNN_BLOCKS, RNN_BLOCK)
    g = jnp.einsum('bsnc,zncd->zbsnd', xb, gate_w.astype(jnp.float32)).reshape(2, B, S, D_RNN)
    g = g + gate_b.astype(jnp.float32)[:, None, None, :]
    r_gate = jax.nn.sigmoid(g[0])
    i_gate = jax.nn.sigmoid(g[1])
    log_a = -C_DECAY * r_gate * jax.nn.softplus(-lam.astype(jnp.float32))
    a = jnp.exp(log_a)
    b = jnp.sqrt(-jnp.expm1(2.0 * log_a)) * (i_gate * xf)
    _, h = lax.associative_scan(_lin_combine, (a, b), axis=1, reverse=reverse)
    return h


def recurrent_mixer(xn, w_in, conv_w, conv_b, gate_w, gate_b, lam, w_out):
    u = xn @ w_in
    gate_branch, rec_branch = jnp.split(u, 2, axis=-1)
    xc = centred_depthwise_conv(rec_branch, conv_w, conv_b)
    h = (rg_lru(xc, gate_w[0], gate_b[0], lam[0], reverse=False)
         + rg_lru(xc, gate_w[1], gate_b[1], lam[1], reverse=True))
    y = jax.nn.gelu(gate_branch) * h.astype(xn.dtype)
    return y @ w_out


def setup_inputs(seed: int = 0) -> dict:
    key = jax.random.key(seed)
    ks = jax.random.split(key, 20)
    n_attn = len(range(0, DEPTH, N_MIXERS))
    n_rec = DEPTH - n_attn
    f32 = jnp.float32

    def nrm(k, shape, fan_in):
        return jax.random.normal(k, shape, f32) * (fan_in ** -0.5)

    def gain(k, shape):
        return 1.0 + 0.02 * jax.random.normal(k, shape, f32)

    x = jax.random.normal(ks[0], (BATCH, SEQ, D_MODEL), f32)
    ffn_norm = gain(ks[1], (DEPTH, 2, D_MODEL))
    ffn_w_gu = nrm(ks[2], (DEPTH, 2, D_MODEL, 2 * D_FF), D_MODEL)
    ffn_w_down = nrm(ks[3], (DEPTH, 2, D_FF, D_MODEL), D_FF)
    attn_norm = gain(ks[4], (n_attn, D_MODEL))
    attn_w_qkv = nrm(ks[5], (n_attn, D_MODEL, QKV_DIM), D_MODEL)
    attn_q_norm = gain(ks[6], (n_attn, HEAD_DIM))
    attn_k_norm = gain(ks[7], (n_attn, HEAD_DIM))
    attn_w_o = nrm(ks[8], (n_attn, Q_DIM, D_MODEL), Q_DIM)
    rec_norm = gain(ks[9], (n_rec, D_MODEL))
    rec_w_in = nrm(ks[10], (n_rec, D_MODEL, 2 * D_RNN), D_MODEL)
    rec_conv_w = nrm(ks[11], (n_rec, CONV_W, D_RNN), CONV_W)
    rec_conv_b = 0.01 * jax.random.normal(ks[12], (n_rec, D_RNN), f32)
    rec_gate_w = nrm(ks[13], (n_rec, 2, 2, N_RNN_BLOCKS, RNN_BLOCK, RNN_BLOCK), RNN_BLOCK)
    rec_gate_b = 0.01 * jax.random.normal(ks[14], (n_rec, 2, 2, D_RNN), f32)
    a8 = jax.random.uniform(ks[15], (n_rec, 2, D_RNN), f32, minval=0.9, maxval=0.999)
    s = a8 ** (1.0 / C_DECAY)
    rec_lambda = jnp.log(s) - jnp.log1p(-s)
    rec_w_out = nrm(ks[16], (n_rec, D_RNN, D_MODEL), D_RNN)
    final_norm = gain(ks[17], (D_MODEL,))
    return {
        "x": x,
        "ffn_norm": ffn_norm, "ffn_w_gu": ffn_w_gu, "ffn_w_down": ffn_w_down,
        "attn_norm": attn_norm, "attn_w_qkv": attn_w_qkv,
        "attn_q_norm": attn_q_norm, "attn_k_norm": attn_k_norm, "attn_w_o": attn_w_o,
        "rec_norm": rec_norm, "rec_w_in": rec_w_in, "rec_conv_w": rec_conv_w,
        "rec_conv_b": rec_conv_b, "rec_gate_w": rec_gate_w, "rec_gate_b": rec_gate_b,
        "rec_lambda": rec_lambda, "rec_w_out": rec_w_out,
        "final_norm": final_norm,
    }


def reference(x, ffn_norm, ffn_w_gu, ffn_w_down, attn_norm, attn_w_qkv, attn_q_norm,
              attn_k_norm, attn_w_o, rec_norm, rec_w_in, rec_conv_w, rec_conv_b,
              rec_gate_w, rec_gate_b, rec_lambda, rec_w_out, final_norm):
    for i in range(DEPTH):
        x = x + 0.5 * swiglu(rms_norm(x, ffn_norm[i, 0]), ffn_w_gu[i, 0], ffn_w_down[i, 0])
        j = i // N_MIXERS
        if i % N_MIXERS == 0:
            x = x + attention_mixer(rms_norm(x, attn_norm[j]), attn_w_qkv[j],
                                    attn_q_norm[j], attn_k_norm[j], attn_w_o[j])
        else:
            x = x + recurrent_mixer(rms_norm(x, rec_norm[j]), rec_w_in[j], rec_conv_w[j],
                                    rec_conv_b[j], rec_gate_w[j], rec_gate_b[j],
                                    rec_lambda[j], rec_w_out[j])
        x = x + 0.5 * swiglu(rms_norm(x, ffn_norm[i, 1]), ffn_w_gu[i, 1], ffn_w_down[i, 1])
    return rms_norm(x, final_norm)
```

```cpp
#include <hip/hip_runtime.h>
#include <hip/hip_bf16.h>
#include <cstdio>
#include <cstdint>
#define MK_MULTI 1
namespace pg8 {
#define PG8_LAS __attribute__((address_space(3)))
typedef unsigned short bf16_t;
typedef short bf16x8 __attribute__((ext_vector_type(8)));
typedef float f32x4 __attribute__((ext_vector_type(4)));
typedef unsigned u32x4 __attribute__((ext_vector_type(4)));
constexpr int BM = 256, BK = 64, HALF = 128, HTB = HALF * BK * 2  , STAGE_BYTES = 8 * HTB, NXCD = 8, WGM = 8;

__host__ __device__ __forceinline__ int lds_byte(int r, int c) { const int st = (r >> 4) * 2 + (c >> 5), rr = r & 15, cc = c & 31, ob = rr * 64 + cc * 2; return st * 1024 + (ob ^ (((ob >> 9) & 1) << 5)); }
__host__ __device__ __forceinline__ void stage_rc(int b, int& R, int& C) { const int st = b / 1024, sb = b % 1024, swz = sb ^ (((sb >> 9) & 1) << 5); R = (st >> 1) * 16 + swz / 64; C = (st & 1) * 32 + (swz % 64) / 2; }
__host__ __device__ __forceinline__ int perm32(int rho) { const int n = rho >> 4, i = rho & 15; return 8 * (i >> 2) + 4 * n + (i & 3); }

struct Unit { int pm, pn; };
struct Gemm { const bf16_t* A; const bf16_t* Bt; int M, N, K; };

struct StaticOrder {
    int nM, nN, nwg, G, c;
    __host__ __device__ void init(int M, int N, int G_, int c_) { nM = M / BM; nN = N / BM; nwg = nM * nN; G = G_; c = c_; }
    __host__ __device__ bool next(int i, Unit& u) const {
        const long L = (long)i * G + c; if (L >= nwg) return false;
        int wgid = (int)L; { const int q = nwg / NXCD, r = nwg % NXCD, xcd = wgid % NXCD, off = wgid / NXCD; wgid = (xcd < r ? xcd * (q + 1) : r * (q + 1) + (xcd - r) * q) + off; }
        const int nig = WGM * nN, gid = wgid / nig, fm = gid * WGM, gsz = (nM - fm) < WGM ? (nM - fm) : WGM;
        u.pm = fm + ((wgid % nig) % gsz); u.pn = (wgid % nig) / gsz; return true;
    }
    __device__ __forceinline__ void a_ready(const Unit&) const {}
    __device__ __forceinline__ void done(const Unit&) const {}
};
__device__ __forceinline__ unsigned cvt_pk_bf16(float lo, float hi) { unsigned r; asm volatile("v_cvt_pk_bf16_f32 %0, %1, %2" : "=v"(r) : "v"(lo), "v"(hi)); return r; }
constexpr int DM = 2048, DFF = 5632;
constexpr float RMS_EPS = 1e-6f;
typedef unsigned long long ss_t;
constexpr float SS_SCALE = 16777216.0f;
__device__ __forceinline__ float rs_from_ss(ss_t ss) { return __builtin_amdgcn_rsqf((float)ss * (1.0f / ((float)DM * SS_SCALE)) + RMS_EPS); }
__device__ __forceinline__ float silu_f(float x) { return x * __builtin_amdgcn_rcpf(1.0f + __builtin_amdgcn_exp2f(x * -1.4426950408889634f)); }
__device__ __forceinline__ u32x4 pack8(const f32x4 a, const f32x4 b) { u32x4 w; w.x = cvt_pk_bf16(a[0], a[1]); w.y = cvt_pk_bf16(a[2], a[3]); w.z = cvt_pk_bf16(b[0], b[1]); w.w = cvt_pk_bf16(b[2], b[3]); return w; }

struct EpiSwiglu {
    static constexpr bool PERM = true, AFTER_DRAIN = false;
    bf16_t* H; const ss_t* ss;
    __device__ __forceinline__ void operator()(const f32x4 (&acc)[2][2][4][2], const Unit& u, int wr, int wc, int fr, int fq) const {
        const int row0 = u.pm * BM + wr * 64 + fr, col0 = u.pn * HALF + wc * 32 + 8 * fq;
#pragma unroll
        for (int ai = 0; ai < 2; ++ai)
#pragma unroll
            for (int m = 0; m < 4; ++m) { const int r = row0 + ai * HALF + m * 16; const float rs = rs_from_ss(ss[r]);
                f32x4 h[2];
#pragma unroll
                for (int n = 0; n < 2; ++n) { const f32x4 g = acc[ai][0][m][n] * rs, v = acc[ai][1][m][n] * rs;
                    h[n] = (f32x4){silu_f(g[0]) * v[0], silu_f(g[1]) * v[1], silu_f(g[2]) * v[2], silu_f(g[3]) * v[3]}; }
                *(u32x4*)(H + (size_t)r * DFF + col0) = pack8(h[0], h[1]); }
    }
};
struct EpiPlain {
    static constexpr bool PERM = true, AFTER_DRAIN = false;
    bf16_t* O; int ldc; const ss_t* ss;
    __device__ __forceinline__ void operator()(const f32x4 (&acc)[2][2][4][2], const Unit& u, int wr, int wc, int fr, int fq) const {
        const int row0 = u.pm * BM + wr * 64 + fr, col0 = u.pn * BM + wc * 32 + 8 * fq;
#pragma unroll
        for (int ai = 0; ai < 2; ++ai)
#pragma unroll
            for (int m = 0; m < 4; ++m) { const int r = row0 + ai * HALF + m * 16; const float rs = rs_from_ss(ss[r]); bf16_t* rowp = O + (size_t)r * ldc + col0;
#pragma unroll
                for (int bj = 0; bj < 2; ++bj) *(u32x4*)(rowp + bj * HALF) = pack8(acc[ai][bj][m][0] * rs, acc[ai][bj][m][1] * rs); }
    }
};
struct EpiResid {
    static constexpr bool PERM = true, AFTER_DRAIN = false;
    const float* base; float* out; bf16_t* xb; ss_t* ssn; float alpha;
    __device__ __forceinline__ void operator()(const f32x4 (&acc)[2][2][4][2], const Unit& u, int wr, int wc, int fr, int fq) const {
        const int row0 = u.pm * BM + wr * 64 + fr, col0 = u.pn * BM + wc * 32 + 8 * fq;
#pragma unroll
        for (int ai = 0; ai < 2; ++ai)
#pragma unroll
            for (int m = 0; m < 4; ++m) { const int r = row0 + ai * HALF + m * 16; const size_t off = (size_t)r * DM + col0; float q = 0.f;
#pragma unroll
                for (int bj = 0; bj < 2; ++bj) { const f32x4 b0 = *(const f32x4*)(base + off + bj * HALF), b1 = *(const f32x4*)(base + off + bj * HALF + 4);
                    const f32x4 x0 = b0 + acc[ai][bj][m][0] * alpha, x1 = b1 + acc[ai][bj][m][1] * alpha;
                    *(f32x4*)(out + off + bj * HALF) = x0; *(f32x4*)(out + off + bj * HALF + 4) = x1;
                    *(u32x4*)(xb + off + bj * HALF) = pack8(x0, x1);
                    q += (x0[0] * x0[0] + x0[1] * x0[1]) + (x0[2] * x0[2] + x0[3] * x0[3]) + (x1[0] * x1[0] + x1[1] * x1[1]) + (x1[2] * x1[2] + x1[3] * x1[3]); }
                q += __shfl_xor(q, 16); q += __shfl_xor(q, 32);
                if (fq == 0) __hip_atomic_fetch_add(ssn + r, (ss_t)(q * SS_SCALE), __ATOMIC_RELAXED, __HIP_MEMORY_SCOPE_AGENT);
                if (m & 1) asm volatile("" ::: "memory"); }
    }
};

template <class Epi, class Sched, bool ALIGN_EPI = false, bool SP2 = false>
__device__ __forceinline__ void gemm_phase(PG8_LAS unsigned char* lds, const Gemm g, const Sched& S, const Epi& E) {
    int tid_ = threadIdx.x; asm volatile("" : "+v"(tid_));
    const int tid = tid_, wid = __builtin_amdgcn_readfirstlane(tid >> 6), lane = tid & 63, wr = wid >> 2, wc = wid & 3, fr = lane & 15, fq = lane >> 4;
    const int K = g.K, nt = K / BK;
    unsigned voffA[2], voffB[2];
#pragma unroll
    for (int i = 0; i < 2; ++i) { int R, C; stage_rc(tid * 16 + i * 8192, R, C); const int Rb = Epi::PERM ? ((R & ~31) + perm32(R & 31)) : R;
        voffA[i] = (unsigned)(R * K + C) * 2u; voffB[i] = (unsigned)(Rb * K + C) * 2u; }
    const size_t kstep = (size_t)(BK * 2);
    const size_t hstep = (size_t)HALF * K * 2;
    const size_t tstep = 2 * hstep;
    const unsigned ldsw = (unsigned)wid * 1024u;
    const int aoff = lds_byte(wr * 64 + fr, fq * 8), boff = lds_byte(wc * 32 + fr, fq * 8);
#define PG8_SA(b, h) (((b) * 2 + (h)) * HTB)
#define PG8_SB(b, h) ((4 + (b) * 2 + (h)) * HTB)
#define PG8_STAGE(bufoff, gbase, voff) do { _Pragma("unroll") for (int _i = 0; _i < 2; ++_i) \
        __builtin_amdgcn_global_load_lds((const unsigned*)((const char*)(gbase) + (voff)[_i]), (PG8_LAS unsigned*)(lds + (bufoff) + ldsw + _i * 8192), 16, 0, 0); } while (0)
#define PG8_LDA(dst, b, h) do { _Pragma("unroll") for (int m = 0; m < 4; ++m) _Pragma("unroll") for (int k = 0; k < 2; ++k) dst[m][k] = *(const PG8_LAS bf16x8*)(lds + PG8_SA(b, h) + aoff + m * 2048 + k * 1024); } while (0)
#define PG8_LDB(dst, b, h) do { _Pragma("unroll") for (int n = 0; n < 2; ++n) _Pragma("unroll") for (int k = 0; k < 2; ++k) dst[n][k] = *(const PG8_LAS bf16x8*)(lds + PG8_SB(b, h) + boff + n * 2048 + k * 1024); } while (0)
#define PG8_MMA(ai, bj, At, Bt) do { __builtin_amdgcn_s_setprio(1); _Pragma("unroll") for (int m = 0; m < 4; ++m) _Pragma("unroll") for (int n = 0; n < 2; ++n) _Pragma("unroll") for (int k = 0; k < 2; ++k) \
        acc[ai][bj][m][n] = __builtin_amdgcn_mfma_f32_16x16x32_bf16(Bt[n][k], At[m][k], acc[ai][bj][m][n], 0, 0, 0); __builtin_amdgcn_s_setprio(0); } while (0)
#define PG8_WAIT_V(n) asm volatile("s_waitcnt vmcnt(" #n ")" ::: "memory")
#define PG8_WAIT_L(n) asm volatile("s_waitcnt lgkmcnt(" #n ")" ::: "memory")
#define PG8_BAR __builtin_amdgcn_s_barrier()
#define PG8_SCHED __builtin_amdgcn_sched_barrier(0)
    Unit cur, nxt; int ui = 0;
    if (!S.next(0, cur)) return;
    f32x4 acc[2][2][4][2];
#pragma unroll
    for (int a = 0; a < 2; ++a)
#pragma unroll
        for (int b = 0; b < 2; ++b)
#pragma unroll
            for (int m = 0; m < 4; ++m)
#pragma unroll
                for (int n = 0; n < 2; ++n) acc[a][b][m][n] = (f32x4){0.f, 0.f, 0.f, 0.f};
    bf16x8 At[4][2], B0[2][2], B1[2][2];
    const char* cA = (const char*)g.A + (size_t)cur.pm * tstep; const char* cB = (const char*)g.Bt + (size_t)cur.pn * tstep;
    S.a_ready(cur);
    if constexpr (SP2) {
        PG8_STAGE(PG8_SB(0, 0), cB, voffB); PG8_STAGE(PG8_SB(0, 1), cB + hstep, voffB); PG8_STAGE(PG8_SA(0, 0), cA, voffA); PG8_STAGE(PG8_SA(0, 1), cA + hstep, voffA);
        if (wr == 1) PG8_BAR;
        PG8_WAIT_V(2); PG8_BAR;
        PG8_STAGE(PG8_SB(1, 0), cB + kstep, voffB); PG8_STAGE(PG8_SA(1, 0), cA + kstep, voffA); PG8_STAGE(PG8_SB(1, 1), cB + hstep + kstep, voffB);
        PG8_WAIT_V(6); PG8_BAR;
    } else {
        PG8_STAGE(PG8_SB(0, 0), cB, voffB); PG8_STAGE(PG8_SA(0, 0), cA, voffA); PG8_STAGE(PG8_SB(0, 1), cB + hstep, voffB); PG8_STAGE(PG8_SA(0, 1), cA + hstep, voffA);
        if (wr == 1) PG8_BAR;
        PG8_WAIT_V(4); PG8_BAR;
        PG8_STAGE(PG8_SB(1, 0), cB + kstep, voffB); PG8_STAGE(PG8_SA(1, 0), cA + kstep, voffA); PG8_STAGE(PG8_SB(1, 1), cB + hstep + kstep, voffB);
        PG8_WAIT_V(6); PG8_BAR;
    }
    for (;;) {
        const bool has_next = S.next(ui + 1, nxt);
        const char* nA = has_next ? (const char*)g.A + (size_t)nxt.pm * tstep : cA; const char* nB = has_next ? (const char*)g.Bt + (size_t)nxt.pn * tstep : cB;
        for (int t = 0; t < nt; t += 2) {
            const bool last = (t == nt - 2);
            const char* a1 = cA + (size_t)(t + 1) * kstep;
            const char* a2 = last ? nA : cA + (size_t)(t + 2) * kstep; const char* b2 = last ? nB : cB + (size_t)(t + 2) * kstep;
            const char* a3 = a2 + kstep; const char* b3 = b2 + kstep;
            if (last && has_next) S.a_ready(nxt);
            if constexpr (SP2) {
            PG8_LDB(B0, 0, 0); PG8_LDB(B1, 0, 1); PG8_SCHED; PG8_LDA(At, 0, 0); PG8_STAGE(PG8_SA(1, 1), a1 + hstep, voffA);
            PG8_WAIT_V(8); PG8_WAIT_L(0); PG8_BAR; PG8_MMA(0, 0, At, B0); PG8_MMA(0, 1, At, B1); PG8_BAR; PG8_SCHED;
            PG8_LDA(At, 0, 1); PG8_STAGE(PG8_SB(0, 0), b2, voffB); PG8_STAGE(PG8_SB(0, 1), b2 + hstep, voffB); PG8_STAGE(PG8_SA(0, 0), a2, voffA);
            PG8_WAIT_V(8); PG8_WAIT_L(0); PG8_BAR; PG8_MMA(1, 0, At, B0); PG8_MMA(1, 1, At, B1); PG8_BAR; PG8_SCHED;
            PG8_LDB(B0, 1, 0); PG8_LDB(B1, 1, 1); PG8_SCHED; PG8_LDA(At, 1, 0); PG8_STAGE(PG8_SA(0, 1), a2 + hstep, voffA);
            PG8_WAIT_V(8); PG8_WAIT_L(0); PG8_BAR; PG8_MMA(0, 0, At, B0); PG8_MMA(0, 1, At, B1); PG8_BAR; PG8_SCHED;
            PG8_LDA(At, 1, 1); PG8_STAGE(PG8_SB(1, 0), b3, voffB); PG8_STAGE(PG8_SB(1, 1), b3 + hstep, voffB); PG8_STAGE(PG8_SA(1, 0), a3, voffA);
            PG8_WAIT_V(8); PG8_WAIT_L(0); PG8_BAR; PG8_MMA(1, 0, At, B0); PG8_MMA(1, 1, At, B1); PG8_BAR; PG8_SCHED;
            } else {
            PG8_LDB(B0, 0, 0); PG8_SCHED; PG8_LDA(At, 0, 0); PG8_STAGE(PG8_SA(1, 1), a1 + hstep, voffA);
            PG8_WAIT_L(8); PG8_BAR; PG8_WAIT_L(0); PG8_MMA(0, 0, At, B0); PG8_BAR; PG8_SCHED;
            PG8_LDB(B1, 0, 1); PG8_STAGE(PG8_SB(0, 0), b2, voffB);
            PG8_BAR; PG8_WAIT_L(0); PG8_MMA(0, 1, At, B1); PG8_BAR;
            PG8_LDA(At, 0, 1); PG8_STAGE(PG8_SA(0, 0), a2, voffA);
            PG8_BAR; PG8_WAIT_L(0); PG8_MMA(1, 0, At, B0); PG8_BAR; PG8_SCHED;
            PG8_STAGE(PG8_SB(0, 1), b2 + hstep, voffB);
            PG8_WAIT_V(6); PG8_BAR; PG8_MMA(1, 1, At, B1); PG8_BAR;
            PG8_LDB(B0, 1, 0); PG8_SCHED; PG8_LDA(At, 1, 0); PG8_STAGE(PG8_SA(0, 1), a2 + hstep, voffA);
            PG8_WAIT_L(8); PG8_BAR; PG8_WAIT_L(0); PG8_MMA(0, 0, At, B0); PG8_BAR; PG8_SCHED;
            PG8_LDB(B1, 1, 1); PG8_STAGE(PG8_SB(1, 0), b3, voffB);
            PG8_BAR; PG8_WAIT_L(0); PG8_MMA(0, 1, At, B1); PG8_BAR;
            PG8_LDA(At, 1, 1); PG8_STAGE(PG8_SA(1, 0), a3, voffA);
            PG8_BAR; PG8_WAIT_L(0); PG8_MMA(1, 0, At, B0); PG8_BAR; PG8_SCHED;
            PG8_STAGE(PG8_SB(1, 1), b3 + hstep, voffB);
            PG8_WAIT_V(6); PG8_BAR; PG8_MMA(1, 1, At, B1); PG8_BAR;
            }
        }
        if constexpr (ALIGN_EPI) { if (wr == 0) PG8_BAR; }
        if constexpr (!Epi::AFTER_DRAIN) { E(acc, cur, wr, wc, fr, fq); S.done(cur); }
        if (!has_next) break;
#pragma unroll
        for (int a = 0; a < 2; ++a)
#pragma unroll
            for (int b = 0; b < 2; ++b)
#pragma unroll
                for (int m = 0; m < 4; ++m)
#pragma unroll
                    for (int n = 0; n < 2; ++n) acc[a][b][m][n] = (f32x4){0.f, 0.f, 0.f, 0.f};
        cur = nxt; cA = nA; cB = nB; ++ui;
        if constexpr (ALIGN_EPI) { if (wr == 1) PG8_BAR; }
    }
    PG8_WAIT_V(0);
    if constexpr (!ALIGN_EPI) { if (wr == 0) PG8_BAR; }
    PG8_BAR;
    if constexpr (Epi::AFTER_DRAIN) { E.fused(acc, cur, wr, wc, fr, fq, lds, wid, lane); S.done(cur); }
#undef PG8_SA
#undef PG8_SB
#undef PG8_STAGE
#undef PG8_LDA
#undef PG8_LDB
#undef PG8_MMA
#undef PG8_WAIT_V
#undef PG8_WAIT_L
#undef PG8_BAR
#undef PG8_SCHED
}
}
namespace att {
using bf16 = __hip_bfloat16;
constexpr int   D = 128, NW = 8, QBLK = 32, KVBLK = 64;
constexpr float SCALE = 0.088388347648318440f;
constexpr float THR = 8.f;
constexpr int   SDEPTH = 2;
constexpr int   LDQ = 3072, LDK = 3072, LDO = 2048;
constexpr size_t SHM_V = KVBLK * D * 2, SHM_K = KVBLK * D * 2, SHM_ATTN = 2 * SHM_V + 2 * SHM_K + NW * 64 * 4;
using bf16x8 = __attribute__((ext_vector_type(8))) short;
using s16x4  = __attribute__((ext_vector_type(4))) short;
using f32x16 = __attribute__((ext_vector_type(16))) float;
using u32x4  = __attribute__((ext_vector_type(4))) unsigned;
#define KSWZ(row, colB) ((row) * 256 + ((colB) ^ (((row) & 7) << 4)))
#define SBAR() __builtin_amdgcn_sched_barrier(0)
__device__ __forceinline__ int crow(int r, int hi) { return (r & 3) + 8 * (r >> 2) + 4 * hi; }
__device__ __forceinline__ unsigned cvtpk(float lo, float hi) {
  unsigned r; asm volatile("v_cvt_pk_bf16_f32 %0, %1, %2" : "=v"(r) : "v"(lo), "v"(hi)); return r;
}

__device__ __forceinline__ void partialSM(f32x16& p0, f32x16& p1, float& m_reg, float& mn, float& alpha) {
  constexpr float C = SCALE * 1.4426950408889634f;
  float pmax = p0[0]; for (int r = 1; r < 16; ++r) pmax = fmaxf(pmax, p0[r]); for (int r = 0; r < 16; ++r) pmax = fmaxf(pmax, p1[r]);
  { auto rr = __builtin_amdgcn_permlane32_swap(__float_as_uint(pmax), __float_as_uint(pmax), false, false);
    pmax = fmaxf(__uint_as_float(rr[0]), __uint_as_float(rr[1])); }
  if (__builtin_expect(__all(pmax - m_reg <= THR / SCALE), 1)) { mn = m_reg; alpha = 1.f; }
  else { mn = fmaxf(m_reg, pmax); alpha = __builtin_amdgcn_exp2f((m_reg - mn) * C); m_reg = mn; }
  float mnC = -mn * C;
  for (int r = 0; r < 16; ++r) p0[r] = fmaf(p0[r], C, mnC); for (int r = 0; r < 16; ++r) p1[r] = fmaf(p1[r], C, mnC);
  for (int r = 0; r < 16; ++r) p0[r] = __builtin_amdgcn_exp2f(p0[r]);
}
__device__ __forceinline__ void finishSM(f32x16& p0, f32x16& p1, float alpha, float& l_reg, bf16x8& pa0, bf16x8& pa1, bf16x8& pa2, bf16x8& pa3) {
  for (int r = 0; r < 16; ++r) p1[r] = __builtin_amdgcn_exp2f(p1[r]);
  float ps = 0; for (int r = 0; r < 16; ++r) ps += p0[r]; for (int r = 0; r < 16; ++r) ps += p1[r];
  { auto rr = __builtin_amdgcn_permlane32_swap(__float_as_uint(ps), __float_as_uint(ps), false, false);
    ps = __uint_as_float(rr[0]) + __uint_as_float(rr[1]); }
  l_reg = l_reg * alpha + ps;
#define PK4(P, BASE, OUT) do { unsigned a0 = cvtpk(P[BASE + 0], P[BASE + 1]), a1 = cvtpk(P[BASE + 2], P[BASE + 3]);   \
    unsigned b0 = cvtpk(P[BASE + 4], P[BASE + 5]), b1 = cvtpk(P[BASE + 6], P[BASE + 7]);                              \
    auto r0 = __builtin_amdgcn_permlane32_swap(a0, b0, false, false); auto r1 = __builtin_amdgcn_permlane32_swap(a1, b1, false, false); \
    u32x4 w = {r0[0], r1[0], r0[1], r1[1]}; OUT = *reinterpret_cast<bf16x8*>(&w); } while (0)
  PK4(p0, 0, pa0); PK4(p0, 8, pa1); PK4(p1, 0, pa2); PK4(p1, 8, pa3);
#undef PK4
}
__device__ __forceinline__ void qkt(f32x16& p0, f32x16& p1, const bf16* Ks, const bf16x8* qr, int r32, int hi) {
  p0 = f32x16{}; p1 = f32x16{};
  for (int d0 = 0; d0 < 8; ++d0) { int cb = (d0 * 16 + hi * 8) * 2;
    bf16x8 b0 = *reinterpret_cast<const bf16x8*>((const char*)Ks + KSWZ(r32, cb));
    bf16x8 b1 = *reinterpret_cast<const bf16x8*>((const char*)Ks + KSWZ(32 + r32, cb));
    p0 = __builtin_amdgcn_mfma_f32_32x32x16_bf16(b0, qr[d0], p0, 0, 0, 0);
    p1 = __builtin_amdgcn_mfma_f32_32x32x16_bf16(b1, qr[d0], p1, 0, 0, 0); }
}
__device__ __forceinline__ int v_st(int k, int c) { const int kk = (k & ~0xC) | ((k & 4) << 1) | ((k & 8) >> 1); return ((kk >> 3) * 4 + (c >> 5)) * 512 + ((kk & 7) * 32 + (c & 31)) * 2; }
__device__ __forceinline__ int v_rd_base(int lane) { return ((lane & 3) << 3) | (((lane >> 2) & 3) << 6) | (((lane >> 4) & 1) << 5) | (((lane >> 5) & 1) << 8); }
constexpr int v_rd_off(int d0, int ks, int half) { return d0 * 512 + ks * 4096 + half * 2048; }
template <int OFF> __device__ __forceinline__ s16x4 tr_read(int vb) {
  s16x4 r; asm volatile("ds_read_b64_tr_b16 %0, %1 offset:%2" : "=&v"(r) : "v"(vb), "i"(OFF) : "memory"); return r;
}
template <int D0> __device__ __forceinline__ void pv_one(f32x16& od, int vb, bf16x8 pa0, bf16x8 pa1, bf16x8 pa2, bf16x8 pa3) {
  const s16x4 l0 = tr_read<v_rd_off(D0, 0, 0)>(vb), h0 = tr_read<v_rd_off(D0, 0, 1)>(vb), l1 = tr_read<v_rd_off(D0, 1, 0)>(vb), h1 = tr_read<v_rd_off(D0, 1, 1)>(vb);
  const s16x4 l2 = tr_read<v_rd_off(D0, 2, 0)>(vb), h2 = tr_read<v_rd_off(D0, 2, 1)>(vb), l3 = tr_read<v_rd_off(D0, 3, 0)>(vb), h3 = tr_read<v_rd_off(D0, 3, 1)>(vb);
  asm volatile("s_waitcnt lgkmcnt(0)" ::: "memory"); SBAR();
#define PK(L, H) (bf16x8){L[0], L[1], L[2], L[3], H[0], H[1], H[2], H[3]}
  od = __builtin_amdgcn_mfma_f32_32x32x16_bf16(pa0, PK(l0, h0), od, 0, 0, 0);
  od = __builtin_amdgcn_mfma_f32_32x32x16_bf16(pa1, PK(l1, h1), od, 0, 0, 0);
  od = __builtin_amdgcn_mfma_f32_32x32x16_bf16(pa2, PK(l2, h2), od, 0, 0, 0);
  od = __builtin_amdgcn_mfma_f32_32x32x16_bf16(pa3, PK(l3, h3), od, 0, 0, 0);
#undef PK
}
__device__ __forceinline__ void pv_d0(f32x16* o, int vb, bf16x8 pa0, bf16x8 pa1, bf16x8 pa2, bf16x8 pa3) {
  pv_one<0>(o[0], vb, pa0, pa1, pa2, pa3); pv_one<1>(o[1], vb, pa0, pa1, pa2, pa3); pv_one<2>(o[2], vb, pa0, pa1, pa2, pa3); pv_one<3>(o[3], vb, pa0, pa1, pa2, pa3);
}
__device__ __forceinline__ void attn_dense_body(const bf16* __restrict__ Qb, const bf16* __restrict__ Kh, const bf16* __restrict__ Vh, bf16* __restrict__ Ob, int seq, char* lds) {
  int tid_ = threadIdx.x; asm volatile("" : "+v"(tid_));
  const int tid = tid_, wid = tid >> 6, lane = tid & 63, r32 = lane & 31, hi = lane >> 5;
  bf16* V_lds = (bf16*)lds; bf16* K_lds = (bf16*)(lds + 2 * SHM_V);
  float* ws = (float*)(lds + 2 * SHM_V + 2 * SHM_K) + wid * 64; float* li_l = ws; float* al_l = ws + 32;
  float m_reg = -1e30f, l_reg = 0; f32x16 o[4] = {}; bf16x8 qr[8];
  const bf16* Qw = Qb + (long)(wid * QBLK + r32) * LDQ + hi * 8;
#pragma unroll
  for (int d0 = 0; d0 < 8; ++d0) qr[d0] = *reinterpret_cast<const bf16x8*>(Qw + d0 * 16);
  const int sr = tid >> 4, sc = (tid & 15) * 8, vst0 = v_st(sr, sc), vst1 = v_st(32 + sr, sc);
  const int vb0 = (int)(uintptr_t)V_lds + v_rd_base(lane);
  struct { bf16x8 vs0, vs1, ks0, ks1; } sr_[SDEPTH];
#define SLOAD(i, k0) do { sr_[i].vs0 = *reinterpret_cast<const bf16x8*>(&Vh[(long)((k0) + sr) * LDK + sc]); sr_[i].vs1 = *reinterpret_cast<const bf16x8*>(&Vh[(long)((k0) + 32 + sr) * LDK + sc]); \
    sr_[i].ks0 = *reinterpret_cast<const bf16x8*>(&Kh[(long)((k0) + sr) * LDK + sc]); sr_[i].ks1 = *reinterpret_cast<const bf16x8*>(&Kh[(long)((k0) + 32 + sr) * LDK + sc]); } while (0)
#define SWRITE(b, i) do { *(bf16x8*)((char*)V_lds + (b) * SHM_V + vst0) = sr_[i].vs0;          \
    *(bf16x8*)((char*)V_lds + (b) * SHM_V + vst1) = sr_[i].vs1; int kc = sc * 2;               \
    *(bf16x8*)((char*)K_lds + (b) * SHM_K + KSWZ(sr, kc)) = sr_[i].ks0;                       \
    *(bf16x8*)((char*)K_lds + (b) * SHM_K + KSWZ(32 + sr, kc)) = sr_[i].ks1; } while (0)
#define SWAIT() do { asm volatile("s_waitcnt vmcnt(4)" ::: "memory"); } while (0)
#define RESC(a) do { if (__any((a) < 1.f)) { if (hi == 0) al_l[r32] = (a); asm volatile("s_waitcnt lgkmcnt(0)" ::: "memory"); \
    for (int d = 0; d < 4; ++d) for (int r = 0; r < 16; ++r) o[d][r] *= al_l[crow(r, hi)]; } } while (0)
  f32x16 pA0, pA1, pB0, pB1; float mnA, mnB, alA, alB; bf16x8 pa0, pa1, pa2, pa3; const int NT = seq / KVBLK;
  constexpr int SE = 0, SO = SDEPTH - 1;
  SLOAD(SE, 0); asm volatile("s_waitcnt vmcnt(0)" ::: "memory"); SWRITE(0, SE); __syncthreads();
  qkt(pA0, pA1, K_lds, qr, r32, hi); partialSM(pA0, pA1, m_reg, mnA, alA);
  SLOAD(SO, KVBLK); if (2 < NT) SLOAD(SE, 2 * KVBLK);
  SWAIT(); SWRITE(1, SO); __syncthreads();
  for (int j = 1; j + 1 < NT; j += 2) {
    SBAR(); qkt(pB0, pB1, (bf16*)((char*)K_lds + SHM_K), qr, r32, hi);
    finishSM(pA0, pA1, alA, l_reg, pa0, pa1, pa2, pa3); SBAR();
    SLOAD(SO, (j + SDEPTH) * KVBLK); SBAR();
    pv_d0(o, vb0, pa0, pa1, pa2, pa3); partialSM(pB0, pB1, m_reg, mnB, alB);
    __syncthreads(); SWAIT(); SWRITE(0, SE);
    RESC(alB); __syncthreads();
    SBAR(); qkt(pA0, pA1, K_lds, qr, r32, hi);
    finishSM(pB0, pB1, alB, l_reg, pa0, pa1, pa2, pa3); SBAR();
    if (j + 3 < NT) SLOAD(SE, (j + 1 + SDEPTH) * KVBLK); SBAR();
    pv_d0(o, vb0 + (int)SHM_V, pa0, pa1, pa2, pa3); partialSM(pA0, pA1, m_reg, mnA, alA);
    __syncthreads(); SWAIT(); SWRITE(1, SO);
    RESC(alA); __syncthreads();
  }
  SBAR(); qkt(pB0, pB1, (bf16*)((char*)K_lds + SHM_K), qr, r32, hi);
  finishSM(pA0, pA1, alA, l_reg, pa0, pa1, pa2, pa3); SBAR();
  pv_d0(o, vb0, pa0, pa1, pa2, pa3); partialSM(pB0, pB1, m_reg, mnB, alB);
  __syncthreads(); RESC(alB);
  finishSM(pB0, pB1, alB, l_reg, pa0, pa1, pa2, pa3); SBAR();
  pv_d0(o, vb0 + (int)SHM_V, pa0, pa1, pa2, pa3);
  if (hi == 0) li_l[r32] = l_reg; asm volatile("s_waitcnt lgkmcnt(0)" ::: "memory");
  float rli[16];
#pragma unroll
  for (int r = 0; r < 16; ++r) rli[r] = __builtin_amdgcn_rcpf(li_l[crow(r, hi)]);
  asm volatile("s_waitcnt vmcnt(0) lgkmcnt(0)" ::: "memory");
  __syncthreads();
  char* ost = lds + wid * 8192;
#pragma unroll
  for (int r = 0; r < 16; r += 2) { const int row_a = crow(r, hi), row_b = crow(r + 1, hi);
#pragma unroll
    for (int d0 = 0; d0 < 4; ++d0) { const unsigned w = cvtpk(o[d0][r] * rli[r], o[d0][r + 1] * rli[r + 1]);
      *(unsigned short*)(ost + row_a * 256 + (d0 * 32 + r32) * 2) = (unsigned short)(w & 0xffffu);
      *(unsigned short*)(ost + row_b * 256 + (d0 * 32 + r32) * 2) = (unsigned short)(w >> 16); } }
  asm volatile("s_waitcnt lgkmcnt(0)" ::: "memory");
  bf16* Ow = Ob + (long)(wid * QBLK) * LDO;
#pragma unroll
  for (int i = 0; i < 8; ++i) { const int idx = lane + 64 * i, row = idx >> 4, c16 = idx & 15;
    const u32x4 v = *(const u32x4*)(ost + row * 256 + c16 * 16); *(u32x4*)(Ow + (long)row * LDO + c16 * 8) = v; }
  asm volatile("s_waitcnt lgkmcnt(0)" ::: "memory");
  __syncthreads();
#undef SLOAD
#undef SWRITE
#undef SWAIT
#undef RESC
}
#undef KSWZ
#undef SBAR
}

constexpr int NWAVES = 8;
#ifndef MK_MULTI
#define MK_MULTI 0
#endif

#ifndef PH_P0
#define PH_P0 1
#endif
#ifndef PH_GU
#define PH_GU 1
#endif
#ifndef PH_PLAIN
#define PH_PLAIN 1
#endif
#ifndef PH_ROPE
#define PH_ROPE 1
#endif
#ifndef PH_ATT
#define PH_ATT 1
#endif
#ifndef PH_REC1
#define PH_REC1 1
#endif
#ifndef PH_REC2
#define PH_REC2 1
#endif
#ifndef PH_RES
#define PH_RES 1
#endif
#ifndef PH_FN
#define PH_FN 1
#endif
constexpr int S = 8192, DM = 2048, DFF = 5632, NGU = 2 * DFF, QKVD = 3072, DRNN = 2048, NFFN = 8, NSB = 12;
constexpr int N_PHASES = 2 + 4 * NSB;
constexpr float NORM_EPS = 1e-6f;

constexpr size_t MiB = 1u << 20;
constexpr size_t WS_CTL = 0, CTL_ZERO_BYTES = 2 * MiB;
constexpr size_t WS_SS = 1 * MiB;
constexpr size_t WS_ROPE = 2 * MiB;
constexpr size_t WS_WG = 3 * MiB;
constexpr size_t WS_AGGS = 7 * MiB;
constexpr size_t WS_AGGC = 15 * MiB;
constexpr size_t WS_WGU = 16 * MiB, SZ_WGU = (size_t)NGU * DM * 2;
constexpr size_t WS_WD = WS_WGU + NFFN * SZ_WGU, SZ_WD = (size_t)DM * DFF * 2;
constexpr size_t WS_WQKV = WS_WD + NFFN * SZ_WD, SZ_WQKV = (size_t)QKVD * DM * 2;
constexpr size_t WS_WO = WS_WQKV + 2 * SZ_WQKV, SZ_WO = (size_t)DM * DM * 2;
constexpr size_t WS_WIN = WS_WO + 2 * SZ_WO, SZ_WIN = (size_t)2 * DRNN * DM * 2;
constexpr size_t WS_WOUT = WS_WIN + 2 * SZ_WIN, SZ_WOUT = (size_t)DM * DRNN * 2;
constexpr size_t WS_XB = WS_WOUT + 2 * SZ_WOUT;
constexpr size_t WS_H = WS_XB + (size_t)S * DM * 2;
constexpr size_t WS_QKV = WS_H + (size_t)S * DFF * 2;
constexpr size_t WS_O = WS_QKV + (size_t)S * QKVD * 2;
constexpr size_t WS_U = WS_O + (size_t)S * DM * 2;
constexpr size_t WS_Y = WS_U + (size_t)S * 2 * DRNN * 2;
constexpr size_t WS_END = WS_Y + (size_t)S * DRNN * 2;
static_assert(WS_WG + 128 * 16384 * 2 <= WS_AGGS && WS_AGGS + 256 * 2 * 2048 * 8 <= WS_AGGC && WS_AGGC + 16 * 2 * 2048 * 8 <= WS_WGU, "small tables do not overlap");
static_assert(WS_SS + 13 * (size_t)S * 8 <= CTL_ZERO_BYTES, "ss arrays inside the memset region");
static_assert(WS_WGU % 256 == 0 && WS_XB % 256 == 0 && WS_H % 256 == 0 && WS_QKV % 256 == 0 && WS_O % 256 == 0 && WS_U % 256 == 0 && WS_Y % 256 == 0, "alignment");
constexpr int CW_BAR = 4096;

constexpr int RING_OFF = 0, RING_BYTES = 131072;
constexpr int LDSCTL_OFF = RING_BYTES, MISC_OFF = LDSCTL_OFF + 320;
constexpr int LDS_BYTES = 147456;
static_assert(MISC_OFF + 128 <= LDS_BYTES, "LDS map");

#define GAS __attribute__((address_space(1)))
#define LAS __attribute__((address_space(3)))
typedef unsigned short bf16;
typedef unsigned v4u __attribute__((ext_vector_type(4)));
typedef float f32x4 __attribute__((ext_vector_type(4)));
typedef short bf16x8 __attribute__((ext_vector_type(8)));
typedef GAS unsigned gu32;
#define RLX_AGENT __ATOMIC_RELAXED, __HIP_MEMORY_SCOPE_AGENT
#define LDS_WAIT() asm volatile("s_waitcnt lgkmcnt(0)" ::: "memory")
#define VM_WAIT() asm volatile("s_waitcnt vmcnt(0)" ::: "memory")
__device__ __forceinline__ unsigned f2bf(float f) { unsigned u = __builtin_bit_cast(unsigned, f); return (u + 0x7fffu + ((u >> 16) & 1u)) >> 16; }
__device__ __forceinline__ unsigned pk2(float lo, float hi) { return f2bf(lo) | (f2bf(hi) << 16); }
__device__ __forceinline__ float bf_lo(unsigned w) { return __builtin_bit_cast(float, w << 16); }
__device__ __forceinline__ float bf_hi(unsigned w) { return __builtin_bit_cast(float, w & 0xffff0000u); }

#define XB_TMO      128
#define XB_XCNT(j)  (256  + 64 * (j))
#define XB_XSUB(j)  (1280 + 64 * (j))
#define XB_XGEN(j)  (2304 + 64 * (j))
#define XB_TOP      3328
#define XB_TOPGEN   3392
#define XCD_BAR_WORDS 3456
#define XB_SPIN_CAP (1u << 18)

__device__ __forceinline__ unsigned xb_ld(unsigned* p)              { return __hip_atomic_load(p, __ATOMIC_RELAXED, __HIP_MEMORY_SCOPE_AGENT); }
__device__ __forceinline__ unsigned xb_add(unsigned* p, unsigned v) { return __hip_atomic_fetch_add(p, v, __ATOMIC_RELAXED, __HIP_MEMORY_SCOPE_AGENT); }
__device__ __forceinline__ unsigned xb_xcc_id() { return (unsigned)__builtin_amdgcn_s_getreg((3 << 11) | 20) & 0xFu; }
#define XB_SPIN(cond, bar) do { unsigned _sp = 0; while (cond) { __builtin_amdgcn_s_sleep(1); \
    if ((++_sp & 255u) == 0u) { if (xb_ld(&(bar)[XB_TMO])) break; if (_sp > XB_SPIN_CAP) { atomicAdd(&(bar)[XB_TMO], 1u); break; } } } } while (0)

struct XcdBarrier {
    unsigned* bar; unsigned x;
    volatile LAS unsigned* st;
};

__device__ __forceinline__ XcdBarrier xcd_barrier_post(unsigned* bar, volatile LAS unsigned* st) {
    XcdBarrier b; b.bar = bar; b.x = xb_xcc_id(); b.st = st;
    if (threadIdx.x == 0) (void)xb_add(&bar[XB_XCNT(b.x)], 1u);
    return b;
}
__device__ __forceinline__ void xcd_barrier_complete(unsigned* bar, unsigned x, unsigned& nloc, unsigned& nx) {
    const unsigned G = gridDim.x * gridDim.y * gridDim.z;
    unsigned sum, cnt, mine, sp = 0u;
    for (;;) {
        sum = 0u; cnt = 0u; mine = 0u;
#pragma unroll
        for (unsigned j = 0; j < 16; ++j) { const unsigned c = xb_ld(&bar[XB_XCNT(j)]); sum += c; cnt += (c > 0u) ? 1u : 0u; mine = (j == x) ? c : mine; }
        if (sum == G) break;
        __builtin_amdgcn_s_sleep(1);
        if ((++sp & 255u) == 0u) { if (xb_ld(&bar[XB_TMO])) break; if (sp > XB_SPIN_CAP) { atomicAdd(&bar[XB_TMO], 1u); break; } }
    }
    nloc = mine > 0u ? mine : 1u; nx = cnt > 0u ? cnt : 1u;
}

__device__ __forceinline__ void xcd_barrier(const XcdBarrier& b) {
    asm volatile("s_waitcnt vmcnt(0)" ::: "memory");
    __syncthreads();
    if (threadIdx.x == 0) {
        unsigned* bar = b.bar;
        __builtin_amdgcn_s_waitcnt(0);
        unsigned nloc = b.st[0], nx = b.st[1];
        if (nloc == 0u) { xcd_barrier_complete(bar, b.x, nloc, nx); b.st[0] = nloc; b.st[1] = nx; }
        const unsigned old = xb_add(&bar[XB_XSUB(b.x)], 1u);
        const unsigned gen = old / nloc;
        if (old + 1u == (gen + 1u) * nloc) {
            __builtin_amdgcn_fence(__ATOMIC_RELEASE, "agent");
            asm volatile("s_waitcnt vmcnt(0)" ::: "memory");
            const unsigned og = xb_add(&bar[XB_TOP], 1u);
            const unsigned tg = og / nx;
            if (og + 1u == (tg + 1u) * nx) xb_add(&bar[XB_TOPGEN], 1u);
            else XB_SPIN(xb_ld(&bar[XB_TOPGEN]) == tg, bar);
            __builtin_amdgcn_fence(__ATOMIC_ACQUIRE, "agent");
            xb_add(&bar[XB_XGEN(b.x)], 1u);
            asm volatile("s_waitcnt vmcnt(0)" ::: "memory");
        } else {
            XB_SPIN(xb_ld(&bar[XB_XGEN(b.x)]) == gen, bar);
            __builtin_amdgcn_fence(__ATOMIC_ACQUIRE, "agent");
            asm volatile("s_waitcnt vmcnt(0)" ::: "memory");
        }
    }
    __syncthreads();
}
#define OPAQUE_LANE() int tid_ = threadIdx.x; asm volatile("" : "+v"(tid_)); const int lane_ = tid_ & 63, wave_ = __builtin_amdgcn_readfirstlane(tid_ >> 6); (void)lane_; (void)wave_
struct Frame {
    LAS unsigned char* lds;
    volatile LAS unsigned* MISC;
    gu32* ctl;
    int tid, lane, wave;
    int vcu, G;
    unsigned char* ws;
    const float* const* in;
};
__device__ __forceinline__ float wave_sum(float v) {
#pragma unroll
    for (int o = 1; o < 64; o <<= 1) v += __shfl_xor(v, o);
    return v;
}
__device__ __forceinline__ void p0_transpose_item(const float* W, int K, int N, bf16* WT, const float* gain, int gu_mode, LAS float* scr, int item, int lane) {
    const int nblk = N / 32, kb = item / nblk, nb = item - kb * nblk, k0 = 64 * kb, n0 = 32 * nb;
#pragma unroll 8
    for (int i = 0; i < 32; ++i) { const int kk = 2 * i + (lane >> 5); float v = W[(size_t)(k0 + kk) * N + n0 + (lane & 31)]; if (gain) v *= gain[k0 + kk]; scr[kk * 33 + (lane & 31)] = v; }
    LDS_WAIT(); asm volatile("" ::: "memory");
    int d0 = n0; if (gu_mode) { const int isu = n0 >= DFF ? 1 : 0, nn = n0 - isu * DFF; d0 = (nn >> 7) * 256 + isu * 128 + (nn & 127); }
    const int c = lane & 7;
#pragma unroll
    for (int j = 0; j < 4; ++j) { const int n = (lane >> 3) + 8 * j; const LAS float* s = scr + (8 * c) * 33 + n;
        v4u o; o.x = pk2(s[0 * 33], s[1 * 33]); o.y = pk2(s[2 * 33], s[3 * 33]); o.z = pk2(s[4 * 33], s[5 * 33]); o.w = pk2(s[6 * 33], s[7 * 33]);
        *(GAS v4u*)(WT + (size_t)(d0 + n) * K + k0 + 8 * c) = o; }
    LDS_WAIT(); asm volatile("" ::: "memory");
}
__device__ __forceinline__ void sincos_acc(float ang, float& sn, float& cs) {
    const double a = (double)ang; const double kq = __builtin_rint(a * 0.63661977236758134308);
    double r = __builtin_fma(-kq, 1.5707963267948966192, a); r = __builtin_fma(-kq, 6.123233995736766036e-17, r);
    const double r2 = r * r;
    double ps = -1.0 / 1307674368000.0; ps = ps * r2 + 1.0 / 6227020800.0; ps = ps * r2 - 1.0 / 39916800.0; ps = ps * r2 + 1.0 / 362880.0; ps = ps * r2 - 1.0 / 5040.0; ps = ps * r2 + 1.0 / 120.0; ps = ps * r2 - 1.0 / 6.0; ps = ps * r2 + 1.0;
    const double s = ps * r;
    double pc = 1.0 / 20922789888000.0; pc = pc * r2 - 1.0 / 87178291200.0; pc = pc * r2 + 1.0 / 479001600.0; pc = pc * r2 - 1.0 / 3628800.0; pc = pc * r2 + 1.0 / 40320.0; pc = pc * r2 - 1.0 / 720.0; pc = pc * r2 + 1.0 / 24.0; pc = pc * r2 - 0.5; pc = pc * r2 + 1.0;
    const int q = ((int)kq) & 3;
    const double ss = (q == 0) ? s : (q == 1) ? pc : (q == 2) ? -s : -pc;
    const double cc = (q == 0) ? pc : (q == 1) ? -s : (q == 2) ? -pc : s;
    sn = (float)ss; cs = (float)cc;
}
__device__ __forceinline__ void p0_prologue(Frame& F) {
    OPAQUE_LANE();
    LAS float* scr = (LAS float*)(F.lds + RING_OFF + wave_ * 16384);
    const int gw = F.vcu * NWAVES + wave_, NGW = F.G * NWAVES;
    constexpr int I_GU = (DM / 64) * (NGU / 32), I_D = (DFF / 64) * (DM / 32), I_QKV = (DM / 64) * (QKVD / 32), I_O = (DM / 64) * (DM / 32), I_IN = (DM / 64) * (2 * DRNN / 32), I_OUT = (DRNN / 64) * (DM / 32), I_G = 8;
    constexpr int NITEMS = NFFN * (I_GU + I_D) + 2 * (I_QKV + I_O + I_IN + I_OUT) + 128 * I_G;
    for (int it = gw; it < NITEMS; it += NGW) {
        int r = it; const float* W; bf16* WT; const float* gain = nullptr; int K, N, gm = 0, item;
        if (r < NFFN * I_GU) { const int f = r / I_GU; item = r - f * I_GU; W = F.in[2] + (size_t)f * DM * NGU; K = DM; N = NGU; WT = (bf16*)(F.ws + WS_WGU + f * SZ_WGU); gain = F.in[1] + f * DM; gm = 1; }
        else if ((r -= NFFN * I_GU) < NFFN * I_D) { const int f = r / I_D; item = r - f * I_D; W = F.in[3] + (size_t)f * DFF * DM; K = DFF; N = DM; WT = (bf16*)(F.ws + WS_WD + f * SZ_WD); }
        else if ((r -= NFFN * I_D) < 2 * I_QKV) { const int l = r / I_QKV; item = r - l * I_QKV; W = F.in[5] + (size_t)l * DM * QKVD; K = DM; N = QKVD; WT = (bf16*)(F.ws + WS_WQKV + l * SZ_WQKV); gain = F.in[4] + l * DM; }
        else if ((r -= 2 * I_QKV) < 2 * I_O) { const int l = r / I_O; item = r - l * I_O; W = F.in[8] + (size_t)l * DM * DM; K = DM; N = DM; WT = (bf16*)(F.ws + WS_WO + l * SZ_WO); }
        else if ((r -= 2 * I_O) < 2 * I_IN) { const int l = r / I_IN; item = r - l * I_IN; W = F.in[10] + (size_t)l * DM * 2 * DRNN; K = DM; N = 2 * DRNN; WT = (bf16*)(F.ws + WS_WIN + l * SZ_WIN); gain = F.in[9] + l * DM; }
        else if ((r -= 2 * I_IN) < 2 * I_OUT) { const int l = r / I_OUT; item = r - l * I_OUT; W = F.in[16] + (size_t)l * DRNN * DM; K = DRNN; N = DM; WT = (bf16*)(F.ws + WS_WOUT + l * SZ_WOUT); }
        else { r -= 2 * I_OUT; const int b = r / I_G; item = r - b * I_G; W = F.in[13] + (size_t)b * 16384; K = 128; N = 128; WT = (bf16*)(F.ws + WS_WG) + (size_t)b * 16384; }
        p0_transpose_item(W, K, N, WT, gain, gm, scr, item, lane_);
    }
    { bf16* XB = (bf16*)(F.ws + WS_XB); pg8::ss_t* ss0 = (pg8::ss_t*)(F.ws + WS_SS);
      for (int m = gw; m < S; m += NGW) {
        const GAS f32x4* xr = (const GAS f32x4*)(F.in[0] + (size_t)m * DM) + lane_; f32x4 v[8]; float s = 0.f;
#pragma unroll
        for (int j = 0; j < 8; ++j) { v[j] = xr[64 * j]; s += (v[j].x * v[j].x + v[j].y * v[j].y) + (v[j].z * v[j].z + v[j].w * v[j].w); }
        s = wave_sum(s); if (lane_ == 0) ss0[m] = (pg8::ss_t)(s * pg8::SS_SCALE);
        GAS unsigned long long* o8 = (GAS unsigned long long*)(XB + (size_t)m * DM) + lane_;
#pragma unroll
        for (int j = 0; j < 8; ++j) o8[64 * j] = (unsigned long long)pk2(v[j].x, v[j].y) | ((unsigned long long)pk2(v[j].z, v[j].w) << 32);
      } }
    { float* rt = (float*)(F.ws + WS_ROPE); const int gt = (F.vcu * NWAVES + wave_) * 64 + lane_;
      for (int e = gt; e < (128 + 64) * 32; e += NGW * 64) { const int f = e & 31, pe = e >> 5; const int isc = pe >= 128 ? 1 : 0, pos = pe - isc * 128;
        double inv = 1.0; for (int k = 0; k < f; ++k) inv *= 0.74989420933245582730;
        const float ang = (float)pos * (float)inv; float sn, cs; sincos_acc(ang, sn, cs);
        float* cst = rt + (isc ? 8192 : 0); const int nel = isc ? 2048 : 4096;
        cst[pos * 32 + f] = cs; cst[nel + pos * 32 + f] = sn; } }
}
__device__ __forceinline__ void rope_phase(Frame& F, const float* qg, const float* kg) {
    OPAQUE_LANE();
    bf16* QKV = (bf16*)(F.ws + WS_QKV); const float* rt = (const float*)(F.ws + WS_ROPE);
    const int gw = F.vcu * NWAVES + wave_, NGW = F.G * NWAVES, g = lane_ >> 4, j = lane_ & 15;
    const int d = 8 * j, axis = d >> 6, first = ((d & 63) < 32) ? 1 : 0, f0 = d & 31;
    const float* gq = qg + d; const float* gk = kg + d;
    f32x4 gq0 = *(const f32x4*)gq, gq1 = *(const f32x4*)(gq + 4), gk0 = *(const f32x4*)gk, gk1 = *(const f32x4*)(gk + 4);
    for (int it = gw; it < S * 5; it += NGW) {
        const int row = it / 5, part = it - row * 5;
        bf16* p = QKV + (size_t)row * QKVD + part * 512 + g * 128 + d;
        const v4u w = *(const GAS v4u*)p;
        float x[8] = {bf_lo(w.x), bf_hi(w.x), bf_lo(w.y), bf_hi(w.y), bf_lo(w.z), bf_hi(w.z), bf_lo(w.w), bf_hi(w.w)};
        float ssq = 0.f;
#pragma unroll
        for (int e = 0; e < 8; ++e) ssq += x[e] * x[e];
        ssq += __shfl_xor(ssq, 1); ssq += __shfl_xor(ssq, 2); ssq += __shfl_xor(ssq, 4); ssq += __shfl_xor(ssq, 8);
        const float rstd = __builtin_amdgcn_rsqf(ssq * (1.0f / 128.0f) + NORM_EPS);
        const f32x4 g0 = part < 4 ? gq0 : gk0, g1 = part < 4 ? gq1 : gk1;
        const float gn[8] = {g0.x, g0.y, g0.z, g0.w, g1.x, g1.y, g1.z, g1.w};
        const int pos = axis ? (row & 63) : (row >> 6);
        const float* ct = rt + (axis ? 8192 : 0) + pos * 32 + f0; const float* st = ct + (axis ? 2048 : 4096);
        const f32x4 c0 = *(const f32x4*)ct, c1 = *(const f32x4*)(ct + 4), s0 = *(const f32x4*)st, s1 = *(const f32x4*)(st + 4);
        const float cs[8] = {c0.x, c0.y, c0.z, c0.w, c1.x, c1.y, c1.z, c1.w}, sn[8] = {s0.x, s0.y, s0.z, s0.w, s1.x, s1.y, s1.z, s1.w};
        float o[8];
#pragma unroll
        for (int e = 0; e < 8; ++e) { const float xn = x[e] * rstd * gn[e]; const float pn = __shfl_xor(xn, 4);
            o[e] = first ? (xn * cs[e] - pn * sn[e]) : (xn * cs[e] + pn * sn[e]); }
        v4u ow; ow.x = pk2(o[0], o[1]); ow.y = pk2(o[2], o[3]); ow.z = pk2(o[4], o[5]); ow.w = pk2(o[6], o[7]);
        *(GAS v4u*)p = ow;
    }
}
__device__ __forceinline__ void attn_phase(Frame& F, char* lds) {
    const att::bf16* QKV = (const att::bf16*)(F.ws + WS_QKV); att::bf16* O = (att::bf16*)(F.ws + WS_O);
    for (int u = F.vcu; u < 512; u += F.G) {
        const int i = u >> 8, x = (u & 255) >> 5, l = u & 31, kvh = x >> 1, h = kvh * 4 + (x & 1) * 2 + i, qb = l;
        att::attn_dense_body(QKV + (size_t)(qb * 256) * QKVD + h * 128, QKV + 2048 + kvh * 128, QKV + 2560 + kvh * 128, O + (size_t)(qb * 256) * DM + h * 128, S, lds);
    }
}
constexpr int SC_AT = 0, SC_ATP = 272;
constexpr int SC_XF = 9216, SC_XFP = 528;
constexpr int SC_AB = 26624;
constexpr int SC_CR = 92160;
#ifdef DBG_REC
#define DBG_CHECK(code, bad) do { if (bad) atomicMax((unsigned*)(F.ws + 2 * MiB - 256), 100u - (unsigned)(code)); } while (0)
#else
#define DBG_CHECK(code, bad) do { } while (0)
#endif
__device__ __forceinline__ bool nonfinite(float x) { return !(__builtin_fabsf(x) < 3.0e38f); }
struct RecArgs { const bf16* U; const bf16* Wg; const float* gate_b; const float* lam; const float* conv_w; const float* conv_b; float2* aggs; float2* aggc; bf16* Y; };
__device__ __forceinline__ float sigmoid_f(float x) { return __builtin_amdgcn_rcpf(1.0f + __builtin_amdgcn_exp2f(x * -1.4426950408889634f)); }
template <int PASS>
__device__ __forceinline__ void rec_pass(Frame& F, char* lds, const RecArgs& R) {
    typedef float f32x4v __attribute__((ext_vector_type(4)));
    OPAQUE_LANE();
    const int tid = tid_, lane = lane_, w = wave_, wd = w >> 2, wq = w & 3, l15 = lane & 15, l4 = lane >> 4;
    const int tl = tid >> 4, c8 = (tid & 15) * 8;
    const int sd = tid >> 7, sch = tid & 127;
    for (int item = F.vcu; item < 256; item += F.G) {
        const int n = item & 15, c = item >> 4;
        bf16x8 bfr[2][2][4];
#pragma unroll
        for (int z = 0; z < 2; ++z)
#pragma unroll
            for (int nt = 0; nt < 2; ++nt)
#pragma unroll
                for (int ks = 0; ks < 4; ++ks)
                    bfr[z][nt][ks] = *(const GAS bf16x8*)(R.Wg + ((size_t)(((wd * 2 + z) * 16 + n) * 128 + wq * 32 + nt * 16 + l15)) * 128 + ks * 32 + l4 * 8);
#ifdef DBG_REC
        { bool bad = false, big = false;
          for (int z = 0; z < 2; ++z) for (int nt = 0; nt < 2; ++nt) for (int ks = 0; ks < 4; ++ks) for (int e = 0; e < 8; ++e) { const float v = __builtin_bit_cast(float, ((unsigned)(unsigned short)bfr[z][nt][ks][e]) << 16); bad |= nonfinite(v); big |= __builtin_fabsf(v) > 100.f; }
          DBG_CHECK(1, bad); DBG_CHECK(2, big); }
#endif
        float br[2], bi[2], sp[2];
#pragma unroll
        for (int nt = 0; nt < 2; ++nt) { const int ch = n * 128 + wq * 32 + nt * 16 + l15; br[nt] = R.gate_b[(wd * 2 + 0) * DRNN + ch]; bi[nt] = R.gate_b[(wd * 2 + 1) * DRNN + ch];
            const float lm = R.lam[wd * DRNN + ch]; sp[nt] = 8.0f * log1pf(__expf(-lm)); }
        float cw[4][8], cb[8];
        { const int ch0 = n * 128 + c8;
#pragma unroll
          for (int tp = 0; tp < 4; ++tp) { const f32x4v a = *(const f32x4v*)(R.conv_w + tp * DRNN + ch0), b = *(const f32x4v*)(R.conv_w + tp * DRNN + ch0 + 4);
              cw[tp][0] = a.x; cw[tp][1] = a.y; cw[tp][2] = a.z; cw[tp][3] = a.w; cw[tp][4] = b.x; cw[tp][5] = b.y; cw[tp][6] = b.z; cw[tp][7] = b.w; }
          const f32x4v a = *(const f32x4v*)(R.conv_b + ch0), b = *(const f32x4v*)(R.conv_b + ch0 + 4);
          cb[0] = a.x; cb[1] = a.y; cb[2] = a.z; cb[3] = a.w; cb[4] = b.x; cb[5] = b.y; cb[6] = b.z; cb[7] = b.w; }
        float aggA = 1.f, aggB = 0.f;
        if (PASS == 2 && tid < 256) {
            const int ch = n * 128 + sch; float h = 0.f; float* cr = (float*)(lds + SC_CR);
            if (sd == 0) { for (int cc = 0; cc < c; ++cc) { const float2 ab = R.aggc[(size_t)(cc * 2 + 0) * DRNN + ch]; h = ab.x * h + ab.y; }
                for (int s = 0; s < 16; ++s) { cr[(s * 2 + 0) * 128 + sch] = h; const float2 ab = R.aggs[(size_t)((c * 16 + s) * 2 + 0) * DRNN + ch]; h = ab.x * h + ab.y; } }
            else { for (int cc = 15; cc > c; --cc) { const float2 ab = R.aggc[(size_t)(cc * 2 + 1) * DRNN + ch]; h = ab.x * h + ab.y; }
                for (int s = 15; s >= 0; --s) { cr[(s * 2 + 1) * 128 + sch] = h; const float2 ab = R.aggs[(size_t)((c * 16 + s) * 2 + 1) * DRNN + ch]; h = ab.x * h + ab.y; } }
        }
        for (int s = 0; s < 16; ++s) {
            const int t0 = c * 512 + s * 32;
            { float xc[8];
#pragma unroll
              for (int e = 0; e < 8; ++e) xc[e] = cb[e];
              const int t = t0 + tl;
#pragma unroll
              for (int tp = 0; tp < 4; ++tp) { const int tt = t + tp - 2;
                  if (tt >= 0 && tt < S) { const v4u wv = *(const GAS v4u*)(R.U + (size_t)tt * (2 * DRNN) + DRNN + n * 128 + c8);
                      xc[0] += cw[tp][0] * bf_lo(wv.x); xc[1] += cw[tp][1] * bf_hi(wv.x); xc[2] += cw[tp][2] * bf_lo(wv.y); xc[3] += cw[tp][3] * bf_hi(wv.y);
                      xc[4] += cw[tp][4] * bf_lo(wv.z); xc[5] += cw[tp][5] * bf_hi(wv.z); xc[6] += cw[tp][6] * bf_lo(wv.w); xc[7] += cw[tp][7] * bf_hi(wv.w); } }
              { bool bad = false; for (int e = 0; e < 8; ++e) bad |= nonfinite(xc[e]); DBG_CHECK(5, bad); }
              v4u o; o.x = pk2(xc[0], xc[1]); o.y = pk2(xc[2], xc[3]); o.z = pk2(xc[4], xc[5]); o.w = pk2(xc[6], xc[7]);
              *(v4u*)(lds + SC_AT + tl * SC_ATP + c8 * 2) = o;
              *(f32x4v*)(lds + SC_XF + tl * SC_XFP + c8 * 4) = (f32x4v){xc[0], xc[1], xc[2], xc[3]};
              *(f32x4v*)(lds + SC_XF + tl * SC_XFP + c8 * 4 + 16) = (f32x4v){xc[4], xc[5], xc[6], xc[7]}; }
            __syncthreads();
#pragma unroll
            for (int mt = 0; mt < 2; ++mt) {
                bf16x8 af[4];
#pragma unroll
                for (int ks = 0; ks < 4; ++ks) af[ks] = *(const bf16x8*)(lds + SC_AT + (mt * 16 + l15) * SC_ATP + (ks * 32 + l4 * 8) * 2);
#ifdef DBG_REC
                { bool bad = false, big = false; for (int ks = 0; ks < 4; ++ks) for (int e = 0; e < 8; ++e) { const float v = __builtin_bit_cast(float, ((unsigned)(unsigned short)af[ks][e]) << 16); bad |= nonfinite(v); big |= __builtin_fabsf(v) > 1.0e4f; } DBG_CHECK(3, bad); DBG_CHECK(4, big); }
#endif
                f32x4v acc[2][2];
#pragma unroll
                for (int z = 0; z < 2; ++z)
#pragma unroll
                    for (int nt = 0; nt < 2; ++nt) { acc[z][nt] = (f32x4v){0.f, 0.f, 0.f, 0.f};
#pragma unroll
                        for (int ks = 0; ks < 4; ++ks) acc[z][nt] = __builtin_amdgcn_mfma_f32_16x16x32_bf16(af[ks], bfr[z][nt][ks], acc[z][nt], 0, 0, 0); }
#pragma unroll
                for (int nt = 0; nt < 2; ++nt)
#pragma unroll
                    for (int rg = 0; rg < 4; ++rg) { const int tt = mt * 16 + l4 * 4 + rg, chl = wq * 32 + nt * 16 + l15;
                        const float rgate = sigmoid_f(acc[0][nt][rg] + br[nt]), igate = sigmoid_f(acc[1][nt][rg] + bi[nt]);
                        const float la = -sp[nt] * rgate, a = __expf(la), x2 = 2.0f * la;
                        const float em = (x2 > -0.25f) ? -x2 * (1.0f + x2 * (0.5f + x2 * (0.16666667f + x2 * (0.041666668f + x2 * (0.0083333338f + x2 * 0.0013888889f))))) : (1.0f - a * a);
                        const float xv = *(const float*)(lds + SC_XF + tt * SC_XFP + chl * 4);
                        const float bb = __builtin_sqrtf(em) * igate * xv;
                        DBG_CHECK(6, nonfinite(acc[0][nt][rg]) || nonfinite(acc[1][nt][rg])); DBG_CHECK(7, nonfinite(a) || a > 1.0f || a < 0.f); DBG_CHECK(31, nonfinite(xv)); DBG_CHECK(32, nonfinite(em) || em < 0.f); DBG_CHECK(33, nonfinite(igate)); DBG_CHECK(25, nonfinite(bb));
                        *(float*)(lds + SC_AB + ((wd * 2 + 0) * 32 + tt) * 512 + chl * 4) = a;
                        *(float*)(lds + SC_AB + ((wd * 2 + 1) * 32 + tt) * 512 + chl * 4) = bb; }
            }
            __syncthreads();
            if (tid < 256) {
                const float* pa = (const float*)(lds + SC_AB + (sd * 2 + 0) * 16384) + sch; float* pb = (float*)(lds + SC_AB + (sd * 2 + 1) * 16384) + sch;
                if (PASS == 1) {
                    float P = 1.f, h = 0.f;
#pragma unroll 8
                    for (int k = 0; k < 32; ++k) { const int t = sd ? 31 - k : k; const float a = pa[t * 128], b = pb[t * 128]; h = a * h + b; P *= a; DBG_CHECK(34, nonfinite(a) || a > 1.0f); DBG_CHECK(35, nonfinite(b)); }
                    DBG_CHECK(26, nonfinite(h) || nonfinite(P));
                    R.aggs[(size_t)((c * 16 + s) * 2 + sd) * DRNN + n * 128 + sch] = make_float2(P, h);
                    if (sd == 0) { aggB = P * aggB + h; aggA = P * aggA; } else { aggB = aggA * h + aggB; aggA = aggA * P; }
                } else {
                    float h = *((const float*)(lds + SC_CR) + (s * 2 + sd) * 128 + sch);
                    DBG_CHECK(27, nonfinite(h));
#pragma unroll 8
                    for (int k = 0; k < 32; ++k) { const int t = sd ? 31 - k : k; const float a = pa[t * 128], b = pb[t * 128]; h = a * h + b; pb[t * 128] = h; }
                    DBG_CHECK(28, nonfinite(h));
                }
            }
            if (PASS == 2) {
                __syncthreads();
                const float* hf = (const float*)(lds + SC_AB + 1 * 16384 + tl * 512 + c8 * 4); const float* hb = (const float*)(lds + SC_AB + 3 * 16384 + tl * 512 + c8 * 4);
                const f32x4v f0 = *(const f32x4v*)hf, f1 = *(const f32x4v*)(hf + 4), b0 = *(const f32x4v*)hb, b1 = *(const f32x4v*)(hb + 4);
                const int t = t0 + tl;
                const v4u gv = *(const GAS v4u*)(R.U + (size_t)t * (2 * DRNN) + n * 128 + c8);
                const float gx[8] = {bf_lo(gv.x), bf_hi(gv.x), bf_lo(gv.y), bf_hi(gv.y), bf_lo(gv.z), bf_hi(gv.z), bf_lo(gv.w), bf_hi(gv.w)};
                const float hs[8] = {f0.x + b0.x, f0.y + b0.y, f0.z + b0.z, f0.w + b0.w, f1.x + b1.x, f1.y + b1.y, f1.z + b1.z, f1.w + b1.w};
                { bool bad = false; for (int e = 0; e < 8; ++e) bad |= nonfinite(gx[e]); DBG_CHECK(29, bad); bad = false; for (int e = 0; e < 8; ++e) bad |= nonfinite(hs[e]); DBG_CHECK(36, bad); }
                float y[8];
#pragma unroll
                for (int e = 0; e < 8; ++e) { const float v = gx[e]; const float u = 1.5957691216057308f * (v + 0.044715f * v * v * v); y[e] = v * sigmoid_f(u) * hs[e];
                    DBG_CHECK(30, nonfinite(y[e]));
#ifdef DBG_SANITIZE_Y
                    if (!(__builtin_fabsf(y[e]) < 1e30f)) y[e] = 0.f;
#endif
                }
                v4u o; o.x = pk2(y[0], y[1]); o.y = pk2(y[2], y[3]); o.z = pk2(y[4], y[5]); o.w = pk2(y[6], y[7]);
                *(GAS v4u*)(R.Y + (size_t)t * DRNN + n * 128 + c8) = o;
            }
        }
        if (PASS == 1 && tid < 256) R.aggc[(size_t)(c * 2 + sd) * DRNN + n * 128 + sch] = make_float2(aggA, aggB);
        __syncthreads();
    }
}
__device__ __forceinline__ void final_norm_phase(Frame& F, float* X, const pg8::ss_t* ss, const float* g) {
    OPAQUE_LANE();
    const int gw = F.vcu * NWAVES + wave_, NGW = F.G * NWAVES;
    f32x4 gv[8];
#pragma unroll
    for (int j = 0; j < 8; ++j) gv[j] = *((const GAS f32x4*)g + lane_ + 64 * j);
    for (int m = gw; m < S; m += NGW) { GAS f32x4* xr = (GAS f32x4*)(X + (size_t)m * DM) + lane_; const float rs = pg8::rs_from_ss(ss[m]);
#pragma unroll
        for (int j = 0; j < 8; ++j) { const f32x4 v = xr[64 * j]; xr[64 * j] = v * rs * gv[j]; } }
#ifdef DBG_REC
    { const unsigned code = *(const unsigned*)(F.ws + 2 * MiB - 256); if (code && gw == 0 && lane_ == 0) { VM_WAIT(); X[0] = 1000.0f * (float)(100u - code); } }
#endif
}
struct Args { const float* in[18]; float* out; unsigned char* ws; int ph_lo, ph_hi; };
static_assert(sizeof(Args) == 18 * 8 + 8 + 8 + 8, "Args has no padding");
__global__ void __launch_bounds__(NWAVES * 64, 2) mega_fwd(Args args) {
    extern __shared__ __attribute__((aligned(16))) unsigned char lds[];
    Frame F;
    F.lds = (LAS unsigned char*)lds;
    F.MISC = (volatile LAS unsigned*)(F.lds + MISC_OFF);
    F.tid = threadIdx.x; F.lane = F.tid & 63; F.wave = __builtin_amdgcn_readfirstlane(F.tid >> 6);
    F.G = gridDim.x; { const int bx = blockIdx.x; F.vcu = (F.G % 8 == 0) ? (bx % 8) * (F.G / 8) + bx / 8 : bx; }
    F.ws = args.ws; F.ctl = (gu32*)(args.ws + WS_CTL); F.in = args.in;
    for (int u = F.tid; u < (LDS_BYTES - LDSCTL_OFF) / 4; u += NWAVES * 64) ((LAS unsigned*)(F.lds + LDSCTL_OFF))[u] = 0u;
    __syncthreads();
    const int lo = args.ph_lo, hi = args.ph_hi;
    const bool use_bar = (hi - lo) > 1;
    XcdBarrier bar; bar.bar = (unsigned*)(F.ctl + CW_BAR); bar.x = 0; bar.st = nullptr;
    if (use_bar) bar = xcd_barrier_post((unsigned*)(F.ctl + CW_BAR), F.MISC + 8);
#define IN(k) (lo <= (k) && (k) < hi)
#define SEAM(k) do { if (IN((k) + 1)) xcd_barrier(bar); } while (0)
    pg8::ss_t* const ssb = (pg8::ss_t*)(args.ws + WS_SS);
    bf16* const XB = (bf16*)(args.ws + WS_XB);

    #if PH_P0
    if (IN(0)) { p0_prologue(F); SEAM(0); }
#endif

    for (int sb = 0; sb < NSB; ++sb) {
        const int p6 = sb / 6, k6 = sb - 6 * p6;
        const int type = (k6 == 1) ? 1 : (k6 == 4) ? 2 : 0;
        const int f = 4 * p6 + (k6 == 0 ? 0 : k6 == 2 ? 1 : k6 == 3 ? 2 : 3);
        const int pb = 1 + 4 * sb;
        const pg8::ss_t* ss_in = ssb + (size_t)sb * S; pg8::ss_t* ss_out = ssb + (size_t)(sb + 1) * S;
        if (IN(pb)) {
#if PH_GU
            if (type == 0) {
                pg8::Gemm g{XB, (const bf16*)(args.ws + WS_WGU + f * SZ_WGU), S, NGU, DM}; pg8::StaticOrder So; So.init(S, NGU, F.G, (int)blockIdx.x);
                pg8::EpiSwiglu E{(bf16*)(args.ws + WS_H), ss_in};
                pg8::gemm_phase<pg8::EpiSwiglu, pg8::StaticOrder, true, true>(F.lds + RING_OFF, g, So, E);
            }
#endif
#if PH_PLAIN
            if (type != 0) {
                const int N = (type == 1) ? QKVD : 2 * DRNN;
                const bf16* Wt = (type == 1) ? (const bf16*)(args.ws + WS_WQKV + p6 * SZ_WQKV) : (const bf16*)(args.ws + WS_WIN + p6 * SZ_WIN);
                bf16* Out = (type == 1) ? (bf16*)(args.ws + WS_QKV) : (bf16*)(args.ws + WS_U);
                pg8::Gemm g{XB, Wt, S, N, DM}; pg8::StaticOrder So; So.init(S, N, F.G, (int)blockIdx.x);
                pg8::EpiPlain E{Out, N, ss_in};
                pg8::gemm_phase<pg8::EpiPlain, pg8::StaticOrder, true, true>(F.lds + RING_OFF, g, So, E);
            }
#endif
            SEAM(pb);
        }
        if (type == 1) {
#if PH_ROPE
            if (IN(pb + 1)) { rope_phase(F, args.in[6] + p6 * 128, args.in[7] + p6 * 128); SEAM(pb + 1); }
#endif
#if PH_ATT
            if (IN(pb + 2)) { attn_phase(F, (char*)lds + RING_OFF); SEAM(pb + 2); }
#endif
        } else if (type == 2) {
            const RecArgs R{(const bf16*)(args.ws + WS_U), (const bf16*)(args.ws + WS_WG) + (size_t)p6 * (4 * 16 * 16384), args.in[14] + p6 * 4 * DRNN, args.in[15] + p6 * 2 * DRNN,
                            args.in[11] + p6 * 4 * DRNN, args.in[12] + p6 * DRNN, (float2*)(args.ws + WS_AGGS), (float2*)(args.ws + WS_AGGC), (bf16*)(args.ws + WS_Y)};
#if PH_REC1
            if (IN(pb + 1)) { rec_pass<1>(F, (char*)lds + RING_OFF, R); SEAM(pb + 1); }
#endif
#if PH_REC2
            if (IN(pb + 2)) { rec_pass<2>(F, (char*)lds + RING_OFF, R); SEAM(pb + 2); }
#endif
        }
#if PH_RES
        if (IN(pb + 3)) {
            const bf16* A = (type == 0) ? (const bf16*)(args.ws + WS_H) : (type == 1) ? (const bf16*)(args.ws + WS_O) : (const bf16*)(args.ws + WS_Y);
            const bf16* Wt = (type == 0) ? (const bf16*)(args.ws + WS_WD + f * SZ_WD) : (type == 1) ? (const bf16*)(args.ws + WS_WO + p6 * SZ_WO) : (const bf16*)(args.ws + WS_WOUT + p6 * SZ_WOUT);
            const int K = (type == 0) ? DFF : DM;
            pg8::Gemm g{A, Wt, S, DM, K}; pg8::StaticOrder So; So.init(S, DM, F.G, (int)blockIdx.x);
            pg8::EpiResid E{sb == 0 ? args.in[0] : (const float*)args.out, args.out, XB, ss_out, type == 0 ? 0.5f : 1.0f};
            pg8::gemm_phase<pg8::EpiResid, pg8::StaticOrder, true, true>(F.lds + RING_OFF, g, So, E);
            SEAM(pb + 3);
        }
#endif
    }
#if PH_FN
    if (IN(N_PHASES - 1)) final_norm_phase(F, args.out, ssb + (size_t)NSB * S, args.in[17]);
#endif
#undef IN
#undef SEAM
}

extern "C" void kernel_launch(void* const* d_in, const int* in_sizes, int n_in, void* d_out, int out_size, void* d_ws, size_t ws_size, hipStream_t stream) {
    static int grid = 0;
    if (grid == 0) {
        if (n_in != 18 || in_sizes[0] != S * DM || out_size != S * DM || ws_size < WS_END) { fprintf(stderr, "kernel_launch: shape mismatch: n_in %d in0 %d out %d ws %zu (need %zu)\n", n_in, n_in > 0 ? in_sizes[0] : -1, out_size, ws_size, (size_t)WS_END); grid = -1; return; }
        int dev = 0, cus = 0, per_cu = 0;
        if (hipGetDevice(&dev) != hipSuccess || hipDeviceGetAttribute(&cus, hipDeviceAttributeMultiprocessorCount, dev) != hipSuccess) { fprintf(stderr, "kernel_launch: device query failed\n"); grid = -1; return; }
        if (hipFuncSetAttribute((const void*)mega_fwd, hipFuncAttributeMaxDynamicSharedMemorySize, LDS_BYTES) != hipSuccess) { fprintf(stderr, "kernel_launch: hipFuncSetAttribute failed\n"); grid = -1; return; }
        if (hipOccupancyMaxActiveBlocksPerMultiprocessor(&per_cu, (const void*)mega_fwd, NWAVES * 64, LDS_BYTES) != hipSuccess || per_cu < 1) { fprintf(stderr, "kernel_launch: occupancy query says %d blocks per CU\n", per_cu); }
        (void)hipGetLastError();
        grid = cus;
    }
    if (grid < 0) return;
    if (hipMemsetAsync((char*)d_ws + WS_CTL, 0, CTL_ZERO_BYTES, stream) != hipSuccess) { fprintf(stderr, "kernel_launch: memset failed\n"); return; }
    Args a{};
    for (int i = 0; i < 18; ++i) a.in[i] = (const float*)d_in[i];
    a.out = (float*)d_out; a.ws = (unsigned char*)d_ws;
#if MK_MULTI
    for (int ph = 0; ph < N_PHASES; ++ph) {
        if (ph >= 1 && ph < N_PHASES - 1) { const int sb = (ph - 1) / 4, k = (ph - 1) % 4, k6 = sb % 6; if ((k == 1 || k == 2) && !(k6 == 1 || k6 == 4)) continue; }
        a.ph_lo = ph; a.ph_hi = ph + 1;
        hipLaunchKernelGGL(mega_fwd, dim3(grid), dim3(NWAVES * 64), LDS_BYTES, stream, a);
    }
#else
    a.ph_lo = 0; a.ph_hi = N_PHASES;
    hipLaunchKernelGGL(mega_fwd, dim3(grid), dim3(NWAVES * 64), LDS_BYTES, stream, a);
#endif
    const hipError_t le = hipPeekAtLastError();
    if (le != hipSuccess) fprintf(stderr, "kernel_launch: launch failed: %s\n", hipGetErrorName(le));
}
```

```cpp
#include <hip/hip_runtime.h>
#include <hip/hip_bf16.h>
#include <cstdio>
#include <cstdint>
#define MK_MULTI 0
namespace pg8 {
#define PG8_LAS __attribute__((address_space(3)))
typedef unsigned short bf16_t;
typedef short bf16x8 __attribute__((ext_vector_type(8)));
typedef float f32x4 __attribute__((ext_vector_type(4)));
typedef unsigned u32x4 __attribute__((ext_vector_type(4)));
constexpr int BM = 256, BK = 64, HALF = 128, HTB = HALF * BK * 2  , STAGE_BYTES = 8 * HTB, NXCD = 8, WGM = 8;

__host__ __device__ __forceinline__ int lds_byte(int r, int c) { const int st = (r >> 4) * 2 + (c >> 5), rr = r & 15, cc = c & 31, ob = rr * 64 + cc * 2; return st * 1024 + (ob ^ (((ob >> 9) & 1) << 5)); }
__host__ __device__ __forceinline__ void stage_rc(int b, int& R, int& C) { const int st = b / 1024, sb = b % 1024, swz = sb ^ (((sb >> 9) & 1) << 5); R = (st >> 1) * 16 + swz / 64; C = (st & 1) * 32 + (swz % 64) / 2; }
__host__ __device__ __forceinline__ int perm32(int rho) { const int n = rho >> 4, i = rho & 15; return 8 * (i >> 2) + 4 * n + (i & 3); }

struct Unit { int pm, pn; };
struct Gemm { const bf16_t* A; const bf16_t* Bt; int M, N, K; };

struct StaticOrder {
    int nM, nN, nwg, G, c;
    __host__ __device__ void init(int M, int N, int G_, int c_) { nM = M / BM; nN = N / BM; nwg = nM * nN; G = G_; c = c_; }
    __host__ __device__ bool next(int i, Unit& u) const {
        const long L = (long)i * G + c; if (L >= nwg) return false;
        int wgid = (int)L; { const int q = nwg / NXCD, r = nwg % NXCD, xcd = wgid % NXCD, off = wgid / NXCD; wgid = (xcd < r ? xcd * (q + 1) : r * (q + 1) + (xcd - r) * q) + off; }
        const int nig = WGM * nN, gid = wgid / nig, fm = gid * WGM, gsz = (nM - fm) < WGM ? (nM - fm) : WGM;
        u.pm = fm + ((wgid % nig) % gsz); u.pn = (wgid % nig) / gsz; return true;
    }
    __device__ __forceinline__ void a_ready(const Unit&) const {}
    __device__ __forceinline__ void done(const Unit&) const {}
};
__device__ __forceinline__ unsigned cvt_pk_bf16(float lo, float hi) { unsigned r; asm volatile("v_cvt_pk_bf16_f32 %0, %1, %2" : "=v"(r) : "v"(lo), "v"(hi)); return r; }
constexpr int DM = 2048, DFF = 5632;
constexpr float RMS_EPS = 1e-6f;
typedef unsigned long long ss_t;
constexpr float SS_SCALE = 16777216.0f;
__device__ __forceinline__ float rs_from_ss(ss_t ss) { return __builtin_amdgcn_rsqf((float)ss * (1.0f / ((float)DM * SS_SCALE)) + RMS_EPS); }
__device__ __forceinline__ float silu_f(float x) { return x * __builtin_amdgcn_rcpf(1.0f + __builtin_amdgcn_exp2f(x * -1.4426950408889634f)); }
__device__ __forceinline__ u32x4 pack8(const f32x4 a, const f32x4 b) { u32x4 w; w.x = cvt_pk_bf16(a[0], a[1]); w.y = cvt_pk_bf16(a[2], a[3]); w.z = cvt_pk_bf16(b[0], b[1]); w.w = cvt_pk_bf16(b[2], b[3]); return w; }

struct EpiSwiglu {
    static constexpr bool PERM = true, AFTER_DRAIN = false;
    bf16_t* H; const ss_t* ss;
    __device__ __forceinline__ void operator()(const f32x4 (&acc)[2][2][4][2], const Unit& u, int wr, int wc, int fr, int fq) const {
        const int row0 = u.pm * BM + wr * 64 + fr, col0 = u.pn * HALF + wc * 32 + 8 * fq;
#pragma unroll
        for (int ai = 0; ai < 2; ++ai)
#pragma unroll
            for (int m = 0; m < 4; ++m) { const int r = row0 + ai * HALF + m * 16; const float rs = rs_from_ss(ss[r]);
                f32x4 h[2];
#pragma unroll
                for (int n = 0; n < 2; ++n) { const f32x4 g = acc[ai][0][m][n] * rs, v = acc[ai][1][m][n] * rs;
                    h[n] = (f32x4){silu_f(g[0]) * v[0], silu_f(g[1]) * v[1], silu_f(g[2]) * v[2], silu_f(g[3]) * v[3]}; }
                *(u32x4*)(H + (size_t)r * DFF + col0) = pack8(h[0], h[1]); }
    }
};
struct EpiPlain {
    static constexpr bool PERM = true, AFTER_DRAIN = false;
    bf16_t* O; int ldc; const ss_t* ss;
    __device__ __forceinline__ void operator()(const f32x4 (&acc)[2][2][4][2], const Unit& u, int wr, int wc, int fr, int fq) const {
        const int row0 = u.pm * BM + wr * 64 + fr, col0 = u.pn * BM + wc * 32 + 8 * fq;
#pragma unroll
        for (int ai = 0; ai < 2; ++ai)
#pragma unroll
            for (int m = 0; m < 4; ++m) { const int r = row0 + ai * HALF + m * 16; const float rs = rs_from_ss(ss[r]); bf16_t* rowp = O + (size_t)r * ldc + col0;
#pragma unroll
                for (int bj = 0; bj < 2; ++bj) *(u32x4*)(rowp + bj * HALF) = pack8(acc[ai][bj][m][0] * rs, acc[ai][bj][m][1] * rs); }
    }
};
struct EpiResid {
    static constexpr bool PERM = true, AFTER_DRAIN = false;
    const float* base; float* out; bf16_t* xb; ss_t* ssn; float alpha;
    __device__ __forceinline__ void operator()(const f32x4 (&acc)[2][2][4][2], const Unit& u, int wr, int wc, int fr, int fq) const {
        const int row0 = u.pm * BM + wr * 64 + fr, col0 = u.pn * BM + wc * 32 + 8 * fq;
#pragma unroll
        for (int ai = 0; ai < 2; ++ai)
#pragma unroll
            for (int m = 0; m < 4; ++m) { const int r = row0 + ai * HALF + m * 16; const size_t off = (size_t)r * DM + col0; float q = 0.f;
#pragma unroll
                for (int bj = 0; bj < 2; ++bj) { const f32x4 b0 = *(const f32x4*)(base + off + bj * HALF), b1 = *(const f32x4*)(base + off + bj * HALF + 4);
                    const f32x4 x0 = b0 + acc[ai][bj][m][0] * alpha, x1 = b1 + acc[ai][bj][m][1] * alpha;
                    *(f32x4*)(out + off + bj * HALF) = x0; *(f32x4*)(out + off + bj * HALF + 4) = x1;
                    *(u32x4*)(xb + off + bj * HALF) = pack8(x0, x1);
                    q += (x0[0] * x0[0] + x0[1] * x0[1]) + (x0[2] * x0[2] + x0[3] * x0[3]) + (x1[0] * x1[0] + x1[1] * x1[1]) + (x1[2] * x1[2] + x1[3] * x1[3]); }
                q += __shfl_xor(q, 16); q += __shfl_xor(q, 32);
                if (fq == 0) __hip_atomic_fetch_add(ssn + r, (ss_t)(q * SS_SCALE), __ATOMIC_RELAXED, __HIP_MEMORY_SCOPE_AGENT);
                if (m & 1) asm volatile("" ::: "memory"); }
    }
};

template <class Epi, class Sched, bool ALIGN_EPI = false, bool SP2 = false>
__device__ __forceinline__ void gemm_phase(PG8_LAS unsigned char* lds, const Gemm g, const Sched& S, const Epi& E) {
    int tid_ = threadIdx.x; asm volatile("" : "+v"(tid_));
    const int tid = tid_, wid = __builtin_amdgcn_readfirstlane(tid >> 6), lane = tid & 63, wr = wid >> 2, wc = wid & 3, fr = lane & 15, fq = lane >> 4;
    const int K = g.K, nt = K / BK;
    unsigned voffA[2], voffB[2];
#pragma unroll
    for (int i = 0; i < 2; ++i) { int R, C; stage_rc(tid * 16 + i * 8192, R, C); const int Rb = Epi::PERM ? ((R & ~31) + perm32(R & 31)) : R;
        voffA[i] = (unsigned)(R * K + C) * 2u; voffB[i] = (unsigned)(Rb * K + C) * 2u; }
    const size_t kstep = (size_t)(BK * 2);
    const size_t hstep = (size_t)HALF * K * 2;
    const size_t tstep = 2 * hstep;
    const unsigned ldsw = (unsigned)wid * 1024u;
    const int aoff = lds_byte(wr * 64 + fr, fq * 8), boff = lds_byte(wc * 32 + fr, fq * 8);
#define PG8_SA(b, h) (((b) * 2 + (h)) * HTB)
#define PG8_SB(b, h) ((4 + (b) * 2 + (h)) * HTB)
#define PG8_STAGE(bufoff, gbase, voff) do { _Pragma("unroll") for (int _i = 0; _i < 2; ++_i) \
        __builtin_amdgcn_global_load_lds((const unsigned*)((const char*)(gbase) + (voff)[_i]), (PG8_LAS unsigned*)(lds + (bufoff) + ldsw + _i * 8192), 16, 0, 0); } while (0)
#define PG8_LDA(dst, b, h) do { _Pragma("unroll") for (int m = 0; m < 4; ++m) _Pragma("unroll") for (int k = 0; k < 2; ++k) dst[m][k] = *(const PG8_LAS bf16x8*)(lds + PG8_SA(b, h) + aoff + m * 2048 + k * 1024); } while (0)
#define PG8_LDB(dst, b, h) do { _Pragma("unroll") for (int n = 0; n < 2; ++n) _Pragma("unroll") for (int k = 0; k < 2; ++k) dst[n][k] = *(const PG8_LAS bf16x8*)(lds + PG8_SB(b, h) + boff + n * 2048 + k * 1024); } while (0)
#define PG8_MMA(ai, bj, At, Bt) do { __builtin_amdgcn_s_setprio(1); _Pragma("unroll") for (int m = 0; m < 4; ++m) _Pragma("unroll") for (int n = 0; n < 2; ++n) _Pragma("unroll") for (int k = 0; k < 2; ++k) \
        acc[ai][bj][m][n] = __builtin_amdgcn_mfma_f32_16x16x32_bf16(Bt[n][k], At[m][k], acc[ai][bj][m][n], 0, 0, 0); __builtin_amdgcn_s_setprio(0); } while (0)
#define PG8_WAIT_V(n) asm volatile("s_waitcnt vmcnt(" #n ")" ::: "memory")
#define PG8_WAIT_L(n) asm volatile("s_waitcnt lgkmcnt(" #n ")" ::: "memory")
#define PG8_BAR __builtin_amdgcn_s_barrier()
#define PG8_SCHED __builtin_amdgcn_sched_barrier(0)
    Unit cur, nxt; int ui = 0;
    if (!S.next(0, cur)) return;
    f32x4 acc[2][2][4][2];
#pragma unroll
    for (int a = 0; a < 2; ++a)
#pragma unroll
        for (int b = 0; b < 2; ++b)
#pragma unroll
            for (int m = 0; m < 4; ++m)
#pragma unroll
                for (int n = 0; n < 2; ++n) acc[a][b][m][n] = (f32x4){0.f, 0.f, 0.f, 0.f};
    bf16x8 At[4][2], B0[2][2], B1[2][2];
    const char* cA = (const char*)g.A + (size_t)cur.pm * tstep; const char* cB = (const char*)g.Bt + (size_t)cur.pn * tstep;
    S.a_ready(cur);
    if constexpr (SP2) {
        PG8_STAGE(PG8_SB(0, 0), cB, voffB); PG8_STAGE(PG8_SB(0, 1), cB + hstep, voffB); PG8_STAGE(PG8_SA(0, 0), cA, voffA); PG8_STAGE(PG8_SA(0, 1), cA + hstep, voffA);
        if (wr == 1) PG8_BAR;
        PG8_WAIT_V(2); PG8_BAR;
        PG8_STAGE(PG8_SB(1, 0), cB + kstep, voffB); PG8_STAGE(PG8_SA(1, 0), cA + kstep, voffA); PG8_STAGE(PG8_SB(1, 1), cB + hstep + kstep, voffB);
        PG8_WAIT_V(6); PG8_BAR;
    } else {
        PG8_STAGE(PG8_SB(0, 0), cB, voffB); PG8_STAGE(PG8_SA(0, 0), cA, voffA); PG8_STAGE(PG8_SB(0, 1), cB + hstep, voffB); PG8_STAGE(PG8_SA(0, 1), cA + hstep, voffA);
        if (wr == 1) PG8_BAR;
        PG8_WAIT_V(4); PG8_BAR;
        PG8_STAGE(PG8_SB(1, 0), cB + kstep, voffB); PG8_STAGE(PG8_SA(1, 0), cA + kstep, voffA); PG8_STAGE(PG8_SB(1, 1), cB + hstep + kstep, voffB);
        PG8_WAIT_V(6); PG8_BAR;
    }
    for (;;) {
        const bool has_next = S.next(ui + 1, nxt);
        const char* nA = has_next ? (const char*)g.A + (size_t)nxt.pm * tstep : cA; const char* nB = has_next ? (const char*)g.Bt + (size_t)nxt.pn * tstep : cB;
        for (int t = 0; t < nt; t += 2) {
            const bool last = (t == nt - 2);
            const char* a1 = cA + (size_t)(t + 1) * kstep;
            const char* a2 = last ? nA : cA + (size_t)(t + 2) * kstep; const char* b2 = last ? nB : cB + (size_t)(t + 2) * kstep;
            const char* a3 = a2 + kstep; const char* b3 = b2 + kstep;
            if (last && has_next) S.a_ready(nxt);
            if constexpr (SP2) {
            PG8_LDB(B0, 0, 0); PG8_LDB(B1, 0, 1); PG8_SCHED; PG8_LDA(At, 0, 0); PG8_STAGE(PG8_SA(1, 1), a1 + hstep, voffA);
            PG8_WAIT_V(8); PG8_WAIT_L(0); PG8_BAR; PG8_MMA(0, 0, At, B0); PG8_MMA(0, 1, At, B1); PG8_BAR; PG8_SCHED;
            PG8_LDA(At, 0, 1); PG8_STAGE(PG8_SB(0, 0), b2, voffB); PG8_STAGE(PG8_SB(0, 1), b2 + hstep, voffB); PG8_STAGE(PG8_SA(0, 0), a2, voffA);
            PG8_WAIT_V(8); PG8_WAIT_L(0); PG8_BAR; PG8_MMA(1, 0, At, B0); PG8_MMA(1, 1, At, B1); PG8_BAR; PG8_SCHED;
            PG8_LDB(B0, 1, 0); PG8_LDB(B1, 1, 1); PG8_SCHED; PG8_LDA(At, 1, 0); PG8_STAGE(PG8_SA(0, 1), a2 + hstep, voffA);
            PG8_WAIT_V(8); PG8_WAIT_L(0); PG8_BAR; PG8_MMA(0, 0, At, B0); PG8_MMA(0, 1, At, B1); PG8_BAR; PG8_SCHED;
            PG8_LDA(At, 1, 1); PG8_STAGE(PG8_SB(1, 0), b3, voffB); PG8_STAGE(PG8_SB(1, 1), b3 + hstep, voffB); PG8_STAGE(PG8_SA(1, 0), a3, voffA);
            PG8_WAIT_V(8); PG8_WAIT_L(0); PG8_BAR; PG8_MMA(1, 0, At, B0); PG8_MMA(1, 1, At, B1); PG8_BAR; PG8_SCHED;
            } else {
            PG8_LDB(B0, 0, 0); PG8_SCHED; PG8_LDA(At, 0, 0); PG8_STAGE(PG8_SA(1, 1), a1 + hstep, voffA);
            PG8_WAIT_L(8); PG8_BAR; PG8_WAIT_L(0); PG8_MMA(0, 0, At, B0); PG8_BAR; PG8_SCHED;
            PG8_LDB(B1, 0, 1); PG8_STAGE(PG8_SB(0, 0), b2, voffB);
            PG8_BAR; PG8_WAIT_L(0); PG8_MMA(0, 1, At, B1); PG8_BAR;
            PG8_LDA(At, 0, 1); PG8_STAGE(PG8_SA(0, 0), a2, voffA);
            PG8_BAR; PG8_WAIT_L(0); PG8_MMA(1, 0, At, B0); PG8_BAR; PG8_SCHED;
            PG8_STAGE(PG8_SB(0, 1), b2 + hstep, voffB);
            PG8_WAIT_V(6); PG8_BAR; PG8_MMA(1, 1, At, B1); PG8_BAR;
            PG8_LDB(B0, 1, 0); PG8_SCHED; PG8_LDA(At, 1, 0); PG8_STAGE(PG8_SA(0, 1), a2 + hstep, voffA);
            PG8_WAIT_L(8); PG8_BAR; PG8_WAIT_L(0); PG8_MMA(0, 0, At, B0); PG8_BAR; PG8_SCHED;
            PG8_LDB(B1, 1, 1); PG8_STAGE(PG8_SB(1, 0), b3, voffB);
            PG8_BAR; PG8_WAIT_L(0); PG8_MMA(0, 1, At, B1); PG8_BAR;
            PG8_LDA(At, 1, 1); PG8_STAGE(PG8_SA(1, 0), a3, voffA);
            PG8_BAR; PG8_WAIT_L(0); PG8_MMA(1, 0, At, B0); PG8_BAR; PG8_SCHED;
            PG8_STAGE(PG8_SB(1, 1), b3 + hstep, voffB);
            PG8_WAIT_V(6); PG8_BAR; PG8_MMA(1, 1, At, B1); PG8_BAR;
            }
        }
        if constexpr (ALIGN_EPI) { if (wr == 0) PG8_BAR; }
        if constexpr (!Epi::AFTER_DRAIN) { E(acc, cur, wr, wc, fr, fq); S.done(cur); }
        if (!has_next) break;
#pragma unroll
        for (int a = 0; a < 2; ++a)
#pragma unroll
            for (int b = 0; b < 2; ++b)
#pragma unroll
                for (int m = 0; m < 4; ++m)
#pragma unroll
                    for (int n = 0; n < 2; ++n) acc[a][b][m][n] = (f32x4){0.f, 0.f, 0.f, 0.f};
        cur = nxt; cA = nA; cB = nB; ++ui;
        if constexpr (ALIGN_EPI) { if (wr == 1) PG8_BAR; }
    }
    PG8_WAIT_V(0);
    if constexpr (!ALIGN_EPI) { if (wr == 0) PG8_BAR; }
    PG8_BAR;
    if constexpr (Epi::AFTER_DRAIN) { E.fused(acc, cur, wr, wc, fr, fq, lds, wid, lane); S.done(cur); }
#undef PG8_SA
#undef PG8_SB
#undef PG8_STAGE
#undef PG8_LDA
#undef PG8_LDB
#undef PG8_MMA
#undef PG8_WAIT_V
#undef PG8_WAIT_L
#undef PG8_BAR
#undef PG8_SCHED
}
}
namespace att {
using bf16 = __hip_bfloat16;
constexpr int   D = 128, NW = 8, QBLK = 32, KVBLK = 64;
constexpr float SCALE = 0.088388347648318440f;
constexpr float THR = 8.f;
constexpr int   SDEPTH = 2;
constexpr int   LDQ = 3072, LDK = 3072, LDO = 2048;
constexpr size_t SHM_V = KVBLK * D * 2, SHM_K = KVBLK * D * 2, SHM_ATTN = 2 * SHM_V + 2 * SHM_K + NW * 64 * 4;
using bf16x8 = __attribute__((ext_vector_type(8))) short;
using s16x4  = __attribute__((ext_vector_type(4))) short;
using f32x16 = __attribute__((ext_vector_type(16))) float;
using u32x4  = __attribute__((ext_vector_type(4))) unsigned;
#define KSWZ(row, colB) ((row) * 256 + ((colB) ^ (((row) & 7) << 4)))
#define SBAR() __builtin_amdgcn_sched_barrier(0)
__device__ __forceinline__ int crow(int r, int hi) { return (r & 3) + 8 * (r >> 2) + 4 * hi; }
__device__ __forceinline__ unsigned cvtpk(float lo, float hi) {
  unsigned r; asm volatile("v_cvt_pk_bf16_f32 %0, %1, %2" : "=v"(r) : "v"(lo), "v"(hi)); return r;
}

__device__ __forceinline__ void partialSM(f32x16& p0, f32x16& p1, float& m_reg, float& mn, float& alpha) {
  constexpr float C = SCALE * 1.4426950408889634f;
  float pmax = p0[0]; for (int r = 1; r < 16; ++r) pmax = fmaxf(pmax, p0[r]); for (int r = 0; r < 16; ++r) pmax = fmaxf(pmax, p1[r]);
  { auto rr = __builtin_amdgcn_permlane32_swap(__float_as_uint(pmax), __float_as_uint(pmax), false, false);
    pmax = fmaxf(__uint_as_float(rr[0]), __uint_as_float(rr[1])); }
  if (__builtin_expect(__all(pmax - m_reg <= THR / SCALE), 1)) { mn = m_reg; alpha = 1.f; }
  else { mn = fmaxf(m_reg, pmax); alpha = __builtin_amdgcn_exp2f((m_reg - mn) * C); m_reg = mn; }
  float mnC = -mn * C;
  for (int r = 0; r < 16; ++r) p0[r] = fmaf(p0[r], C, mnC); for (int r = 0; r < 16; ++r) p1[r] = fmaf(p1[r], C, mnC);
  for (int r = 0; r < 16; ++r) p0[r] = __builtin_amdgcn_exp2f(p0[r]);
}
__device__ __forceinline__ void finishSM(f32x16& p0, f32x16& p1, float alpha, float& l_reg, bf16x8& pa0, bf16x8& pa1, bf16x8& pa2, bf16x8& pa3) {
  for (int r = 0; r < 16; ++r) p1[r] = __builtin_amdgcn_exp2f(p1[r]);
  float ps = 0; for (int r = 0; r < 16; ++r) ps += p0[r]; for (int r = 0; r < 16; ++r) ps += p1[r];
  { auto rr = __builtin_amdgcn_permlane32_swap(__float_as_uint(ps), __float_as_uint(ps), false, false);
    ps = __uint_as_float(rr[0]) + __uint_as_float(rr[1]); }
  l_reg = l_reg * alpha + ps;
#define PK4(P, BASE, OUT) do { unsigned a0 = cvtpk(P[BASE + 0], P[BASE + 1]), a1 = cvtpk(P[BASE + 2], P[BASE + 3]);   \
    unsigned b0 = cvtpk(P[BASE + 4], P[BASE + 5]), b1 = cvtpk(P[BASE + 6], P[BASE + 7]);                              \
    auto r0 = __builtin_amdgcn_permlane32_swap(a0, b0, false, false); auto r1 = __builtin_amdgcn_permlane32_swap(a1, b1, false, false); \
    u32x4 w = {r0[0], r1[0], r0[1], r1[1]}; OUT = *reinterpret_cast<bf16x8*>(&w); } while (0)
  PK4(p0, 0, pa0); PK4(p0, 8, pa1); PK4(p1, 0, pa2); PK4(p1, 8, pa3);
#undef PK4
}
__device__ __forceinline__ void qkt(f32x16& p0, f32x16& p1, const bf16* Ks, const bf16x8* qr, int r32, int hi) {
  p0 = f32x16{}; p1 = f32x16{};
  for (int d0 = 0; d0 < 8; ++d0) { int cb = (d0 * 16 + hi * 8) * 2;
    bf16x8 b0 = *reinterpret_cast<const bf16x8*>((const char*)Ks + KSWZ(r32, cb));
    bf16x8 b1 = *reinterpret_cast<const bf16x8*>((const char*)Ks + KSWZ(32 + r32, cb));
    p0 = __builtin_amdgcn_mfma_f32_32x32x16_bf16(b0, qr[d0], p0, 0, 0, 0);
    p1 = __builtin_amdgcn_mfma_f32_32x32x16_bf16(b1, qr[d0], p1, 0, 0, 0); }
}
__device__ __forceinline__ int v_st(int k, int c) { const int kk = (k & ~0xC) | ((k & 4) << 1) | ((k & 8) >> 1); return ((kk >> 3) * 4 + (c >> 5)) * 512 + ((kk & 7) * 32 + (c & 31)) * 2; }
__device__ __forceinline__ int v_rd_base(int lane) { return ((lane & 3) << 3) | (((lane >> 2) & 3) << 6) | (((lane >> 4) & 1) << 5) | (((lane >> 5) & 1) << 8); }
constexpr int v_rd_off(int d0, int ks, int half) { return d0 * 512 + ks * 4096 + half * 2048; }
template <int OFF> __device__ __forceinline__ s16x4 tr_read(int vb) {
  s16x4 r; asm volatile("ds_read_b64_tr_b16 %0, %1 offset:%2" : "=&v"(r) : "v"(vb), "i"(OFF) : "memory"); return r;
}
template <int D0> __device__ __forceinline__ void pv_one(f32x16& od, int vb, bf16x8 pa0, bf16x8 pa1, bf16x8 pa2, bf16x8 pa3) {
  const s16x4 l0 = tr_read<v_rd_off(D0, 0, 0)>(vb), h0 = tr_read<v_rd_off(D0, 0, 1)>(vb), l1 = tr_read<v_rd_off(D0, 1, 0)>(vb), h1 = tr_read<v_rd_off(D0, 1, 1)>(vb);
  const s16x4 l2 = tr_read<v_rd_off(D0, 2, 0)>(vb), h2 = tr_read<v_rd_off(D0, 2, 1)>(vb), l3 = tr_read<v_rd_off(D0, 3, 0)>(vb), h3 = tr_read<v_rd_off(D0, 3, 1)>(vb);
  asm volatile("s_waitcnt lgkmcnt(0)" ::: "memory"); SBAR();
#define PK(L, H) (bf16x8){L[0], L[1], L[2], L[3], H[0], H[1], H[2], H[3]}
  od = __builtin_amdgcn_mfma_f32_32x32x16_bf16(pa0, PK(l0, h0), od, 0, 0, 0);
  od = __builtin_amdgcn_mfma_f32_32x32x16_bf16(pa1, PK(l1, h1), od, 0, 0, 0);
  od = __builtin_amdgcn_mfma_f32_32x32x16_bf16(pa2, PK(l2, h2), od, 0, 0, 0);
  od = __builtin_amdgcn_mfma_f32_32x32x16_bf16(pa3, PK(l3, h3), od, 0, 0, 0);
#undef PK
}
__device__ __forceinline__ void pv_d0(f32x16* o, int vb, bf16x8 pa0, bf16x8 pa1, bf16x8 pa2, bf16x8 pa3) {
  pv_one<0>(o[0], vb, pa0, pa1, pa2, pa3); pv_one<1>(o[1], vb, pa0, pa1, pa2, pa3); pv_one<2>(o[2], vb, pa0, pa1, pa2, pa3); pv_one<3>(o[3], vb, pa0, pa1, pa2, pa3);
}
__device__ __forceinline__ void attn_dense_body(const bf16* __restrict__ Qb, const bf16* __restrict__ Kh, const bf16* __restrict__ Vh, bf16* __restrict__ Ob, int seq, char* lds) {
  int tid_ = threadIdx.x; asm volatile("" : "+v"(tid_));
  const int tid = tid_, wid = tid >> 6, lane = tid & 63, r32 = lane & 31, hi = lane >> 5;
  bf16* V_lds = (bf16*)lds; bf16* K_lds = (bf16*)(lds + 2 * SHM_V);
  float* ws = (float*)(lds + 2 * SHM_V + 2 * SHM_K) + wid * 64; float* li_l = ws; float* al_l = ws + 32;
  float m_reg = -1e30f, l_reg = 0; f32x16 o[4] = {}; bf16x8 qr[8];
  const bf16* Qw = Qb + (long)(wid * QBLK + r32) * LDQ + hi * 8;
#pragma unroll
  for (int d0 = 0; d0 < 8; ++d0) qr[d0] = *reinterpret_cast<const bf16x8*>(Qw + d0 * 16);
  const int sr = tid >> 4, sc = (tid & 15) * 8, vst0 = v_st(sr, sc), vst1 = v_st(32 + sr, sc);
  const int vb0 = (int)(uintptr_t)V_lds + v_rd_base(lane);
  struct { bf16x8 vs0, vs1, ks0, ks1; } sr_[SDEPTH];
#define SLOAD(i, k0) do { sr_[i].vs0 = *reinterpret_cast<const bf16x8*>(&Vh[(long)((k0) + sr) * LDK + sc]); sr_[i].vs1 = *reinterpret_cast<const bf16x8*>(&Vh[(long)((k0) + 32 + sr) * LDK + sc]); \
    sr_[i].ks0 = *reinterpret_cast<const bf16x8*>(&Kh[(long)((k0) + sr) * LDK + sc]); sr_[i].ks1 = *reinterpret_cast<const bf16x8*>(&Kh[(long)((k0) + 32 + sr) * LDK + sc]); } while (0)
#define SWRITE(b, i) do { *(bf16x8*)((char*)V_lds + (b) * SHM_V + vst0) = sr_[i].vs0;          \
    *(bf16x8*)((char*)V_lds + (b) * SHM_V + vst1) = sr_[i].vs1; int kc = sc * 2;               \
    *(bf16x8*)((char*)K_lds + (b) * SHM_K + KSWZ(sr, kc)) = sr_[i].ks0;                       \
    *(bf16x8*)((char*)K_lds + (b) * SHM_K + KSWZ(32 + sr, kc)) = sr_[i].ks1; } while (0)
#define SWAIT() do { asm volatile("s_waitcnt vmcnt(4)" ::: "memory"); } while (0)
#define RESC(a) do { if (__any((a) < 1.f)) { if (hi == 0) al_l[r32] = (a); asm volatile("s_waitcnt lgkmcnt(0)" ::: "memory"); \
    for (int d = 0; d < 4; ++d) for (int r = 0; r < 16; ++r) o[d][r] *= al_l[crow(r, hi)]; } } while (0)
  f32x16 pA0, pA1, pB0, pB1; float mnA, mnB, alA, alB; bf16x8 pa0, pa1, pa2, pa3; const int NT = seq / KVBLK;
  constexpr int SE = 0, SO = SDEPTH - 1;
  SLOAD(SE, 0); asm volatile("s_waitcnt vmcnt(0)" ::: "memory"); SWRITE(0, SE); __syncthreads();
  qkt(pA0, pA1, K_lds, qr, r32, hi); partialSM(pA0, pA1, m_reg, mnA, alA);
  SLOAD(SO, KVBLK); if (2 < NT) SLOAD(SE, 2 * KVBLK);
  SWAIT(); SWRITE(1, SO); __syncthreads();
  for (int j = 1; j + 1 < NT; j += 2) {
    SBAR(); qkt(pB0, pB1, (bf16*)((char*)K_lds + SHM_K), qr, r32, hi);
    finishSM(pA0, pA1, alA, l_reg, pa0, pa1, pa2, pa3); SBAR();
    SLOAD(SO, (j + SDEPTH) * KVBLK); SBAR();
    pv_d0(o, vb0, pa0, pa1, pa2, pa3); partialSM(pB0, pB1, m_reg, mnB, alB);
    __syncthreads(); SWAIT(); SWRITE(0, SE);
    RESC(alB); __syncthreads();
    SBAR(); qkt(pA0, pA1, K_lds, qr, r32, hi);
    finishSM(pB0, pB1, alB, l_reg, pa0, pa1, pa2, pa3); SBAR();
    if (j + 3 < NT) SLOAD(SE, (j + 1 + SDEPTH) * KVBLK); SBAR();
    pv_d0(o, vb0 + (int)SHM_V, pa0, pa1, pa2, pa3); partialSM(pA0, pA1, m_reg, mnA, alA);
    __syncthreads(); SWAIT(); SWRITE(1, SO);
    RESC(alA); __syncthreads();
  }
  SBAR(); qkt(pB0, pB1, (bf16*)((char*)K_lds + SHM_K), qr, r32, hi);
  finishSM(pA0, pA1, alA, l_reg, pa0, pa1, pa2, pa3); SBAR();
  pv_d0(o, vb0, pa0, pa1, pa2, pa3); partialSM(pB0, pB1, m_reg, mnB, alB);
  __syncthreads(); RESC(alB);
  finishSM(pB0, pB1, alB, l_reg, pa0, pa1, pa2, pa3); SBAR();
  pv_d0(o, vb0 + (int)SHM_V, pa0, pa1, pa2, pa3);
  if (hi == 0) li_l[r32] = l_reg; asm volatile("s_waitcnt lgkmcnt(0)" ::: "memory");
  float rli[16];
#pragma unroll
  for (int r = 0; r < 16; ++r) rli[r] = __builtin_amdgcn_rcpf(li_l[crow(r, hi)]);
  asm volatile("s_waitcnt vmcnt(0) lgkmcnt(0)" ::: "memory");
  __syncthreads();
  char* ost = lds + wid * 8192;
#pragma unroll
  for (int r = 0; r < 16; r += 2) { const int row_a = crow(r, hi), row_b = crow(r + 1, hi);
#pragma unroll
    for (int d0 = 0; d0 < 4; ++d0) { const unsigned w = cvtpk(o[d0][r] * rli[r], o[d0][r + 1] * rli[r + 1]);
      *(unsigned short*)(ost + row_a * 256 + (d0 * 32 + r32) * 2) = (unsigned short)(w & 0xffffu);
      *(unsigned short*)(ost + row_b * 256 + (d0 * 32 + r32) * 2) = (unsigned short)(w >> 16); } }
  asm volatile("s_waitcnt lgkmcnt(0)" ::: "memory");
  bf16* Ow = Ob + (long)(wid * QBLK) * LDO;
#pragma unroll
  for (int i = 0; i < 8; ++i) { const int idx = lane + 64 * i, row = idx >> 4, c16 = idx & 15;
    const u32x4 v = *(const u32x4*)(ost + row * 256 + c16 * 16); *(u32x4*)(Ow + (long)row * LDO + c16 * 8) = v; }
  asm volatile("s_waitcnt lgkmcnt(0)" ::: "memory");
  __syncthreads();
#undef SLOAD
#undef SWRITE
#undef SWAIT
#undef RESC
}
#undef KSWZ
#undef SBAR
}

constexpr int NWAVES = 8;
#ifndef MK_MULTI
#define MK_MULTI 0
#endif

#ifndef PH_P0
#define PH_P0 1
#endif
#ifndef PH_GU
#define PH_GU 1
#endif
#ifndef PH_PLAIN
#define PH_PLAIN 1
#endif
#ifndef PH_ROPE
#define PH_ROPE 1
#endif
#ifndef PH_ATT
#define PH_ATT 1
#endif
#ifndef PH_REC1
#define PH_REC1 1
#endif
#ifndef PH_REC2
#define PH_REC2 1
#endif
#ifndef PH_RES
#define PH_RES 1
#endif
#ifndef PH_FN
#define PH_FN 1
#endif
constexpr int S = 8192, DM = 2048, DFF = 5632, NGU = 2 * DFF, QKVD = 3072, DRNN = 2048, NFFN = 8, NSB = 12;
constexpr int N_PHASES = 2 + 4 * NSB;
constexpr float NORM_EPS = 1e-6f;

constexpr size_t MiB = 1u << 20;
constexpr size_t WS_CTL = 0, CTL_ZERO_BYTES = 2 * MiB;
constexpr size_t WS_SS = 1 * MiB;
constexpr size_t WS_ROPE = 2 * MiB;
constexpr size_t WS_WG = 3 * MiB;
constexpr size_t WS_AGGS = 7 * MiB;
constexpr size_t WS_AGGC = 15 * MiB;
constexpr size_t WS_WGU = 16 * MiB, SZ_WGU = (size_t)NGU * DM * 2;
constexpr size_t WS_WD = WS_WGU + NFFN * SZ_WGU, SZ_WD = (size_t)DM * DFF * 2;
constexpr size_t WS_WQKV = WS_WD + NFFN * SZ_WD, SZ_WQKV = (size_t)QKVD * DM * 2;
constexpr size_t WS_WO = WS_WQKV + 2 * SZ_WQKV, SZ_WO = (size_t)DM * DM * 2;
constexpr size_t WS_WIN = WS_WO + 2 * SZ_WO, SZ_WIN = (size_t)2 * DRNN * DM * 2;
constexpr size_t WS_WOUT = WS_WIN + 2 * SZ_WIN, SZ_WOUT = (size_t)DM * DRNN * 2;
constexpr size_t WS_XB = WS_WOUT + 2 * SZ_WOUT;
constexpr size_t WS_H = WS_XB + (size_t)S * DM * 2;
constexpr size_t WS_QKV = WS_H + (size_t)S * DFF * 2;
constexpr size_t WS_O = WS_QKV + (size_t)S * QKVD * 2;
constexpr size_t WS_U = WS_O + (size_t)S * DM * 2;
constexpr size_t WS_Y = WS_U + (size_t)S * 2 * DRNN * 2;
constexpr size_t WS_END = WS_Y + (size_t)S * DRNN * 2;
static_assert(WS_WG + 128 * 16384 * 2 <= WS_AGGS && WS_AGGS + 256 * 2 * 2048 * 8 <= WS_AGGC && WS_AGGC + 16 * 2 * 2048 * 8 <= WS_WGU, "small tables do not overlap");
static_assert(WS_SS + 13 * (size_t)S * 8 <= CTL_ZERO_BYTES, "ss arrays inside the memset region");
static_assert(WS_WGU % 256 == 0 && WS_XB % 256 == 0 && WS_H % 256 == 0 && WS_QKV % 256 == 0 && WS_O % 256 == 0 && WS_U % 256 == 0 && WS_Y % 256 == 0, "alignment");
constexpr int CW_BAR = 4096;

constexpr int RING_OFF = 0, RING_BYTES = 131072;
constexpr int LDSCTL_OFF = RING_BYTES, MISC_OFF = LDSCTL_OFF + 320;
constexpr int LDS_BYTES = 147456;
static_assert(MISC_OFF + 128 <= LDS_BYTES, "LDS map");

#define GAS __attribute__((address_space(1)))
#define LAS __attribute__((address_space(3)))
typedef unsigned short bf16;
typedef unsigned v4u __attribute__((ext_vector_type(4)));
typedef float f32x4 __attribute__((ext_vector_type(4)));
typedef short bf16x8 __attribute__((ext_vector_type(8)));
typedef GAS unsigned gu32;
#define RLX_AGENT __ATOMIC_RELAXED, __HIP_MEMORY_SCOPE_AGENT
#define LDS_WAIT() asm volatile("s_waitcnt lgkmcnt(0)" ::: "memory")
#define VM_WAIT() asm volatile("s_waitcnt vmcnt(0)" ::: "memory")
__device__ __forceinline__ unsigned f2bf(float f) { unsigned u = __builtin_bit_cast(unsigned, f); return (u + 0x7fffu + ((u >> 16) & 1u)) >> 16; }
__device__ __forceinline__ unsigned pk2(float lo, float hi) { return f2bf(lo) | (f2bf(hi) << 16); }
__device__ __forceinline__ float bf_lo(unsigned w) { return __builtin_bit_cast(float, w << 16); }
__device__ __forceinline__ float bf_hi(unsigned w) { return __builtin_bit_cast(float, w & 0xffff0000u); }

#define XB_TMO      128
#define XB_XCNT(j)  (256  + 64 * (j))
#define XB_XSUB(j)  (1280 + 64 * (j))
#define XB_XGEN(j)  (2304 + 64 * (j))
#define XB_TOP      3328
#define XB_TOPGEN   3392
#define XCD_BAR_WORDS 3456
#define XB_SPIN_CAP (1u << 18)

__device__ __forceinline__ unsigned xb_ld(unsigned* p)              { return __hip_atomic_load(p, __ATOMIC_RELAXED, __HIP_MEMORY_SCOPE_AGENT); }
__device__ __forceinline__ unsigned xb_add(unsigned* p, unsigned v) { return __hip_atomic_fetch_add(p, v, __ATOMIC_RELAXED, __HIP_MEMORY_SCOPE_AGENT); }
__device__ __forceinline__ unsigned xb_xcc_id() { return (unsigned)__builtin_amdgcn_s_getreg((3 << 11) | 20) & 0xFu; }
#define XB_SPIN(cond, bar) do { unsigned _sp = 0; while (cond) { __builtin_amdgcn_s_sleep(1); \
    if ((++_sp & 255u) == 0u) { if (xb_ld(&(bar)[XB_TMO])) break; if (_sp > XB_SPIN_CAP) { atomicAdd(&(bar)[XB_TMO], 1u); break; } } } } while (0)

struct XcdBarrier {
    unsigned* bar; unsigned x;
    volatile LAS unsigned* st;
};

__device__ __forceinline__ XcdBarrier xcd_barrier_post(unsigned* bar, volatile LAS unsigned* st) {
    XcdBarrier b; b.bar = bar; b.x = xb_xcc_id(); b.st = st;
    if (threadIdx.x == 0) (void)xb_add(&bar[XB_XCNT(b.x)], 1u);
    return b;
}
__device__ __forceinline__ void xcd_barrier_complete(unsigned* bar, unsigned x, unsigned& nloc, unsigned& nx) {
    const unsigned G = gridDim.x * gridDim.y * gridDim.z;
    unsigned sum, cnt, mine, sp = 0u;
    for (;;) {
        sum = 0u; cnt = 0u; mine = 0u;
#pragma unroll
        for (unsigned j = 0; j < 16; ++j) { const unsigned c = xb_ld(&bar[XB_XCNT(j)]); sum += c; cnt += (c > 0u) ? 1u : 0u; mine = (j == x) ? c : mine; }
        if (sum == G) break;
        __builtin_amdgcn_s_sleep(1);
        if ((++sp & 255u) == 0u) { if (xb_ld(&bar[XB_TMO])) break; if (sp > XB_SPIN_CAP) { atomicAdd(&bar[XB_TMO], 1u); break; } }
    }
    nloc = mine > 0u ? mine : 1u; nx = cnt > 0u ? cnt : 1u;
}

__device__ __forceinline__ void xcd_barrier(const XcdBarrier& b) {
    asm volatile("s_waitcnt vmcnt(0)" ::: "memory");
    __syncthreads();
    if (threadIdx.x == 0) {
        unsigned* bar = b.bar;
        __builtin_amdgcn_s_waitcnt(0);
        unsigned nloc = b.st[0], nx = b.st[1];
        if (nloc == 0u) { xcd_barrier_complete(bar, b.x, nloc, nx); b.st[0] = nloc; b.st[1] = nx; }
        const unsigned old = xb_add(&bar[XB_XSUB(b.x)], 1u);
        const unsigned gen = old / nloc;
        if (old + 1u == (gen + 1u) * nloc) {
            __builtin_amdgcn_fence(__ATOMIC_RELEASE, "agent");
            asm volatile("s_waitcnt vmcnt(0)" ::: "memory");
            const unsigned og = xb_add(&bar[XB_TOP], 1u);
            const unsigned tg = og / nx;
            if (og + 1u == (tg + 1u) * nx) xb_add(&bar[XB_TOPGEN], 1u);
            else XB_SPIN(xb_ld(&bar[XB_TOPGEN]) == tg, bar);
            __builtin_amdgcn_fence(__ATOMIC_ACQUIRE, "agent");
            xb_add(&bar[XB_XGEN(b.x)], 1u);
            asm volatile("s_waitcnt vmcnt(0)" ::: "memory");
        } else {
            XB_SPIN(xb_ld(&bar[XB_XGEN(b.x)]) == gen, bar);
            __builtin_amdgcn_fence(__ATOMIC_ACQUIRE, "agent");
            asm volatile("s_waitcnt vmcnt(0)" ::: "memory");
        }
    }
    __syncthreads();
}
#define OPAQUE_LANE() int tid_ = threadIdx.x; asm volatile("" : "+v"(tid_)); const int lane_ = tid_ & 63, wave_ = __builtin_amdgcn_readfirstlane(tid_ >> 6); (void)lane_; (void)wave_
struct Frame {
    LAS unsigned char* lds;
    volatile LAS unsigned* MISC;
    gu32* ctl;
    int tid, lane, wave;
    int vcu, G;
    unsigned char* ws;
    const float* const* in;
};
__device__ __forceinline__ float wave_sum(float v) {
#pragma unroll
    for (int o = 1; o < 64; o <<= 1) v += __shfl_xor(v, o);
    return v;
}
__device__ __forceinline__ void p0_transpose_item(const float* W, int K, int N, bf16* WT, const float* gain, int gu_mode, LAS float* scr, int item, int lane) {
    const int nblk = N / 32, kb = item / nblk, nb = item - kb * nblk, k0 = 64 * kb, n0 = 32 * nb;
#pragma unroll 8
    for (int i = 0; i < 32; ++i) { const int kk = 2 * i + (lane >> 5); float v = W[(size_t)(k0 + kk) * N + n0 + (lane & 31)]; if (gain) v *= gain[k0 + kk]; scr[kk * 33 + (lane & 31)] = v; }
    LDS_WAIT(); asm volatile("" ::: "memory");
    int d0 = n0; if (gu_mode) { const int isu = n0 >= DFF ? 1 : 0, nn = n0 - isu * DFF; d0 = (nn >> 7) * 256 + isu * 128 + (nn & 127); }
    const int c = lane & 7;
#pragma unroll
    for (int j = 0; j < 4; ++j) { const int n = (lane >> 3) + 8 * j; const LAS float* s = scr + (8 * c) * 33 + n;
        v4u o; o.x = pk2(s[0 * 33], s[1 * 33]); o.y = pk2(s[2 * 33], s[3 * 33]); o.z = pk2(s[4 * 33], s[5 * 33]); o.w = pk2(s[6 * 33], s[7 * 33]);
        *(GAS v4u*)(WT + (size_t)(d0 + n) * K + k0 + 8 * c) = o; }
    LDS_WAIT(); asm volatile("" ::: "memory");
}
__device__ __forceinline__ void sincos_acc(float ang, float& sn, float& cs) {
    const double a = (double)ang; const double kq = __builtin_rint(a * 0.63661977236758134308);
    double r = __builtin_fma(-kq, 1.5707963267948966192, a); r = __builtin_fma(-kq, 6.123233995736766036e-17, r);
    const double r2 = r * r;
    double ps = -1.0 / 1307674368000.0; ps = ps * r2 + 1.0 / 6227020800.0; ps = ps * r2 - 1.0 / 39916800.0; ps = ps * r2 + 1.0 / 362880.0; ps = ps * r2 - 1.0 / 5040.0; ps = ps * r2 + 1.0 / 120.0; ps = ps * r2 - 1.0 / 6.0; ps = ps * r2 + 1.0;
    const double s = ps * r;
    double pc = 1.0 / 20922789888000.0; pc = pc * r2 - 1.0 / 87178291200.0; pc = pc * r2 + 1.0 / 479001600.0; pc = pc * r2 - 1.0 / 3628800.0; pc = pc * r2 + 1.0 / 40320.0; pc = pc * r2 - 1.0 / 720.0; pc = pc * r2 + 1.0 / 24.0; pc = pc * r2 - 0.5; pc = pc * r2 + 1.0;
    const int q = ((int)kq) & 3;
    const double ss = (q == 0) ? s : (q == 1) ? pc : (q == 2) ? -s : -pc;
    const double cc = (q == 0) ? pc : (q == 1) ? -s : (q == 2) ? -pc : s;
    sn = (float)ss; cs = (float)cc;
}
__device__ __forceinline__ void p0_prologue(Frame& F) {
    OPAQUE_LANE();
    LAS float* scr = (LAS float*)(F.lds + RING_OFF + wave_ * 16384);
    const int gw = F.vcu * NWAVES + wave_, NGW = F.G * NWAVES;
    constexpr int I_GU = (DM / 64) * (NGU / 32), I_D = (DFF / 64) * (DM / 32), I_QKV = (DM / 64) * (QKVD / 32), I_O = (DM / 64) * (DM / 32), I_IN = (DM / 64) * (2 * DRNN / 32), I_OUT = (DRNN / 64) * (DM / 32), I_G = 8;
    constexpr int NITEMS = NFFN * (I_GU + I_D) + 2 * (I_QKV + I_O + I_IN + I_OUT) + 128 * I_G;
    for (int it = gw; it < NITEMS; it += NGW) {
        int r = it; const float* W; bf16* WT; const float* gain = nullptr; int K, N, gm = 0, item;
        if (r < NFFN * I_GU) { const int f = r / I_GU; item = r - f * I_GU; W = F.in[2] + (size_t)f * DM * NGU; K = DM; N = NGU; WT = (bf16*)(F.ws + WS_WGU + f * SZ_WGU); gain = F.in[1] + f * DM; gm = 1; }
        else if ((r -= NFFN * I_GU) < NFFN * I_D) { const int f = r / I_D; item = r - f * I_D; W = F.in[3] + (size_t)f * DFF * DM; K = DFF; N = DM; WT = (bf16*)(F.ws + WS_WD + f * SZ_WD); }
        else if ((r -= NFFN * I_D) < 2 * I_QKV) { const int l = r / I_QKV; item = r - l * I_QKV; W = F.in[5] + (size_t)l * DM * QKVD; K = DM; N = QKVD; WT = (bf16*)(F.ws + WS_WQKV + l * SZ_WQKV); gain = F.in[4] + l * DM; }
        else if ((r -= 2 * I_QKV) < 2 * I_O) { const int l = r / I_O; item = r - l * I_O; W = F.in[8] + (size_t)l * DM * DM; K = DM; N = DM; WT = (bf16*)(F.ws + WS_WO + l * SZ_WO); }
        else if ((r -= 2 * I_O) < 2 * I_IN) { const int l = r / I_IN; item = r - l * I_IN; W = F.in[10] + (size_t)l * DM * 2 * DRNN; K = DM; N = 2 * DRNN; WT = (bf16*)(F.ws + WS_WIN + l * SZ_WIN); gain = F.in[9] + l * DM; }
        else if ((r -= 2 * I_IN) < 2 * I_OUT) { const int l = r / I_OUT; item = r - l * I_OUT; W = F.in[16] + (size_t)l * DRNN * DM; K = DRNN; N = DM; WT = (bf16*)(F.ws + WS_WOUT + l * SZ_WOUT); }
        else { r -= 2 * I_OUT; const int b = r / I_G; item = r - b * I_G; W = F.in[13] + (size_t)b * 16384; K = 128; N = 128; WT = (bf16*)(F.ws + WS_WG) + (size_t)b * 16384; }
        p0_transpose_item(W, K, N, WT, gain, gm, scr, item, lane_);
    }
    { bf16* XB = (bf16*)(F.ws + WS_XB); pg8::ss_t* ss0 = (pg8::ss_t*)(F.ws + WS_SS);
      for (int m = gw; m < S; m += NGW) {
        const GAS f32x4* xr = (const GAS f32x4*)(F.in[0] + (size_t)m * DM) + lane_; f32x4 v[8]; float s = 0.f;
#pragma unroll
        for (int j = 0; j < 8; ++j) { v[j] = xr[64 * j]; s += (v[j].x * v[j].x + v[j].y * v[j].y) + (v[j].z * v[j].z + v[j].w * v[j].w); }
        s = wave_sum(s); if (lane_ == 0) ss0[m] = (pg8::ss_t)(s * pg8::SS_SCALE);
        GAS unsigned long long* o8 = (GAS unsigned long long*)(XB + (size_t)m * DM) + lane_;
#pragma unroll
        for (int j = 0; j < 8; ++j) o8[64 * j] = (unsigned long long)pk2(v[j].x, v[j].y) | ((unsigned long long)pk2(v[j].z, v[j].w) << 32);
      } }
    { float* rt = (float*)(F.ws + WS_ROPE); const int gt = (F.vcu * NWAVES + wave_) * 64 + lane_;
      for (int e = gt; e < (128 + 64) * 32; e += NGW * 64) { const int f = e & 31, pe = e >> 5; const int isc = pe >= 128 ? 1 : 0, pos = pe - isc * 128;
        double inv = 1.0; for (int k = 0; k < f; ++k) inv *= 0.74989420933245582730;
        const float ang = (float)pos * (float)inv; float sn, cs; sincos_acc(ang, sn, cs);
        float* cst = rt + (isc ? 8192 : 0); const int nel = isc ? 2048 : 4096;
        cst[pos * 32 + f] = cs; cst[nel + pos * 32 + f] = sn; } }
}
__device__ __forceinline__ void rope_phase(Frame& F, const float* qg, const float* kg) {
    OPAQUE_LANE();
    bf16* QKV = (bf16*)(F.ws + WS_QKV); const float* rt = (const float*)(F.ws + WS_ROPE);
    const int gw = F.vcu * NWAVES + wave_, NGW = F.G * NWAVES, g = lane_ >> 4, j = lane_ & 15;
    const int d = 8 * j, axis = d >> 6, first = ((d & 63) < 32) ? 1 : 0, f0 = d & 31;
    const float* gq = qg + d; const float* gk = kg + d;
    f32x4 gq0 = *(const f32x4*)gq, gq1 = *(const f32x4*)(gq + 4), gk0 = *(const f32x4*)gk, gk1 = *(const f32x4*)(gk + 4);
    for (int it = gw; it < S * 5; it += NGW) {
        const int row = it / 5, part = it - row * 5;
        bf16* p = QKV + (size_t)row * QKVD + part * 512 + g * 128 + d;
        const v4u w = *(const GAS v4u*)p;
        float x[8] = {bf_lo(w.x), bf_hi(w.x), bf_lo(w.y), bf_hi(w.y), bf_lo(w.z), bf_hi(w.z), bf_lo(w.w), bf_hi(w.w)};
        float ssq = 0.f;
#pragma unroll
        for (int e = 0; e < 8; ++e) ssq += x[e] * x[e];
        ssq += __shfl_xor(ssq, 1); ssq += __shfl_xor(ssq, 2); ssq += __shfl_xor(ssq, 4); ssq += __shfl_xor(ssq, 8);
        const float rstd = __builtin_amdgcn_rsqf(ssq * (1.0f / 128.0f) + NORM_EPS);
        const f32x4 g0 = part < 4 ? gq0 : gk0, g1 = part < 4 ? gq1 : gk1;
        const float gn[8] = {g0.x, g0.y, g0.z, g0.w, g1.x, g1.y, g1.z, g1.w};
        const int pos = axis ? (row & 63) : (row >> 6);
        const float* ct = rt + (axis ? 8192 : 0) + pos * 32 + f0; const float* st = ct + (axis ? 2048 : 4096);
        const f32x4 c0 = *(const f32x4*)ct, c1 = *(const f32x4*)(ct + 4), s0 = *(const f32x4*)st, s1 = *(const f32x4*)(st + 4);
        const float cs[8] = {c0.x, c0.y, c0.z, c0.w, c1.x, c1.y, c1.z, c1.w}, sn[8] = {s0.x, s0.y, s0.z, s0.w, s1.x, s1.y, s1.z, s1.w};
        float o[8];
#pragma unroll
        for (int e = 0; e < 8; ++e) { const float xn = x[e] * rstd * gn[e]; const float pn = __shfl_xor(xn, 4);
            o[e] = first ? (xn * cs[e] - pn * sn[e]) : (xn * cs[e] + pn * sn[e]); }
        v4u ow; ow.x = pk2(o[0], o[1]); ow.y = pk2(o[2], o[3]); ow.z = pk2(o[4], o[5]); ow.w = pk2(o[6], o[7]);
        *(GAS v4u*)p = ow;
    }
}
__device__ __forceinline__ void attn_phase(Frame& F, char* lds) {
    const att::bf16* QKV = (const att::bf16*)(F.ws + WS_QKV); att::bf16* O = (att::bf16*)(F.ws + WS_O);
    for (int u = F.vcu; u < 512; u += F.G) {
        const int i = u >> 8, x = (u & 255) >> 5, l = u & 31, kvh = x >> 1, h = kvh * 4 + (x & 1) * 2 + i, qb = l;
        att::attn_dense_body(QKV + (size_t)(qb * 256) * QKVD + h * 128, QKV + 2048 + kvh * 128, QKV + 2560 + kvh * 128, O + (size_t)(qb * 256) * DM + h * 128, S, lds);
    }
}
constexpr int SC_AT = 0, SC_ATP = 272;
constexpr int SC_XF = 9216, SC_XFP = 528;
constexpr int SC_AB = 26624;
constexpr int SC_CR = 92160;
#ifdef DBG_REC
#define DBG_CHECK(code, bad) do { if (bad) atomicMax((unsigned*)(F.ws + 2 * MiB - 256), 100u - (unsigned)(code)); } while (0)
#else
#define DBG_CHECK(code, bad) do { } while (0)
#endif
__device__ __forceinline__ bool nonfinite(float x) { return !(__builtin_fabsf(x) < 3.0e38f); }
struct RecArgs { const bf16* U; const bf16* Wg; const float* gate_b; const float* lam; const float* conv_w; const float* conv_b; float2* aggs; float2* aggc; bf16* Y; };
__device__ __forceinline__ float sigmoid_f(float x) { return __builtin_amdgcn_rcpf(1.0f + __builtin_amdgcn_exp2f(x * -1.4426950408889634f)); }
template <int PASS>
__device__ __forceinline__ void rec_pass(Frame& F, char* lds, const RecArgs& R) {
    typedef float f32x4v __attribute__((ext_vector_type(4)));
    OPAQUE_LANE();
    const int tid = tid_, lane = lane_, w = wave_, wd = w >> 2, wq = w & 3, l15 = lane & 15, l4 = lane >> 4;
    const int tl = tid >> 4, c8 = (tid & 15) * 8;
    const int sd = tid >> 7, sch = tid & 127;
    for (int item = F.vcu; item < 256; item += F.G) {
        const int n = item & 15, c = item >> 4;
        bf16x8 bfr[2][2][4];
#pragma unroll
        for (int z = 0; z < 2; ++z)
#pragma unroll
            for (int nt = 0; nt < 2; ++nt)
#pragma unroll
                for (int ks = 0; ks < 4; ++ks)
                    bfr[z][nt][ks] = *(const GAS bf16x8*)(R.Wg + ((size_t)(((wd * 2 + z) * 16 + n) * 128 + wq * 32 + nt * 16 + l15)) * 128 + ks * 32 + l4 * 8);
#ifdef DBG_REC
        { bool bad = false, big = false;
          for (int z = 0; z < 2; ++z) for (int nt = 0; nt < 2; ++nt) for (int ks = 0; ks < 4; ++ks) for (int e = 0; e < 8; ++e) { const float v = __builtin_bit_cast(float, ((unsigned)(unsigned short)bfr[z][nt][ks][e]) << 16); bad |= nonfinite(v); big |= __builtin_fabsf(v) > 100.f; }
          DBG_CHECK(1, bad); DBG_CHECK(2, big); }
#endif
        float br[2], bi[2], sp[2];
#pragma unroll
        for (int nt = 0; nt < 2; ++nt) { const int ch = n * 128 + wq * 32 + nt * 16 + l15; br[nt] = R.gate_b[(wd * 2 + 0) * DRNN + ch]; bi[nt] = R.gate_b[(wd * 2 + 1) * DRNN + ch];
            const float lm = R.lam[wd * DRNN + ch]; sp[nt] = 8.0f * log1pf(__expf(-lm)); }
        float cw[4][8], cb[8];
        { const int ch0 = n * 128 + c8;
#pragma unroll
          for (int tp = 0; tp < 4; ++tp) { const f32x4v a = *(const f32x4v*)(R.conv_w + tp * DRNN + ch0), b = *(const f32x4v*)(R.conv_w + tp * DRNN + ch0 + 4);
              cw[tp][0] = a.x; cw[tp][1] = a.y; cw[tp][2] = a.z; cw[tp][3] = a.w; cw[tp][4] = b.x; cw[tp][5] = b.y; cw[tp][6] = b.z; cw[tp][7] = b.w; }
          const f32x4v a = *(const f32x4v*)(R.conv_b + ch0), b = *(const f32x4v*)(R.conv_b + ch0 + 4);
          cb[0] = a.x; cb[1] = a.y; cb[2] = a.z; cb[3] = a.w; cb[4] = b.x; cb[5] = b.y; cb[6] = b.z; cb[7] = b.w; }
        float aggA = 1.f, aggB = 0.f;
        if (PASS == 2 && tid < 256) {
            const int ch = n * 128 + sch; float h = 0.f; float* cr = (float*)(lds + SC_CR);
            if (sd == 0) { for (int cc = 0; cc < c; ++cc) { const float2 ab = R.aggc[(size_t)(cc * 2 + 0) * DRNN + ch]; h = ab.x * h + ab.y; }
                for (int s = 0; s < 16; ++s) { cr[(s * 2 + 0) * 128 + sch] = h; const float2 ab = R.aggs[(size_t)((c * 16 + s) * 2 + 0) * DRNN + ch]; h = ab.x * h + ab.y; } }
            else { for (int cc = 15; cc > c; --cc) { const float2 ab = R.aggc[(size_t)(cc * 2 + 1) * DRNN + ch]; h = ab.x * h + ab.y; }
                for (int s = 15; s >= 0; --s) { cr[(s * 2 + 1) * 128 + sch] = h; const float2 ab = R.aggs[(size_t)((c * 16 + s) * 2 + 1) * DRNN + ch]; h = ab.x * h + ab.y; } }
        }
        for (int s = 0; s < 16; ++s) {
            const int t0 = c * 512 + s * 32;
            { float xc[8];
#pragma unroll
              for (int e = 0; e < 8; ++e) xc[e] = cb[e];
              const int t = t0 + tl;
#pragma unroll
              for (int tp = 0; tp < 4; ++tp) { const int tt = t + tp - 2;
                  if (tt >= 0 && tt < S) { const v4u wv = *(const GAS v4u*)(R.U + (size_t)tt * (2 * DRNN) + DRNN + n * 128 + c8);
                      xc[0] += cw[tp][0] * bf_lo(wv.x); xc[1] += cw[tp][1] * bf_hi(wv.x); xc[2] += cw[tp][2] * bf_lo(wv.y); xc[3] += cw[tp][3] * bf_hi(wv.y);
                      xc[4] += cw[tp][4] * bf_lo(wv.z); xc[5] += cw[tp][5] * bf_hi(wv.z); xc[6] += cw[tp][6] * bf_lo(wv.w); xc[7] += cw[tp][7] * bf_hi(wv.w); } }
              { bool bad = false; for (int e = 0; e < 8; ++e) bad |= nonfinite(xc[e]); DBG_CHECK(5, bad); }
              v4u o; o.x = pk2(xc[0], xc[1]); o.y = pk2(xc[2], xc[3]); o.z = pk2(xc[4], xc[5]); o.w = pk2(xc[6], xc[7]);
              *(v4u*)(lds + SC_AT + tl * SC_ATP + c8 * 2) = o;
              *(f32x4v*)(lds + SC_XF + tl * SC_XFP + c8 * 4) = (f32x4v){xc[0], xc[1], xc[2], xc[3]};
              *(f32x4v*)(lds + SC_XF + tl * SC_XFP + c8 * 4 + 16) = (f32x4v){xc[4], xc[5], xc[6], xc[7]}; }
            __syncthreads();
#pragma unroll
            for (int mt = 0; mt < 2; ++mt) {
                bf16x8 af[4];
#pragma unroll
                for (int ks = 0; ks < 4; ++ks) af[ks] = *(const bf16x8*)(lds + SC_AT + (mt * 16 + l15) * SC_ATP + (ks * 32 + l4 * 8) * 2);
#ifdef DBG_REC
                { bool bad = false, big = false; for (int ks = 0; ks < 4; ++ks) for (int e = 0; e < 8; ++e) { const float v = __builtin_bit_cast(float, ((unsigned)(unsigned short)af[ks][e]) << 16); bad |= nonfinite(v); big |= __builtin_fabsf(v) > 1.0e4f; } DBG_CHECK(3, bad); DBG_CHECK(4, big); }
#endif
                f32x4v acc[2][2];
#pragma unroll
                for (int z = 0; z < 2; ++z)
#pragma unroll
                    for (int nt = 0; nt < 2; ++nt) { acc[z][nt] = (f32x4v){0.f, 0.f, 0.f, 0.f};
#pragma unroll
                        for (int ks = 0; ks < 4; ++ks) acc[z][nt] = __builtin_amdgcn_mfma_f32_16x16x32_bf16(af[ks], bfr[z][nt][ks], acc[z][nt], 0, 0, 0); }
#pragma unroll
                for (int nt = 0; nt < 2; ++nt)
#pragma unroll
                    for (int rg = 0; rg < 4; ++rg) { const int tt = mt * 16 + l4 * 4 + rg, chl = wq * 32 + nt * 16 + l15;
                        const float rgate = sigmoid_f(acc[0][nt][rg] + br[nt]), igate = sigmoid_f(acc[1][nt][rg] + bi[nt]);
                        const float la = -sp[nt] * rgate, a = __expf(la), x2 = 2.0f * la;
                        const float em = (x2 > -0.25f) ? -x2 * (1.0f + x2 * (0.5f + x2 * (0.16666667f + x2 * (0.041666668f + x2 * (0.0083333338f + x2 * 0.0013888889f))))) : (1.0f - a * a);
                        const float xv = *(const float*)(lds + SC_XF + tt * SC_XFP + chl * 4);
                        const float bb = __builtin_sqrtf(em) * igate * xv;
                        DBG_CHECK(6, nonfinite(acc[0][nt][rg]) || nonfinite(acc[1][nt][rg])); DBG_CHECK(7, nonfinite(a) || a > 1.0f || a < 0.f); DBG_CHECK(31, nonfinite(xv)); DBG_CHECK(32, nonfinite(em) || em < 0.f); DBG_CHECK(33, nonfinite(igate)); DBG_CHECK(25, nonfinite(bb));
                        *(float*)(lds + SC_AB + ((wd * 2 + 0) * 32 + tt) * 512 + chl * 4) = a;
                        *(float*)(lds + SC_AB + ((wd * 2 + 1) * 32 + tt) * 512 + chl * 4) = bb; }
            }
            __syncthreads();
            if (tid < 256) {
                const float* pa = (const float*)(lds + SC_AB + (sd * 2 + 0) * 16384) + sch; float* pb = (float*)(lds + SC_AB + (sd * 2 + 1) * 16384) + sch;
                if (PASS == 1) {
                    float P = 1.f, h = 0.f;
#pragma unroll 8
                    for (int k = 0; k < 32; ++k) { const int t = sd ? 31 - k : k; const float a = pa[t * 128], b = pb[t * 128]; h = a * h + b; P *= a; DBG_CHECK(34, nonfinite(a) || a > 1.0f); DBG_CHECK(35, nonfinite(b)); }
                    DBG_CHECK(26, nonfinite(h) || nonfinite(P));
                    R.aggs[(size_t)((c * 16 + s) * 2 + sd) * DRNN + n * 128 + sch] = make_float2(P, h);
                    if (sd == 0) { aggB = P * aggB + h; aggA = P * aggA; } else { aggB = aggA * h + aggB; aggA = aggA * P; }
                } else {
                    float h = *((const float*)(lds + SC_CR) + (s * 2 + sd) * 128 + sch);
                    DBG_CHECK(27, nonfinite(h));
#pragma unroll 8
                    for (int k = 0; k < 32; ++k) { const int t = sd ? 31 - k : k; const float a = pa[t * 128], b = pb[t * 128]; h = a * h + b; pb[t * 128] = h; }
                    DBG_CHECK(28, nonfinite(h));
                }
            }
            if (PASS == 2) {
                __syncthreads();
                const float* hf = (const float*)(lds + SC_AB + 1 * 16384 + tl * 512 + c8 * 4); const float* hb = (const float*)(lds + SC_AB + 3 * 16384 + tl * 512 + c8 * 4);
                const f32x4v f0 = *(const f32x4v*)hf, f1 = *(const f32x4v*)(hf + 4), b0 = *(const f32x4v*)hb, b1 = *(const f32x4v*)(hb + 4);
                const int t = t0 + tl;
                const v4u gv = *(const GAS v4u*)(R.U + (size_t)t * (2 * DRNN) + n * 128 + c8);
                const float gx[8] = {bf_lo(gv.x), bf_hi(gv.x), bf_lo(gv.y), bf_hi(gv.y), bf_lo(gv.z), bf_hi(gv.z), bf_lo(gv.w), bf_hi(gv.w)};
                const float hs[8] = {f0.x + b0.x, f0.y + b0.y, f0.z + b0.z, f0.w + b0.w, f1.x + b1.x, f1.y + b1.y, f1.z + b1.z, f1.w + b1.w};
                { bool bad = false; for (int e = 0; e < 8; ++e) bad |= nonfinite(gx[e]); DBG_CHECK(29, bad); bad = false; for (int e = 0; e < 8; ++e) bad |= nonfinite(hs[e]); DBG_CHECK(36, bad); }
                float y[8];
#pragma unroll
                for (int e = 0; e < 8; ++e) { const float v = gx[e]; const float u = 1.5957691216057308f * (v + 0.044715f * v * v * v); y[e] = v * sigmoid_f(u) * hs[e];
                    DBG_CHECK(30, nonfinite(y[e]));
#ifdef DBG_SANITIZE_Y
                    if (!(__builtin_fabsf(y[e]) < 1e30f)) y[e] = 0.f;
#endif
                }
                v4u o; o.x = pk2(y[0], y[1]); o.y = pk2(y[2], y[3]); o.z = pk2(y[4], y[5]); o.w = pk2(y[6], y[7]);
                *(GAS v4u*)(R.Y + (size_t)t * DRNN + n * 128 + c8) = o;
            }
        }
        if (PASS == 1 && tid < 256) R.aggc[(size_t)(c * 2 + sd) * DRNN + n * 128 + sch] = make_float2(aggA, aggB);
        __syncthreads();
    }
}
__device__ __forceinline__ void final_norm_phase(Frame& F, float* X, const pg8::ss_t* ss, const float* g) {
    OPAQUE_LANE();
    const int gw = F.vcu * NWAVES + wave_, NGW = F.G * NWAVES;
    f32x4 gv[8];
#pragma unroll
    for (int j = 0; j < 8; ++j) gv[j] = *((const GAS f32x4*)g + lane_ + 64 * j);
    for (int m = gw; m < S; m += NGW) { GAS f32x4* xr = (GAS f32x4*)(X + (size_t)m * DM) + lane_; const float rs = pg8::rs_from_ss(ss[m]);
#pragma unroll
        for (int j = 0; j < 8; ++j) { const f32x4 v = xr[64 * j]; xr[64 * j] = v * rs * gv[j]; } }
#ifdef DBG_REC
    { const unsigned code = *(const unsigned*)(F.ws + 2 * MiB - 256); if (code && gw == 0 && lane_ == 0) { VM_WAIT(); X[0] = 1000.0f * (float)(100u - code); } }
#endif
}
struct Args { const float* in[18]; float* out; unsigned char* ws; int ph_lo, ph_hi; };
static_assert(sizeof(Args) == 18 * 8 + 8 + 8 + 8, "Args has no padding");
__global__ void __launch_bounds__(NWAVES * 64, 2) mega_fwd(Args args) {
    extern __shared__ __attribute__((aligned(16))) unsigned char lds[];
    Frame F;
    F.lds = (LAS unsigned char*)lds;
    F.MISC = (volatile LAS unsigned*)(F.lds + MISC_OFF);
    F.tid = threadIdx.x; F.lane = F.tid & 63; F.wave = __builtin_amdgcn_readfirstlane(F.tid >> 6);
    F.G = gridDim.x; { const int bx = blockIdx.x; F.vcu = (F.G % 8 == 0) ? (bx % 8) * (F.G / 8) + bx / 8 : bx; }
    F.ws = args.ws; F.ctl = (gu32*)(args.ws + WS_CTL); F.in = args.in;
    for (int u = F.tid; u < (LDS_BYTES - LDSCTL_OFF) / 4; u += NWAVES * 64) ((LAS unsigned*)(F.lds + LDSCTL_OFF))[u] = 0u;
    __syncthreads();
    const int lo = args.ph_lo, hi = args.ph_hi;
    const bool use_bar = (hi - lo) > 1;
    XcdBarrier bar; bar.bar = (unsigned*)(F.ctl + CW_BAR); bar.x = 0; bar.st = nullptr;
    if (use_bar) bar = xcd_barrier_post((unsigned*)(F.ctl + CW_BAR), F.MISC + 8);
#define IN(k) (lo <= (k) && (k) < hi)
#define SEAM(k) do { if (IN((k) + 1)) xcd_barrier(bar); } while (0)
    pg8::ss_t* const ssb = (pg8::ss_t*)(args.ws + WS_SS);
    bf16* const XB = (bf16*)(args.ws + WS_XB);

    #if PH_P0
    if (IN(0)) { p0_prologue(F); SEAM(0); }
#endif

    for (int sb = 0; sb < NSB; ++sb) {
        const int p6 = sb / 6, k6 = sb - 6 * p6;
        const int type = (k6 == 1) ? 1 : (k6 == 4) ? 2 : 0;
        const int f = 4 * p6 + (k6 == 0 ? 0 : k6 == 2 ? 1 : k6 == 3 ? 2 : 3);
        const int pb = 1 + 4 * sb;
        const pg8::ss_t* ss_in = ssb + (size_t)sb * S; pg8::ss_t* ss_out = ssb + (size_t)(sb + 1) * S;
        if (IN(pb)) {
#if PH_GU
            if (type == 0) {
                pg8::Gemm g{XB, (const bf16*)(args.ws + WS_WGU + f * SZ_WGU), S, NGU, DM}; pg8::StaticOrder So; So.init(S, NGU, F.G, (int)blockIdx.x);
                pg8::EpiSwiglu E{(bf16*)(args.ws + WS_H), ss_in};
                pg8::gemm_phase<pg8::EpiSwiglu, pg8::StaticOrder, true, true>(F.lds + RING_OFF, g, So, E);
            }
#endif
#if PH_PLAIN
            if (type != 0) {
                const int N = (type == 1) ? QKVD : 2 * DRNN;
                const bf16* Wt = (type == 1) ? (const bf16*)(args.ws + WS_WQKV + p6 * SZ_WQKV) : (const bf16*)(args.ws + WS_WIN + p6 * SZ_WIN);
                bf16* Out = (type == 1) ? (bf16*)(args.ws + WS_QKV) : (bf16*)(args.ws + WS_U);
                pg8::Gemm g{XB, Wt, S, N, DM}; pg8::StaticOrder So; So.init(S, N, F.G, (int)blockIdx.x);
                pg8::EpiPlain E{Out, N, ss_in};
                pg8::gemm_phase<pg8::EpiPlain, pg8::StaticOrder, true, true>(F.lds + RING_OFF, g, So, E);
            }
#endif
            SEAM(pb);
        }
        if (type == 1) {
#if PH_ROPE
            if (IN(pb + 1)) { rope_phase(F, args.in[6] + p6 * 128, args.in[7] + p6 * 128); SEAM(pb + 1); }
#endif
#if PH_ATT
            if (IN(pb + 2)) { attn_phase(F, (char*)lds + RING_OFF); SEAM(pb + 2); }
#endif
        } else if (type == 2) {
            const RecArgs R{(const bf16*)(args.ws + WS_U), (const bf16*)(args.ws + WS_WG) + (size_t)p6 * (4 * 16 * 16384), args.in[14] + p6 * 4 * DRNN, args.in[15] + p6 * 2 * DRNN,
                            args.in[11] + p6 * 4 * DRNN, args.in[12] + p6 * DRNN, (float2*)(args.ws + WS_AGGS), (float2*)(args.ws + WS_AGGC), (bf16*)(args.ws + WS_Y)};
#if PH_REC1
            if (IN(pb + 1)) { rec_pass<1>(F, (char*)lds + RING_OFF, R); SEAM(pb + 1); }
#endif
#if PH_REC2
            if (IN(pb + 2)) { rec_pass<2>(F, (char*)lds + RING_OFF, R); SEAM(pb + 2); }
#endif
        }
#if PH_RES
        if (IN(pb + 3)) {
            const bf16* A = (type == 0) ? (const bf16*)(args.ws + WS_H) : (type == 1) ? (const bf16*)(args.ws + WS_O) : (const bf16*)(args.ws + WS_Y);
            const bf16* Wt = (type == 0) ? (const bf16*)(args.ws + WS_WD + f * SZ_WD) : (type == 1) ? (const bf16*)(args.ws + WS_WO + p6 * SZ_WO) : (const bf16*)(args.ws + WS_WOUT + p6 * SZ_WOUT);
            const int K = (type == 0) ? DFF : DM;
            pg8::Gemm g{A, Wt, S, DM, K}; pg8::StaticOrder So; So.init(S, DM, F.G, (int)blockIdx.x);
            pg8::EpiResid E{sb == 0 ? args.in[0] : (const float*)args.out, args.out, XB, ss_out, type == 0 ? 0.5f : 1.0f};
            pg8::gemm_phase<pg8::EpiResid, pg8::StaticOrder, true, true>(F.lds + RING_OFF, g, So, E);
            SEAM(pb + 3);
        }
#endif
    }
#if PH_FN
    if (IN(N_PHASES - 1)) final_norm_phase(F, args.out, ssb + (size_t)NSB * S, args.in[17]);
#endif
#undef IN
#undef SEAM
}

extern "C" void kernel_launch(void* const* d_in, const int* in_sizes, int n_in, void* d_out, int out_size, void* d_ws, size_t ws_size, hipStream_t stream) {
    static int grid = 0;
    if (grid == 0) {
        if (n_in != 18 || in_sizes[0] != S * DM || out_size != S * DM || ws_size < WS_END) { fprintf(stderr, "kernel_launch: shape mismatch: n_in %d in0 %d out %d ws %zu (need %zu)\n", n_in, n_in > 0 ? in_sizes[0] : -1, out_size, ws_size, (size_t)WS_END); grid = -1; return; }
        int dev = 0, cus = 0, per_cu = 0;
        if (hipGetDevice(&dev) != hipSuccess || hipDeviceGetAttribute(&cus, hipDeviceAttributeMultiprocessorCount, dev) != hipSuccess) { fprintf(stderr, "kernel_launch: device query failed\n"); grid = -1; return; }
        if (hipFuncSetAttribute((const void*)mega_fwd, hipFuncAttributeMaxDynamicSharedMemorySize, LDS_BYTES) != hipSuccess) { fprintf(stderr, "kernel_launch: hipFuncSetAttribute failed\n"); grid = -1; return; }
        if (hipOccupancyMaxActiveBlocksPerMultiprocessor(&per_cu, (const void*)mega_fwd, NWAVES * 64, LDS_BYTES) != hipSuccess || per_cu < 1) { fprintf(stderr, "kernel_launch: occupancy query says %d blocks per CU\n", per_cu); }
        (void)hipGetLastError();
        grid = cus;
    }
    if (grid < 0) return;
    if (hipMemsetAsync((char*)d_ws + WS_CTL, 0, CTL_ZERO_BYTES, stream) != hipSuccess) { fprintf(stderr, "kernel_launch: memset failed\n"); return; }
    Args a{};
    for (int i = 0; i < 18; ++i) a.in[i] = (const float*)d_in[i];
    a.out = (float*)d_out; a.ws = (unsigned char*)d_ws;
#if MK_MULTI
    for (int ph = 0; ph < N_PHASES; ++ph) {
        if (ph >= 1 && ph < N_PHASES - 1) { const int sb = (ph - 1) / 4, k = (ph - 1) % 4, k6 = sb % 6; if ((k == 1 || k == 2) && !(k6 == 1 || k6 == 4)) continue; }
        a.ph_lo = ph; a.ph_hi = ph + 1;
        hipLaunchKernelGGL(mega_fwd, dim3(grid), dim3(NWAVES * 64), LDS_BYTES, stream, a);
    }
#else
    a.ph_lo = 0; a.ph_hi = N_PHASES;
    hipLaunchKernelGGL(mega_fwd, dim3(grid), dim3(NWAVES * 64), LDS_BYTES, stream, a);
#endif
    const hipError_t le = hipPeekAtLastError();
    if (le != hipSuccess) fprintf(stderr, "kernel_launch: launch failed: %s\n", hipGetErrorName(le));
}
```

```cpp
#include <hip/hip_runtime.h>
#include <hip/hip_bf16.h>
#include <cstdio>
#include <cstdint>
#define MK_MULTI 0
namespace pg8 {
#define PG8_LAS __attribute__((address_space(3)))
typedef unsigned short bf16_t;
typedef short bf16x8 __attribute__((ext_vector_type(8)));
typedef float f32x4 __attribute__((ext_vector_type(4)));
typedef unsigned u32x4 __attribute__((ext_vector_type(4)));
constexpr int BM = 256, BK = 64, HALF = 128, HTB = HALF * BK * 2  , STAGE_BYTES = 8 * HTB, NXCD = 8, WGM = 8;

__host__ __device__ __forceinline__ int lds_byte(int r, int c) { const int st = (r >> 4) * 2 + (c >> 5), rr = r & 15, cc = c & 31, ob = rr * 64 + cc * 2; return st * 1024 + (ob ^ (((ob >> 9) & 1) << 5)); }
__host__ __device__ __forceinline__ void stage_rc(int b, int& R, int& C) { const int st = b / 1024, sb = b % 1024, swz = sb ^ (((sb >> 9) & 1) << 5); R = (st >> 1) * 16 + swz / 64; C = (st & 1) * 32 + (swz % 64) / 2; }
__host__ __device__ __forceinline__ int perm32(int rho) { const int n = rho >> 4, i = rho & 15; return 8 * (i >> 2) + 4 * n + (i & 3); }

struct Unit { int pm, pn; };
struct Gemm { const bf16_t* A; const bf16_t* Bt; int M, N, K; };

struct StaticOrder {
    int nM, nN, nwg, G, c;
    __host__ __device__ void init(int M, int N, int G_, int c_) { nM = M / BM; nN = N / BM; nwg = nM * nN; G = G_; c = c_; }
    __host__ __device__ bool next(int i, Unit& u) const {
        const long L = (long)i * G + c; if (L >= nwg) return false;
        int wgid = (int)L; { const int q = nwg / NXCD, r = nwg % NXCD, xcd = wgid % NXCD, off = wgid / NXCD; wgid = (xcd < r ? xcd * (q + 1) : r * (q + 1) + (xcd - r) * q) + off; }
        const int nig = WGM * nN, gid = wgid / nig, fm = gid * WGM, gsz = (nM - fm) < WGM ? (nM - fm) : WGM;
        u.pm = fm + ((wgid % nig) % gsz); u.pn = (wgid % nig) / gsz; return true;
    }
    __device__ __forceinline__ void a_ready(const Unit&) const {}
    __device__ __forceinline__ void done(const Unit&) const {}
};
__device__ __forceinline__ unsigned cvt_pk_bf16(float lo, float hi) { unsigned r; asm volatile("v_cvt_pk_bf16_f32 %0, %1, %2" : "=v"(r) : "v"(lo), "v"(hi)); return r; }
constexpr int DM = 2048, DFF = 5632;
constexpr float RMS_EPS = 1e-6f;
typedef unsigned long long ss_t;
constexpr float SS_SCALE = 16777216.0f;
__device__ __forceinline__ float rs_from_ss(ss_t ss) { return __builtin_amdgcn_rsqf((float)ss * (1.0f / ((float)DM * SS_SCALE)) + RMS_EPS); }
__device__ __forceinline__ float silu_f(float x) { return x * __builtin_amdgcn_rcpf(1.0f + __builtin_amdgcn_exp2f(x * -1.4426950408889634f)); }
__device__ __forceinline__ u32x4 pack8(const f32x4 a, const f32x4 b) { u32x4 w; w.x = cvt_pk_bf16(a[0], a[1]); w.y = cvt_pk_bf16(a[2], a[3]); w.z = cvt_pk_bf16(b[0], b[1]); w.w = cvt_pk_bf16(b[2], b[3]); return w; }

struct EpiSwiglu {
    static constexpr bool PERM = true, AFTER_DRAIN = false;
    bf16_t* H; const ss_t* ss;
    __device__ __forceinline__ void operator()(const f32x4 (&acc)[2][2][4][2], const Unit& u, int wr, int wc, int fr, int fq) const {
        const int row0 = u.pm * BM + wr * 64 + fr, col0 = u.pn * HALF + wc * 32 + 8 * fq;
#pragma unroll
        for (int ai = 0; ai < 2; ++ai)
#pragma unroll
            for (int m = 0; m < 4; ++m) { const int r = row0 + ai * HALF + m * 16; const float rs = rs_from_ss(ss[r]);
                f32x4 h[2];
#pragma unroll
                for (int n = 0; n < 2; ++n) { const f32x4 g = acc[ai][0][m][n] * rs, v = acc[ai][1][m][n] * rs;
                    h[n] = (f32x4){silu_f(g[0]) * v[0], silu_f(g[1]) * v[1], silu_f(g[2]) * v[2], silu_f(g[3]) * v[3]}; }
                *(u32x4*)(H + (size_t)r * DFF + col0) = pack8(h[0], h[1]); }
    }
};
struct EpiPlain {
    static constexpr bool PERM = true, AFTER_DRAIN = false;
    bf16_t* O; int ldc; const ss_t* ss;
    __device__ __forceinline__ void operator()(const f32x4 (&acc)[2][2][4][2], const Unit& u, int wr, int wc, int fr, int fq) const {
        const int row0 = u.pm * BM + wr * 64 + fr, col0 = u.pn * BM + wc * 32 + 8 * fq;
#pragma unroll
        for (int ai = 0; ai < 2; ++ai)
#pragma unroll
            for (int m = 0; m < 4; ++m) { const int r = row0 + ai * HALF + m * 16; const float rs = rs_from_ss(ss[r]); bf16_t* rowp = O + (size_t)r * ldc + col0;
#pragma unroll
                for (int bj = 0; bj < 2; ++bj) *(u32x4*)(rowp + bj * HALF) = pack8(acc[ai][bj][m][0] * rs, acc[ai][bj][m][1] * rs); }
    }
};
struct EpiResid {
    static constexpr bool PERM = true, AFTER_DRAIN = false;
    const float* base; float* out; bf16_t* xb; ss_t* ssn; float alpha;
    __device__ __forceinline__ void operator()(const f32x4 (&acc)[2][2][4][2], const Unit& u, int wr, int wc, int fr, int fq) const {
        const int row0 = u.pm * BM + wr * 64 + fr, col0 = u.pn * BM + wc * 32 + 8 * fq;
#pragma unroll
        for (int ai = 0; ai < 2; ++ai)
#pragma unroll
            for (int m = 0; m < 4; ++m) { const int r = row0 + ai * HALF + m * 16; const size_t off = (size_t)r * DM + col0; float q = 0.f;
#pragma unroll
                for (int bj = 0; bj < 2; ++bj) { const f32x4 b0 = *(const f32x4*)(base + off + bj * HALF), b1 = *(const f32x4*)(base + off + bj * HALF + 4);
                    const f32x4 x0 = b0 + acc[ai][bj][m][0] * alpha, x1 = b1 + acc[ai][bj][m][1] * alpha;
                    *(f32x4*)(out + off + bj * HALF) = x0; *(f32x4*)(out + off + bj * HALF + 4) = x1;
                    *(u32x4*)(xb + off + bj * HALF) = pack8(x0, x1);
                    q += (x0[0] * x0[0] + x0[1] * x0[1]) + (x0[2] * x0[2] + x0[3] * x0[3]) + (x1[0] * x1[0] + x1[1] * x1[1]) + (x1[2] * x1[2] + x1[3] * x1[3]); }
                q += __shfl_xor(q, 16); q += __shfl_xor(q, 32);
                if (fq == 0) __hip_atomic_fetch_add(ssn + r, (ss_t)(q * SS_SCALE), __ATOMIC_RELAXED, __HIP_MEMORY_SCOPE_AGENT);
                if (m & 1) asm volatile("" ::: "memory"); }
    }
};

template <class Epi, class Sched, bool ALIGN_EPI = false, bool SP2 = false>
__device__ __forceinline__ void gemm_phase(PG8_LAS unsigned char* lds, const Gemm g, const Sched& S, const Epi& E) {
    int tid_ = threadIdx.x; asm volatile("" : "+v"(tid_));
    const int tid = tid_, wid = __builtin_amdgcn_readfirstlane(tid >> 6), lane = tid & 63, wr = wid >> 2, wc = wid & 3, fr = lane & 15, fq = lane >> 4;
    const int K = g.K, nt = K / BK;
    unsigned voffA[2], voffB[2];
#pragma unroll
    for (int i = 0; i < 2; ++i) { int R, C; stage_rc(tid * 16 + i * 8192, R, C); const int Rb = Epi::PERM ? ((R & ~31) + perm32(R & 31)) : R;
        voffA[i] = (unsigned)(R * K + C) * 2u; voffB[i] = (unsigned)(Rb * K + C) * 2u; }
    const size_t kstep = (size_t)(BK * 2);
    const size_t hstep = (size_t)HALF * K * 2;
    const size_t tstep = 2 * hstep;
    const unsigned ldsw = (unsigned)wid * 1024u;
    const int aoff = lds_byte(wr * 64 + fr, fq * 8), boff = lds_byte(wc * 32 + fr, fq * 8);
#define PG8_SA(b, h) (((b) * 2 + (h)) * HTB)
#define PG8_SB(b, h) ((4 + (b) * 2 + (h)) * HTB)
#define PG8_STAGE(bufoff, gbase, voff) do { _Pragma("unroll") for (int _i = 0; _i < 2; ++_i) \
        __builtin_amdgcn_global_load_lds((const unsigned*)((const char*)(gbase) + (voff)[_i]), (PG8_LAS unsigned*)(lds + (bufoff) + ldsw + _i * 8192), 16, 0, 0); } while (0)
#define PG8_LDA(dst, b, h) do { _Pragma("unroll") for (int m = 0; m < 4; ++m) _Pragma("unroll") for (int k = 0; k < 2; ++k) dst[m][k] = *(const PG8_LAS bf16x8*)(lds + PG8_SA(b, h) + aoff + m * 2048 + k * 1024); } while (0)
#define PG8_LDB(dst, b, h) do { _Pragma("unroll") for (int n = 0; n < 2; ++n) _Pragma("unroll") for (int k = 0; k < 2; ++k) dst[n][k] = *(const PG8_LAS bf16x8*)(lds + PG8_SB(b, h) + boff + n * 2048 + k * 1024); } while (0)
#define PG8_MMA(ai, bj, At, Bt) do { __builtin_amdgcn_s_setprio(1); _Pragma("unroll") for (int m = 0; m < 4; ++m) _Pragma("unroll") for (int n = 0; n < 2; ++n) _Pragma("unroll") for (int k = 0; k < 2; ++k) \
        acc[ai][bj][m][n] = __builtin_amdgcn_mfma_f32_16x16x32_bf16(Bt[n][k], At[m][k], acc[ai][bj][m][n], 0, 0, 0); __builtin_amdgcn_s_setprio(0); } while (0)
#define PG8_WAIT_V(n) asm volatile("s_waitcnt vmcnt(" #n ")" ::: "memory")
#define PG8_WAIT_L(n) asm volatile("s_waitcnt lgkmcnt(" #n ")" ::: "memory")
#define PG8_BAR __builtin_amdgcn_s_barrier()
#define PG8_SCHED __builtin_amdgcn_sched_barrier(0)
    Unit cur, nxt; int ui = 0;
    if (!S.next(0, cur)) return;
    f32x4 acc[2][2][4][2];
#pragma unroll
    for (int a = 0; a < 2; ++a)
#pragma unroll
        for (int b = 0; b < 2; ++b)
#pragma unroll
            for (int m = 0; m < 4; ++m)
#pragma unroll
                for (int n = 0; n < 2; ++n) acc[a][b][m][n] = (f32x4){0.f, 0.f, 0.f, 0.f};
    bf16x8 At[4][2], B0[2][2], B1[2][2];
    const char* cA = (const char*)g.A + (size_t)cur.pm * tstep; const char* cB = (const char*)g.Bt + (size_t)cur.pn * tstep;
    S.a_ready(cur);
    if constexpr (SP2) {
        PG8_STAGE(PG8_SB(0, 0), cB, voffB); PG8_STAGE(PG8_SB(0, 1), cB + hstep, voffB); PG8_STAGE(PG8_SA(0, 0), cA, voffA); PG8_STAGE(PG8_SA(0, 1), cA + hstep, voffA);
        if (wr == 1) PG8_BAR;
        PG8_WAIT_V(2); PG8_BAR;
        PG8_STAGE(PG8_SB(1, 0), cB + kstep, voffB); PG8_STAGE(PG8_SA(1, 0), cA + kstep, voffA); PG8_STAGE(PG8_SB(1, 1), cB + hstep + kstep, voffB);
        PG8_WAIT_V(6); PG8_BAR;
    } else {
        PG8_STAGE(PG8_SB(0, 0), cB, voffB); PG8_STAGE(PG8_SA(0, 0), cA, voffA); PG8_STAGE(PG8_SB(0, 1), cB + hstep, voffB); PG8_STAGE(PG8_SA(0, 1), cA + hstep, voffA);
        if (wr == 1) PG8_BAR;
        PG8_WAIT_V(4); PG8_BAR;
        PG8_STAGE(PG8_SB(1, 0), cB + kstep, voffB); PG8_STAGE(PG8_SA(1, 0), cA + kstep, voffA); PG8_STAGE(PG8_SB(1, 1), cB + hstep + kstep, voffB);
        PG8_WAIT_V(6); PG8_BAR;
    }
    for (;;) {
        const bool has_next = S.next(ui + 1, nxt);
        const char* nA = has_next ? (const char*)g.A + (size_t)nxt.pm * tstep : cA; const char* nB = has_next ? (const char*)g.Bt + (size_t)nxt.pn * tstep : cB;
        for (int t = 0; t < nt; t += 2) {
            const bool last = (t == nt - 2);
            const char* a1 = cA + (size_t)(t + 1) * kstep;
            const char* a2 = last ? nA : cA + (size_t)(t + 2) * kstep; const char* b2 = last ? nB : cB + (size_t)(t + 2) * kstep;
            const char* a3 = a2 + kstep; const char* b3 = b2 + kstep;
            if (last && has_next) S.a_ready(nxt);
            if constexpr (SP2) {
            PG8_LDB(B0, 0, 0); PG8_LDB(B1, 0, 1); PG8_SCHED; PG8_LDA(At, 0, 0); PG8_STAGE(PG8_SA(1, 1), a1 + hstep, voffA);
            PG8_WAIT_V(8); PG8_WAIT_L(0); PG8_BAR; PG8_MMA(0, 0, At, B0); PG8_MMA(0, 1, At, B1); PG8_BAR; PG8_SCHED;
            PG8_LDA(At, 0, 1); PG8_STAGE(PG8_SB(0, 0), b2, voffB); PG8_STAGE(PG8_SB(0, 1), b2 + hstep, voffB); PG8_STAGE(PG8_SA(0, 0), a2, voffA);
            PG8_WAIT_V(8); PG8_WAIT_L(0); PG8_BAR; PG8_MMA(1, 0, At, B0); PG8_MMA(1, 1, At, B1); PG8_BAR; PG8_SCHED;
            PG8_LDB(B0, 1, 0); PG8_LDB(B1, 1, 1); PG8_SCHED; PG8_LDA(At, 1, 0); PG8_STAGE(PG8_SA(0, 1), a2 + hstep, voffA);
            PG8_WAIT_V(8); PG8_WAIT_L(0); PG8_BAR; PG8_MMA(0, 0, At, B0); PG8_MMA(0, 1, At, B1); PG8_BAR; PG8_SCHED;
            PG8_LDA(At, 1, 1); PG8_STAGE(PG8_SB(1, 0), b3, voffB); PG8_STAGE(PG8_SB(1, 1), b3 + hstep, voffB); PG8_STAGE(PG8_SA(1, 0), a3, voffA);
            PG8_WAIT_V(8); PG8_WAIT_L(0); PG8_BAR; PG8_MMA(1, 0, At, B0); PG8_MMA(1, 1, At, B1); PG8_BAR; PG8_SCHED;
            } else {
            PG8_LDB(B0, 0, 0); PG8_SCHED; PG8_LDA(At, 0, 0); PG8_STAGE(PG8_SA(1, 1), a1 + hstep, voffA);
            PG8_WAIT_L(8); PG8_BAR; PG8_WAIT_L(0); PG8_MMA(0, 0, At, B0); PG8_BAR; PG8_SCHED;
            PG8_LDB(B1, 0, 1); PG8_STAGE(PG8_SB(0, 0), b2, voffB);
            PG8_BAR; PG8_WAIT_L(0); PG8_MMA(0, 1, At, B1); PG8_BAR;
            PG8_LDA(At, 0, 1); PG8_STAGE(PG8_SA(0, 0), a2, voffA);
            PG8_BAR; PG8_WAIT_L(0); PG8_MMA(1, 0, At, B0); PG8_BAR; PG8_SCHED;
            PG8_STAGE(PG8_SB(0, 1), b2 + hstep, voffB);
            PG8_WAIT_V(6); PG8_BAR; PG8_MMA(1, 1, At, B1); PG8_BAR;
            PG8_LDB(B0, 1, 0); PG8_SCHED; PG8_LDA(At, 1, 0); PG8_STAGE(PG8_SA(0, 1), a2 + hstep, voffA);
            PG8_WAIT_L(8); PG8_BAR; PG8_WAIT_L(0); PG8_MMA(0, 0, At, B0); PG8_BAR; PG8_SCHED;
            PG8_LDB(B1, 1, 1); PG8_STAGE(PG8_SB(1, 0), b3, voffB);
            PG8_BAR; PG8_WAIT_L(0); PG8_MMA(0, 1, At, B1); PG8_BAR;
            PG8_LDA(At, 1, 1); PG8_STAGE(PG8_SA(1, 0), a3, voffA);
            PG8_BAR; PG8_WAIT_L(0); PG8_MMA(1, 0, At, B0); PG8_BAR; PG8_SCHED;
            PG8_STAGE(PG8_SB(1, 1), b3 + hstep, voffB);
            PG8_WAIT_V(6); PG8_BAR; PG8_MMA(1, 1, At, B1); PG8_BAR;
            }
        }
        if constexpr (ALIGN_EPI) { if (wr == 0) PG8_BAR; }
        if constexpr (!Epi::AFTER_DRAIN) { E(acc, cur, wr, wc, fr, fq); S.done(cur); }
        if (!has_next) break;
#pragma unroll
        for (int a = 0; a < 2; ++a)
#pragma unroll
            for (int b = 0; b < 2; ++b)
#pragma unroll
                for (int m = 0; m < 4; ++m)
#pragma unroll
                    for (int n = 0; n < 2; ++n) acc[a][b][m][n] = (f32x4){0.f, 0.f, 0.f, 0.f};
        cur = nxt; cA = nA; cB = nB; ++ui;
        if constexpr (ALIGN_EPI) { if (wr == 1) PG8_BAR; }
    }
    PG8_WAIT_V(0);
    if constexpr (!ALIGN_EPI) { if (wr == 0) PG8_BAR; }
    PG8_BAR;
    if constexpr (Epi::AFTER_DRAIN) { E.fused(acc, cur, wr, wc, fr, fq, lds, wid, lane); S.done(cur); }
#undef PG8_SA
#undef PG8_SB
#undef PG8_STAGE
#undef PG8_LDA
#undef PG8_LDB
#undef PG8_MMA
#undef PG8_WAIT_V
#undef PG8_WAIT_L
#undef PG8_BAR
#undef PG8_SCHED
}
}
namespace att {
using bf16 = __hip_bfloat16;
constexpr int   D = 128, NW = 8, QBLK = 32, KVBLK = 64;
constexpr float SCALE = 0.088388347648318440f;
constexpr float THR = 8.f;
constexpr int   SDEPTH = 2;
constexpr int   LDQ = 3072, LDK = 3072, LDO = 2048;
constexpr size_t SHM_V = KVBLK * D * 2, SHM_K = KVBLK * D * 2, SHM_ATTN = 2 * SHM_V + 2 * SHM_K + NW * 64 * 4;
using bf16x8 = __attribute__((ext_vector_type(8))) short;
using s16x4  = __attribute__((ext_vector_type(4))) short;
using f32x16 = __attribute__((ext_vector_type(16))) float;
using u32x4  = __attribute__((ext_vector_type(4))) unsigned;
#define KSWZ(row, colB) ((row) * 256 + ((colB) ^ (((row) & 7) << 4)))
#define SBAR() __builtin_amdgcn_sched_barrier(0)
__device__ __forceinline__ int crow(int r, int hi) { return (r & 3) + 8 * (r >> 2) + 4 * hi; }
__device__ __forceinline__ unsigned cvtpk(float lo, float hi) {
  unsigned r; asm volatile("v_cvt_pk_bf16_f32 %0, %1, %2" : "=v"(r) : "v"(lo), "v"(hi)); return r;
}

__device__ __forceinline__ void partialSM(f32x16& p0, f32x16& p1, float& m_reg, float& mn, float& alpha) {
  constexpr float C = SCALE * 1.4426950408889634f;
  float pmax = p0[0]; for (int r = 1; r < 16; ++r) pmax = fmaxf(pmax, p0[r]); for (int r = 0; r < 16; ++r) pmax = fmaxf(pmax, p1[r]);
  { auto rr = __builtin_amdgcn_permlane32_swap(__float_as_uint(pmax), __float_as_uint(pmax), false, false);
    pmax = fmaxf(__uint_as_float(rr[0]), __uint_as_float(rr[1])); }
  if (__builtin_expect(__all(pmax - m_reg <= THR / SCALE), 1)) { mn = m_reg; alpha = 1.f; }
  else { mn = fmaxf(m_reg, pmax); alpha = __builtin_amdgcn_exp2f((m_reg - mn) * C); m_reg = mn; }
  float mnC = -mn * C;
  for (int r = 0; r < 16; ++r) p0[r] = fmaf(p0[r], C, mnC); for (int r = 0; r < 16; ++r) p1[r] = fmaf(p1[r], C, mnC);
  for (int r = 0; r < 16; ++r) p0[r] = __builtin_amdgcn_exp2f(p0[r]);
}
__device__ __forceinline__ void finishSM(f32x16& p0, f32x16& p1, float alpha, float& l_reg, bf16x8& pa0, bf16x8& pa1, bf16x8& pa2, bf16x8& pa3) {
  for (int r = 0; r < 16; ++r) p1[r] = __builtin_amdgcn_exp2f(p1[r]);
  float ps = 0; for (int r = 0; r < 16; ++r) ps += p0[r]; for (int r = 0; r < 16; ++r) ps += p1[r];
  { auto rr = __builtin_amdgcn_permlane32_swap(__float_as_uint(ps), __float_as_uint(ps), false, false);
    ps = __uint_as_float(rr[0]) + __uint_as_float(rr[1]); }
  l_reg = l_reg * alpha + ps;
#define PK4(P, BASE, OUT) do { unsigned a0 = cvtpk(P[BASE + 0], P[BASE + 1]), a1 = cvtpk(P[BASE + 2], P[BASE + 3]);   \
    unsigned b0 = cvtpk(P[BASE + 4], P[BASE + 5]), b1 = cvtpk(P[BASE + 6], P[BASE + 7]);                              \
    auto r0 = __builtin_amdgcn_permlane32_swap(a0, b0, false, false); auto r1 = __builtin_amdgcn_permlane32_swap(a1, b1, false, false); \
    u32x4 w = {r0[0], r1[0], r0[1], r1[1]}; OUT = *reinterpret_cast<bf16x8*>(&w); } while (0)
  PK4(p0, 0, pa0); PK4(p0, 8, pa1); PK4(p1, 0, pa2); PK4(p1, 8, pa3);
#undef PK4
}
__device__ __forceinline__ void qkt(f32x16& p0, f32x16& p1, const bf16* Ks, const bf16x8* qr, int r32, int hi) {
  p0 = f32x16{}; p1 = f32x16{};
  for (int d0 = 0; d0 < 8; ++d0) { int cb = (d0 * 16 + hi * 8) * 2;
    bf16x8 b0 = *reinterpret_cast<const bf16x8*>((const char*)Ks + KSWZ(r32, cb));
    bf16x8 b1 = *reinterpret_cast<const bf16x8*>((const char*)Ks + KSWZ(32 + r32, cb));
    p0 = __builtin_amdgcn_mfma_f32_32x32x16_bf16(b0, qr[d0], p0, 0, 0, 0);
    p1 = __builtin_amdgcn_mfma_f32_32x32x16_bf16(b1, qr[d0], p1, 0, 0, 0); }
}
__device__ __forceinline__ int v_st(int k, int c) { const int kk = (k & ~0xC) | ((k & 4) << 1) | ((k & 8) >> 1); return ((kk >> 3) * 4 + (c >> 5)) * 512 + ((kk & 7) * 32 + (c & 31)) * 2; }
__device__ __forceinline__ int v_rd_base(int lane) { return ((lane & 3) << 3) | (((lane >> 2) & 3) << 6) | (((lane >> 4) & 1) << 5) | (((lane >> 5) & 1) << 8); }
constexpr int v_rd_off(int d0, int ks, int half) { return d0 * 512 + ks * 4096 + half * 2048; }
template <int OFF> __device__ __forceinline__ s16x4 tr_read(int vb) {
  s16x4 r; asm volatile("ds_read_b64_tr_b16 %0, %1 offset:%2" : "=&v"(r) : "v"(vb), "i"(OFF) : "memory"); return r;
}
template <int D0> __device__ __forceinline__ void pv_one(f32x16& od, int vb, bf16x8 pa0, bf16x8 pa1, bf16x8 pa2, bf16x8 pa3) {
  const s16x4 l0 = tr_read<v_rd_off(D0, 0, 0)>(vb), h0 = tr_read<v_rd_off(D0, 0, 1)>(vb), l1 = tr_read<v_rd_off(D0, 1, 0)>(vb), h1 = tr_read<v_rd_off(D0, 1, 1)>(vb);
  const s16x4 l2 = tr_read<v_rd_off(D0, 2, 0)>(vb), h2 = tr_read<v_rd_off(D0, 2, 1)>(vb), l3 = tr_read<v_rd_off(D0, 3, 0)>(vb), h3 = tr_read<v_rd_off(D0, 3, 1)>(vb);
  asm volatile("s_waitcnt lgkmcnt(0)" ::: "memory"); SBAR();
#define PK(L, H) (bf16x8){L[0], L[1], L[2], L[3], H[0], H[1], H[2], H[3]}
  od = __builtin_amdgcn_mfma_f32_32x32x16_bf16(pa0, PK(l0, h0), od, 0, 0, 0);
  od = __builtin_amdgcn_mfma_f32_32x32x16_bf16(pa1, PK(l1, h1), od, 0, 0, 0);
  od = __builtin_amdgcn_mfma_f32_32x32x16_bf16(pa2, PK(l2, h2), od, 0, 0, 0);
  od = __builtin_amdgcn_mfma_f32_32x32x16_bf16(pa3, PK(l3, h3), od, 0, 0, 0);
#undef PK
}
__device__ __forceinline__ void pv_d0(f32x16* o, int vb, bf16x8 pa0, bf16x8 pa1, bf16x8 pa2, bf16x8 pa3) {
  pv_one<0>(o[0], vb, pa0, pa1, pa2, pa3); pv_one<1>(o[1], vb, pa0, pa1, pa2, pa3); pv_one<2>(o[2], vb, pa0, pa1, pa2, pa3); pv_one<3>(o[3], vb, pa0, pa1, pa2, pa3);
}
__device__ __forceinline__ void attn_dense_body(const bf16* __restrict__ Qb, const bf16* __restrict__ Kh, const bf16* __restrict__ Vh, bf16* __restrict__ Ob, int seq, char* lds) {
  int tid_ = threadIdx.x; asm volatile("" : "+v"(tid_));
  const int tid = tid_, wid = tid >> 6, lane = tid & 63, r32 = lane & 31, hi = lane >> 5;
  bf16* V_lds = (bf16*)lds; bf16* K_lds = (bf16*)(lds + 2 * SHM_V);
  float* ws = (float*)(lds + 2 * SHM_V + 2 * SHM_K) + wid * 64; float* li_l = ws; float* al_l = ws + 32;
  float m_reg = -1e30f, l_reg = 0; f32x16 o[4] = {}; bf16x8 qr[8];
  const bf16* Qw = Qb + (long)(wid * QBLK + r32) * LDQ + hi * 8;
#pragma unroll
  for (int d0 = 0; d0 < 8; ++d0) qr[d0] = *reinterpret_cast<const bf16x8*>(Qw + d0 * 16);
  const int sr = tid >> 4, sc = (tid & 15) * 8, vst0 = v_st(sr, sc), vst1 = v_st(32 + sr, sc);
  const int vb0 = (int)(uintptr_t)V_lds + v_rd_base(lane);
  struct { bf16x8 vs0, vs1, ks0, ks1; } sr_[SDEPTH];
#define SLOAD(i, k0) do { sr_[i].vs0 = *reinterpret_cast<const bf16x8*>(&Vh[(long)((k0) + sr) * LDK + sc]); sr_[i].vs1 = *reinterpret_cast<const bf16x8*>(&Vh[(long)((k0) + 32 + sr) * LDK + sc]); \
    sr_[i].ks0 = *reinterpret_cast<const bf16x8*>(&Kh[(long)((k0) + sr) * LDK + sc]); sr_[i].ks1 = *reinterpret_cast<const bf16x8*>(&Kh[(long)((k0) + 32 + sr) * LDK + sc]); } while (0)
#define SWRITE(b, i) do { *(bf16x8*)((char*)V_lds + (b) * SHM_V + vst0) = sr_[i].vs0;          \
    *(bf16x8*)((char*)V_lds + (b) * SHM_V + vst1) = sr_[i].vs1; int kc = sc * 2;               \
    *(bf16x8*)((char*)K_lds + (b) * SHM_K + KSWZ(sr, kc)) = sr_[i].ks0;                       \
    *(bf16x8*)((char*)K_lds + (b) * SHM_K + KSWZ(32 + sr, kc)) = sr_[i].ks1; } while (0)
#define SWAIT() do { asm volatile("s_waitcnt vmcnt(4)" ::: "memory"); } while (0)
#define RESC(a) do { if (__any((a) < 1.f)) { if (hi == 0) al_l[r32] = (a); asm volatile("s_waitcnt lgkmcnt(0)" ::: "memory"); \
    for (int d = 0; d < 4; ++d) for (int r = 0; r < 16; ++r) o[d][r] *= al_l[crow(r, hi)]; } } while (0)
  f32x16 pA0, pA1, pB0, pB1; float mnA, mnB, alA, alB; bf16x8 pa0, pa1, pa2, pa3; const int NT = seq / KVBLK;
  constexpr int SE = 0, SO = SDEPTH - 1;
  SLOAD(SE, 0); asm volatile("s_waitcnt vmcnt(0)" ::: "memory"); SWRITE(0, SE); __syncthreads();
  qkt(pA0, pA1, K_lds, qr, r32, hi); partialSM(pA0, pA1, m_reg, mnA, alA);
  SLOAD(SO, KVBLK); if (2 < NT) SLOAD(SE, 2 * KVBLK);
  SWAIT(); SWRITE(1, SO); __syncthreads();
  for (int j = 1; j + 1 < NT; j += 2) {
    SBAR(); qkt(pB0, pB1, (bf16*)((char*)K_lds + SHM_K), qr, r32, hi);
    finishSM(pA0, pA1, alA, l_reg, pa0, pa1, pa2, pa3); SBAR();
    SLOAD(SO, (j + SDEPTH) * KVBLK); SBAR();
    pv_d0(o, vb0, pa0, pa1, pa2, pa3); partialSM(pB0, pB1, m_reg, mnB, alB);
    __syncthreads(); SWAIT(); SWRITE(0, SE);
    RESC(alB); __syncthreads();
    SBAR(); qkt(pA0, pA1, K_lds, qr, r32, hi);
    finishSM(pB0, pB1, alB, l_reg, pa0, pa1, pa2, pa3); SBAR();
    if (j + 3 < NT) SLOAD(SE, (j + 1 + SDEPTH) * KVBLK); SBAR();
    pv_d0(o, vb0 + (int)SHM_V, pa0, pa1, pa2, pa3); partialSM(pA0, pA1, m_reg, mnA, alA);
    __syncthreads(); SWAIT(); SWRITE(1, SO);
    RESC(alA); __syncthreads();
  }
  SBAR(); qkt(pB0, pB1, (bf16*)((char*)K_lds + SHM_K), qr, r32, hi);
  finishSM(pA0, pA1, alA, l_reg, pa0, pa1, pa2, pa3); SBAR();
  pv_d0(o, vb0, pa0, pa1, pa2, pa3); partialSM(pB0, pB1, m_reg, mnB, alB);
  __syncthreads(); RESC(alB);
  finishSM(pB0, pB1, alB, l_reg, pa0, pa1, pa2, pa3); SBAR();
  pv_d0(o, vb0 + (int)SHM_V, pa0, pa1, pa2, pa3);
  if (hi == 0) li_l[r32] = l_reg; asm volatile("s_waitcnt lgkmcnt(0)" ::: "memory");
  float rli[16];
#pragma unroll
  for (int r = 0; r < 16; ++r) rli[r] = __builtin_amdgcn_rcpf(li_l[crow(r, hi)]);
  asm volatile("s_waitcnt vmcnt(0) lgkmcnt(0)" ::: "memory");
  __syncthreads();
  char* ost = lds + wid * 8192;
#pragma unroll
  for (int r = 0; r < 16; r += 2) { const int row_a = crow(r, hi), row_b = crow(r + 1, hi);
#pragma unroll
    for (int d0 = 0; d0 < 4; ++d0) { const unsigned w = cvtpk(o[d0][r] * rli[r], o[d0][r + 1] * rli[r + 1]);
      *(unsigned short*)(ost + row_a * 256 + (d0 * 32 + r32) * 2) = (unsigned short)(w & 0xffffu);
      *(unsigned short*)(ost + row_b * 256 + (d0 * 32 + r32) * 2) = (unsigned short)(w >> 16); } }
  asm volatile("s_waitcnt lgkmcnt(0)" ::: "memory");
  bf16* Ow = Ob + (long)(wid * QBLK) * LDO;
#pragma unroll
  for (int i = 0; i < 8; ++i) { const int idx = lane + 64 * i, row = idx >> 4, c16 = idx & 15;
    const u32x4 v = *(const u32x4*)(ost + row * 256 + c16 * 16); *(u32x4*)(Ow + (long)row * LDO + c16 * 8) = v; }
  asm volatile("s_waitcnt lgkmcnt(0)" ::: "memory");
  __syncthreads();
#undef SLOAD
#undef SWRITE
#undef SWAIT
#undef RESC
}
#undef KSWZ
#undef SBAR
}

constexpr int NWAVES = 8;
#ifndef MK_MULTI
#define MK_MULTI 0
#endif

#ifndef PH_P0
#define PH_P0 1
#endif
#ifndef PH_GU
#define PH_GU 1
#endif
#ifndef PH_PLAIN
#define PH_PLAIN 1
#endif
#ifndef PH_ROPE
#define PH_ROPE 1
#endif
#ifndef PH_ATT
#define PH_ATT 1
#endif
#ifndef PH_REC1
#define PH_REC1 1
#endif
#ifndef PH_REC2
#define PH_REC2 1
#endif
#ifndef PH_RES
#define PH_RES 1
#endif
#ifndef PH_FN
#define PH_FN 1
#endif
#ifndef DUP_P0
#define DUP_P0 1
#endif
#ifndef DUP_GU
#define DUP_GU 1
#endif
#ifndef DUP_PLAIN
#define DUP_PLAIN 1
#endif
#ifndef DUP_ATT
#define DUP_ATT 1
#endif
#ifndef DUP_RES
#define DUP_RES 1
#endif
#ifndef DUP_BAR
#define DUP_BAR 1
#endif
#ifndef DUP_REC
#define DUP_REC 1
#endif
constexpr int S = 8192, DM = 2048, DFF = 5632, NGU = 2 * DFF, QKVD = 3072, DRNN = 2048, NFFN = 8, NSB = 12;
constexpr int N_PHASES = 2 + 4 * NSB;
constexpr float NORM_EPS = 1e-6f;

constexpr size_t MiB = 1u << 20;
constexpr size_t WS_CTL = 0, CTL_ZERO_BYTES = 2 * MiB;
constexpr size_t WS_SS = 1 * MiB;
constexpr size_t WS_ROPE = 2 * MiB;
constexpr size_t WS_WG = 3 * MiB;
constexpr size_t WS_AGGS = 7 * MiB;
constexpr size_t WS_AGGC = 15 * MiB;
constexpr size_t WS_WGU = 16 * MiB, SZ_WGU = (size_t)NGU * DM * 2;
constexpr size_t WS_WD = WS_WGU + NFFN * SZ_WGU, SZ_WD = (size_t)DM * DFF * 2;
constexpr size_t WS_WQKV = WS_WD + NFFN * SZ_WD, SZ_WQKV = (size_t)QKVD * DM * 2;
constexpr size_t WS_WO = WS_WQKV + 2 * SZ_WQKV, SZ_WO = (size_t)DM * DM * 2;
constexpr size_t WS_WIN = WS_WO + 2 * SZ_WO, SZ_WIN = (size_t)2 * DRNN * DM * 2;
constexpr size_t WS_WOUT = WS_WIN + 2 * SZ_WIN, SZ_WOUT = (size_t)DM * DRNN * 2;
constexpr size_t WS_XB = WS_WOUT + 2 * SZ_WOUT;
constexpr size_t WS_H = WS_XB + (size_t)S * DM * 2;
constexpr size_t WS_QKV = WS_H + (size_t)S * DFF * 2;
constexpr size_t WS_O = WS_QKV + (size_t)S * QKVD * 2;
constexpr size_t WS_U = WS_O + (size_t)S * DM * 2;
constexpr size_t WS_Y = WS_U + (size_t)S * 2 * DRNN * 2;
constexpr size_t WS_END = WS_Y + (size_t)S * DRNN * 2;
static_assert(WS_WG + 128 * 16384 * 2 <= WS_AGGS && WS_AGGS + 256 * 2 * 2048 * 8 <= WS_AGGC && WS_AGGC + 16 * 2 * 2048 * 8 <= WS_WGU, "small tables do not overlap");
static_assert(WS_SS + 14 * (size_t)S * 8 + 256 <= CTL_ZERO_BYTES, "ss arrays inside the memset region");
static_assert(WS_WGU % 256 == 0 && WS_XB % 256 == 0 && WS_H % 256 == 0 && WS_QKV % 256 == 0 && WS_O % 256 == 0 && WS_U % 256 == 0 && WS_Y % 256 == 0, "alignment");
constexpr int CW_BAR = 4096;

constexpr int RING_OFF = 0, RING_BYTES = 131072;
constexpr int LDSCTL_OFF = RING_BYTES, MISC_OFF = LDSCTL_OFF + 320;
constexpr int LDS_BYTES = 147456;
static_assert(MISC_OFF + 128 <= LDS_BYTES, "LDS map");

#define GAS __attribute__((address_space(1)))
#define LAS __attribute__((address_space(3)))
typedef unsigned short bf16;
typedef unsigned v4u __attribute__((ext_vector_type(4)));
typedef float f32x4 __attribute__((ext_vector_type(4)));
typedef short bf16x8 __attribute__((ext_vector_type(8)));
typedef GAS unsigned gu32;
#define RLX_AGENT __ATOMIC_RELAXED, __HIP_MEMORY_SCOPE_AGENT
#define LDS_WAIT() asm volatile("s_waitcnt lgkmcnt(0)" ::: "memory")
#define VM_WAIT() asm volatile("s_waitcnt vmcnt(0)" ::: "memory")
__device__ __forceinline__ unsigned f2bf(float f) { unsigned u = __builtin_bit_cast(unsigned, f); return (u + 0x7fffu + ((u >> 16) & 1u)) >> 16; }
__device__ __forceinline__ unsigned pk2(float lo, float hi) { return f2bf(lo) | (f2bf(hi) << 16); }
__device__ __forceinline__ float bf_lo(unsigned w) { return __builtin_bit_cast(float, w << 16); }
__device__ __forceinline__ float bf_hi(unsigned w) { return __builtin_bit_cast(float, w & 0xffff0000u); }

#define XB_TMO      128
#define XB_XCNT(j)  (256  + 64 * (j))
#define XB_XSUB(j)  (1280 + 64 * (j))
#define XB_XGEN(j)  (2304 + 64 * (j))
#define XB_TOP      3328
#define XB_TOPGEN   3392
#define XCD_BAR_WORDS 3456
#define XB_SPIN_CAP (1u << 18)

__device__ __forceinline__ unsigned xb_ld(unsigned* p)              { return __hip_atomic_load(p, __ATOMIC_RELAXED, __HIP_MEMORY_SCOPE_AGENT); }
__device__ __forceinline__ unsigned xb_add(unsigned* p, unsigned v) { return __hip_atomic_fetch_add(p, v, __ATOMIC_RELAXED, __HIP_MEMORY_SCOPE_AGENT); }
__device__ __forceinline__ unsigned xb_xcc_id() { return (unsigned)__builtin_amdgcn_s_getreg((3 << 11) | 20) & 0xFu; }
#define XB_SPIN(cond, bar) do { unsigned _sp = 0; while (cond) { __builtin_amdgcn_s_sleep(1); \
    if ((++_sp & 255u) == 0u) { if (xb_ld(&(bar)[XB_TMO])) break; if (_sp > XB_SPIN_CAP) { atomicAdd(&(bar)[XB_TMO], 1u); break; } } } } while (0)

struct XcdBarrier {
    unsigned* bar; unsigned x;
    volatile LAS unsigned* st;
};

__device__ __forceinline__ XcdBarrier xcd_barrier_post(unsigned* bar, volatile LAS unsigned* st) {
    XcdBarrier b; b.bar = bar; b.x = xb_xcc_id(); b.st = st;
    if (threadIdx.x == 0) (void)xb_add(&bar[XB_XCNT(b.x)], 1u);
    return b;
}
__device__ __forceinline__ void xcd_barrier_complete(unsigned* bar, unsigned x, unsigned& nloc, unsigned& nx) {
    const unsigned G = gridDim.x * gridDim.y * gridDim.z;
    unsigned sum, cnt, mine, sp = 0u;
    for (;;) {
        sum = 0u; cnt = 0u; mine = 0u;
#pragma unroll
        for (unsigned j = 0; j < 16; ++j) { const unsigned c = xb_ld(&bar[XB_XCNT(j)]); sum += c; cnt += (c > 0u) ? 1u : 0u; mine = (j == x) ? c : mine; }
        if (sum == G) break;
        __builtin_amdgcn_s_sleep(1);
        if ((++sp & 255u) == 0u) { if (xb_ld(&bar[XB_TMO])) break; if (sp > XB_SPIN_CAP) { atomicAdd(&bar[XB_TMO], 1u); break; } }
    }
    nloc = mine > 0u ? mine : 1u; nx = cnt > 0u ? cnt : 1u;
}

__device__ __forceinline__ void xcd_barrier(const XcdBarrier& b) {
    asm volatile("s_waitcnt vmcnt(0)" ::: "memory");
    __syncthreads();
    if (threadIdx.x == 0) {
        unsigned* bar = b.bar;
        __builtin_amdgcn_s_waitcnt(0);
        unsigned nloc = b.st[0], nx = b.st[1];
        if (nloc == 0u) { xcd_barrier_complete(bar, b.x, nloc, nx); b.st[0] = nloc; b.st[1] = nx; }
        const unsigned old = xb_add(&bar[XB_XSUB(b.x)], 1u);
        const unsigned gen = old / nloc;
        if (old + 1u == (gen + 1u) * nloc) {
            __builtin_amdgcn_fence(__ATOMIC_RELEASE, "agent");
            asm volatile("s_waitcnt vmcnt(0)" ::: "memory");
            const unsigned og = xb_add(&bar[XB_TOP], 1u);
            const unsigned tg = og / nx;
            if (og + 1u == (tg + 1u) * nx) xb_add(&bar[XB_TOPGEN], 1u);
            else XB_SPIN(xb_ld(&bar[XB_TOPGEN]) == tg, bar);
            __builtin_amdgcn_fence(__ATOMIC_ACQUIRE, "agent");
            xb_add(&bar[XB_XGEN(b.x)], 1u);
            asm volatile("s_waitcnt vmcnt(0)" ::: "memory");
        } else {
            XB_SPIN(xb_ld(&bar[XB_XGEN(b.x)]) == gen, bar);
            __builtin_amdgcn_fence(__ATOMIC_ACQUIRE, "agent");
            asm volatile("s_waitcnt vmcnt(0)" ::: "memory");
        }
    }
    __syncthreads();
}
#define OPAQUE_LANE() int tid_ = threadIdx.x; asm volatile("" : "+v"(tid_)); const int lane_ = tid_ & 63, wave_ = __builtin_amdgcn_readfirstlane(tid_ >> 6); (void)lane_; (void)wave_
struct Frame {
    LAS unsigned char* lds;
    volatile LAS unsigned* MISC;
    gu32* ctl;
    int tid, lane, wave;
    int vcu, G;
    unsigned char* ws;
    const float* const* in;
};
__device__ __forceinline__ float wave_sum(float v) {
#pragma unroll
    for (int o = 1; o < 64; o <<= 1) v += __shfl_xor(v, o);
    return v;
}
__device__ __forceinline__ void p0_transpose_item(const float* W, int K, int N, bf16* WT, const float* gain, int gu_mode, LAS float* scr, int item, int lane) {
    const int nblk = N / 32, kb = item / nblk, nb = item - kb * nblk, k0 = 64 * kb, n0 = 32 * nb;
    const int c = lane & 7;
    f32x4 g0 = (f32x4){1.f, 1.f, 1.f, 1.f}, g1 = g0;
    if (gain) { g0 = *(const GAS f32x4*)(gain + k0 + 8 * c); g1 = *(const GAS f32x4*)(gain + k0 + 8 * c + 4); }
    const GAS float* src = (const GAS float*)W + (size_t)(k0 + (lane >> 5)) * N + n0 + (lane & 31);
    float v[32];
#pragma unroll
    for (int i = 0; i < 32; ++i) v[i] = src[(size_t)(2 * i) * N];
#pragma unroll
    for (int i = 0; i < 32; ++i) scr[(2 * i + (lane >> 5)) * 33 + (lane & 31)] = v[i];
    LDS_WAIT(); asm volatile("" ::: "memory");
    int d0 = n0; if (gu_mode) { const int isu = n0 >= DFF ? 1 : 0, nn = n0 - isu * DFF; d0 = (nn >> 7) * 256 + isu * 128 + (nn & 127); }
#pragma unroll
    for (int j = 0; j < 4; ++j) { const int n = (lane >> 3) + 8 * j; const LAS float* s = scr + (8 * c) * 33 + n;
        v4u o; o.x = pk2(s[0 * 33] * g0.x, s[1 * 33] * g0.y); o.y = pk2(s[2 * 33] * g0.z, s[3 * 33] * g0.w); o.z = pk2(s[4 * 33] * g1.x, s[5 * 33] * g1.y); o.w = pk2(s[6 * 33] * g1.z, s[7 * 33] * g1.w);
        *(GAS v4u*)(WT + (size_t)(d0 + n) * K + k0 + 8 * c) = o; }
    LDS_WAIT(); asm volatile("" ::: "memory");
}
__device__ __forceinline__ void sincos_acc(float ang, float& sn, float& cs) {
    const double a = (double)ang; const double kq = __builtin_rint(a * 0.63661977236758134308);
    double r = __builtin_fma(-kq, 1.5707963267948966192, a); r = __builtin_fma(-kq, 6.123233995736766036e-17, r);
    const double r2 = r * r;
    double ps = -1.0 / 1307674368000.0; ps = ps * r2 + 1.0 / 6227020800.0; ps = ps * r2 - 1.0 / 39916800.0; ps = ps * r2 + 1.0 / 362880.0; ps = ps * r2 - 1.0 / 5040.0; ps = ps * r2 + 1.0 / 120.0; ps = ps * r2 - 1.0 / 6.0; ps = ps * r2 + 1.0;
    const double s = ps * r;
    double pc = 1.0 / 20922789888000.0; pc = pc * r2 - 1.0 / 87178291200.0; pc = pc * r2 + 1.0 / 479001600.0; pc = pc * r2 - 1.0 / 3628800.0; pc = pc * r2 + 1.0 / 40320.0; pc = pc * r2 - 1.0 / 720.0; pc = pc * r2 + 1.0 / 24.0; pc = pc * r2 - 0.5; pc = pc * r2 + 1.0;
    const int q = ((int)kq) & 3;
    const double ss = (q == 0) ? s : (q == 1) ? pc : (q == 2) ? -s : -pc;
    const double cc = (q == 0) ? pc : (q == 1) ? -s : (q == 2) ? -pc : s;
    sn = (float)ss; cs = (float)cc;
}
__device__ __forceinline__ void p0_prologue(Frame& F) {
    OPAQUE_LANE();
    LAS float* scr = (LAS float*)(F.lds + RING_OFF + wave_ * 16384);
    const int gw = F.vcu * NWAVES + wave_, NGW = F.G * NWAVES;
    constexpr int I_GU = (DM / 64) * (NGU / 32), I_D = (DFF / 64) * (DM / 32), I_QKV = (DM / 64) * (QKVD / 32), I_O = (DM / 64) * (DM / 32), I_IN = (DM / 64) * (2 * DRNN / 32), I_OUT = (DRNN / 64) * (DM / 32), I_G = 8;
    constexpr int NITEMS = NFFN * (I_GU + I_D) + 2 * (I_QKV + I_O + I_IN + I_OUT) + 128 * I_G;
    for (int it = gw; it < NITEMS; it += NGW) {
        int r = it; const float* W; bf16* WT; const float* gain = nullptr; int K, N, gm = 0, item;
        if (r < NFFN * I_GU) { const int f = r / I_GU; item = r - f * I_GU; W = F.in[2] + (size_t)f * DM * NGU; K = DM; N = NGU; WT = (bf16*)(F.ws + WS_WGU + f * SZ_WGU); gain = F.in[1] + f * DM; gm = 1; }
        else if ((r -= NFFN * I_GU) < NFFN * I_D) { const int f = r / I_D; item = r - f * I_D; W = F.in[3] + (size_t)f * DFF * DM; K = DFF; N = DM; WT = (bf16*)(F.ws + WS_WD + f * SZ_WD); }
        else if ((r -= NFFN * I_D) < 2 * I_QKV) { const int l = r / I_QKV; item = r - l * I_QKV; W = F.in[5] + (size_t)l * DM * QKVD; K = DM; N = QKVD; WT = (bf16*)(F.ws + WS_WQKV + l * SZ_WQKV); gain = F.in[4] + l * DM; }
        else if ((r -= 2 * I_QKV) < 2 * I_O) { const int l = r / I_O; item = r - l * I_O; W = F.in[8] + (size_t)l * DM * DM; K = DM; N = DM; WT = (bf16*)(F.ws + WS_WO + l * SZ_WO); }
        else if ((r -= 2 * I_O) < 2 * I_IN) { const int l = r / I_IN; item = r - l * I_IN; W = F.in[10] + (size_t)l * DM * 2 * DRNN; K = DM; N = 2 * DRNN; WT = (bf16*)(F.ws + WS_WIN + l * SZ_WIN); gain = F.in[9] + l * DM; }
        else if ((r -= 2 * I_IN) < 2 * I_OUT) { const int l = r / I_OUT; item = r - l * I_OUT; W = F.in[16] + (size_t)l * DRNN * DM; K = DRNN; N = DM; WT = (bf16*)(F.ws + WS_WOUT + l * SZ_WOUT); }
        else { r -= 2 * I_OUT; const int b = r / I_G; item = r - b * I_G; W = F.in[13] + (size_t)b * 16384; K = 128; N = 128; WT = (bf16*)(F.ws + WS_WG) + (size_t)b * 16384; }
        p0_transpose_item(W, K, N, WT, gain, gm, scr, item, lane_);
    }
    { bf16* XB = (bf16*)(F.ws + WS_XB); pg8::ss_t* ss0 = (pg8::ss_t*)(F.ws + WS_SS);
      for (int m = gw; m < S; m += NGW) {
        const GAS f32x4* xr = (const GAS f32x4*)(F.in[0] + (size_t)m * DM) + lane_; f32x4 v[8]; float s = 0.f;
#pragma unroll
        for (int j = 0; j < 8; ++j) { v[j] = xr[64 * j]; s += (v[j].x * v[j].x + v[j].y * v[j].y) + (v[j].z * v[j].z + v[j].w * v[j].w); }
        s = wave_sum(s); if (lane_ == 0) ss0[m] = (pg8::ss_t)(s * pg8::SS_SCALE);
        GAS unsigned long long* o8 = (GAS unsigned long long*)(XB + (size_t)m * DM) + lane_;
#pragma unroll
        for (int j = 0; j < 8; ++j) o8[64 * j] = (unsigned long long)pk2(v[j].x, v[j].y) | ((unsigned long long)pk2(v[j].z, v[j].w) << 32);
      } }
    { float* rt = (float*)(F.ws + WS_ROPE); const int gt = (F.vcu * NWAVES + wave_) * 64 + lane_;
      for (int e = gt; e < (128 + 64) * 32; e += NGW * 64) { const int f = e & 31, pe = e >> 5; const int isc = pe >= 128 ? 1 : 0, pos = pe - isc * 128;
        double inv = 1.0; for (int k = 0; k < f; ++k) inv *= 0.74989420933245582730;
        const float ang = (float)pos * (float)inv; float sn, cs; sincos_acc(ang, sn, cs);
        float* cst = rt + (isc ? 8192 : 0); const int nel = isc ? 2048 : 4096;
        cst[pos * 32 + f] = cs; cst[nel + pos * 32 + f] = sn; } }
}
__device__ __forceinline__ void rope_phase(Frame& F, const float* qg, const float* kg) {
    OPAQUE_LANE();
    bf16* QKV = (bf16*)(F.ws + WS_QKV); const float* rt = (const float*)(F.ws + WS_ROPE);
    const int gw = F.vcu * NWAVES + wave_, NGW = F.G * NWAVES, g = lane_ >> 4, j = lane_ & 15;
    const int d = 8 * j, axis = d >> 6, first = ((d & 63) < 32) ? 1 : 0, f0 = d & 31;
    const float* gq = qg + d; const float* gk = kg + d;
    f32x4 gq0 = *(const f32x4*)gq, gq1 = *(const f32x4*)(gq + 4), gk0 = *(const f32x4*)gk, gk1 = *(const f32x4*)(gk + 4);
    for (int it = gw; it < S * 5; it += NGW) {
        const int row = it / 5, part = it - row * 5;
        bf16* p = QKV + (size_t)row * QKVD + part * 512 + g * 128 + d;
        const v4u w = *(const GAS v4u*)p;
        float x[8] = {bf_lo(w.x), bf_hi(w.x), bf_lo(w.y), bf_hi(w.y), bf_lo(w.z), bf_hi(w.z), bf_lo(w.w), bf_hi(w.w)};
        float ssq = 0.f;
#pragma unroll
        for (int e = 0; e < 8; ++e) ssq += x[e] * x[e];
        ssq += __shfl_xor(ssq, 1); ssq += __shfl_xor(ssq, 2); ssq += __shfl_xor(ssq, 4); ssq += __shfl_xor(ssq, 8);
        const float rstd = __builtin_amdgcn_rsqf(ssq * (1.0f / 128.0f) + NORM_EPS);
        const f32x4 g0 = part < 4 ? gq0 : gk0, g1 = part < 4 ? gq1 : gk1;
        const float gn[8] = {g0.x, g0.y, g0.z, g0.w, g1.x, g1.y, g1.z, g1.w};
        const int pos = axis ? (row & 63) : (row >> 6);
        const float* ct = rt + (axis ? 8192 : 0) + pos * 32 + f0; const float* st = ct + (axis ? 2048 : 4096);
        const f32x4 c0 = *(const f32x4*)ct, c1 = *(const f32x4*)(ct + 4), s0 = *(const f32x4*)st, s1 = *(const f32x4*)(st + 4);
        const float cs[8] = {c0.x, c0.y, c0.z, c0.w, c1.x, c1.y, c1.z, c1.w}, sn[8] = {s0.x, s0.y, s0.z, s0.w, s1.x, s1.y, s1.z, s1.w};
        float o[8];
#pragma unroll
        for (int e = 0; e < 8; ++e) { const float xn = x[e] * rstd * gn[e]; const float pn = __shfl_xor(xn, 4);
            o[e] = first ? (xn * cs[e] - pn * sn[e]) : (xn * cs[e] + pn * sn[e]); }
        v4u ow; ow.x = pk2(o[0], o[1]); ow.y = pk2(o[2], o[3]); ow.z = pk2(o[4], o[5]); ow.w = pk2(o[6], o[7]);
        *(GAS v4u*)p = ow;
    }
}
__device__ __forceinline__ void attn_phase(Frame& F, char* lds) {
    const att::bf16* QKV = (const att::bf16*)(F.ws + WS_QKV); att::bf16* O = (att::bf16*)(F.ws + WS_O);
    for (int u = F.vcu; u < 512; u += F.G) {
        const int i = u >> 8, x = (u & 255) >> 5, l = u & 31, kvh = x >> 1, h = kvh * 4 + (x & 1) * 2 + i, qb = l;
        att::attn_dense_body(QKV + (size_t)(qb * 256) * QKVD + h * 128, QKV + 2048 + kvh * 128, QKV + 2560 + kvh * 128, O + (size_t)(qb * 256) * DM + h * 128, S, lds);
    }
}
constexpr int SC_AT = 0, SC_ATP = 272;
constexpr int SC_XF = 9216, SC_XFP = 528;
constexpr int SC_AB = 26624;
constexpr int SC_CR = 92160;
#ifdef DBG_REC
#define DBG_CHECK(code, bad) do { if (bad) atomicMax((unsigned*)(F.ws + 2 * MiB - 256), 100u - (unsigned)(code)); } while (0)
#else
#define DBG_CHECK(code, bad) do { } while (0)
#endif
__device__ __forceinline__ bool nonfinite(float x) { return !(__builtin_fabsf(x) < 3.0e38f); }
struct RecArgs { const bf16* U; const bf16* Wg; const float* gate_b; const float* lam; const float* conv_w; const float* conv_b; float2* aggs; float2* aggc; bf16* Y; };
__device__ __forceinline__ float sigmoid_f(float x) { return __builtin_amdgcn_rcpf(1.0f + __builtin_amdgcn_exp2f(x * -1.4426950408889634f)); }
template <int PASS>
__device__ __forceinline__ void rec_pass(Frame& F, char* lds, const RecArgs& R) {
    typedef float f32x4v __attribute__((ext_vector_type(4)));
    OPAQUE_LANE();
    const int tid = tid_, lane = lane_, w = wave_, wd = w >> 2, wq = w & 3, l15 = lane & 15, l4 = lane >> 4;
    const int tl = tid >> 4, c8 = (tid & 15) * 8;
    const int sd = tid >> 7, sch = tid & 127;
    for (int item = F.vcu; item < 256; item += F.G) {
        const int n = item & 15, c = item >> 4;
        bf16x8 bfr[2][2][4];
#pragma unroll
        for (int z = 0; z < 2; ++z)
#pragma unroll
            for (int nt = 0; nt < 2; ++nt)
#pragma unroll
                for (int ks = 0; ks < 4; ++ks)
                    bfr[z][nt][ks] = *(const GAS bf16x8*)(R.Wg + ((size_t)(((wd * 2 + z) * 16 + n) * 128 + wq * 32 + nt * 16 + l15)) * 128 + ks * 32 + l4 * 8);
#ifdef DBG_REC
        { bool bad = false, big = false;
          for (int z = 0; z < 2; ++z) for (int nt = 0; nt < 2; ++nt) for (int ks = 0; ks < 4; ++ks) for (int e = 0; e < 8; ++e) { const float v = __builtin_bit_cast(float, ((unsigned)(unsigned short)bfr[z][nt][ks][e]) << 16); bad |= nonfinite(v); big |= __builtin_fabsf(v) > 100.f; }
          DBG_CHECK(1, bad); DBG_CHECK(2, big); }
#endif
        float br[2], bi[2], sp[2];
#pragma unroll
        for (int nt = 0; nt < 2; ++nt) { const int ch = n * 128 + wq * 32 + nt * 16 + l15; br[nt] = R.gate_b[(wd * 2 + 0) * DRNN + ch]; bi[nt] = R.gate_b[(wd * 2 + 1) * DRNN + ch];
            const float lm = R.lam[wd * DRNN + ch]; sp[nt] = 8.0f * log1pf(__expf(-lm)); }
        float cw[4][8], cb[8];
        { const int ch0 = n * 128 + c8;
#pragma unroll
          for (int tp = 0; tp < 4; ++tp) { const f32x4v a = *(const f32x4v*)(R.conv_w + tp * DRNN + ch0), b = *(const f32x4v*)(R.conv_w + tp * DRNN + ch0 + 4);
              cw[tp][0] = a.x; cw[tp][1] = a.y; cw[tp][2] = a.z; cw[tp][3] = a.w; cw[tp][4] = b.x; cw[tp][5] = b.y; cw[tp][6] = b.z; cw[tp][7] = b.w; }
          const f32x4v a = *(const f32x4v*)(R.conv_b + ch0), b = *(const f32x4v*)(R.conv_b + ch0 + 4);
          cb[0] = a.x; cb[1] = a.y; cb[2] = a.z; cb[3] = a.w; cb[4] = b.x; cb[5] = b.y; cb[6] = b.z; cb[7] = b.w; }
        float aggA = 1.f, aggB = 0.f;
        if (PASS == 2 && tid < 256) {
            const int ch = n * 128 + sch; float h = 0.f; float* cr = (float*)(lds + SC_CR);
            if (sd == 0) { for (int cc = 0; cc < c; ++cc) { const float2 ab = R.aggc[(size_t)(cc * 2 + 0) * DRNN + ch]; h = ab.x * h + ab.y; }
                for (int s = 0; s < 16; ++s) { cr[(s * 2 + 0) * 128 + sch] = h; const float2 ab = R.aggs[(size_t)((c * 16 + s) * 2 + 0) * DRNN + ch]; h = ab.x * h + ab.y; } }
            else { for (int cc = 15; cc > c; --cc) { const float2 ab = R.aggc[(size_t)(cc * 2 + 1) * DRNN + ch]; h = ab.x * h + ab.y; }
                for (int s = 15; s >= 0; --s) { cr[(s * 2 + 1) * 128 + sch] = h; const float2 ab = R.aggs[(size_t)((c * 16 + s) * 2 + 1) * DRNN + ch]; h = ab.x * h + ab.y; } }
        }
        for (int s = 0; s < 16; ++s) {
            const int t0 = c * 512 + s * 32;
            { float xc[8];
#pragma unroll
              for (int e = 0; e < 8; ++e) xc[e] = cb[e];
              const int t = t0 + tl;
#pragma unroll
              for (int tp = 0; tp < 4; ++tp) { const int tt = t + tp - 2;
                  if (tt >= 0 && tt < S) { const v4u wv = *(const GAS v4u*)(R.U + (size_t)tt * (2 * DRNN) + DRNN + n * 128 + c8);
                      xc[0] += cw[tp][0] * bf_lo(wv.x); xc[1] += cw[tp][1] * bf_hi(wv.x); xc[2] += cw[tp][2] * bf_lo(wv.y); xc[3] += cw[tp][3] * bf_hi(wv.y);
                      xc[4] += cw[tp][4] * bf_lo(wv.z); xc[5] += cw[tp][5] * bf_hi(wv.z); xc[6] += cw[tp][6] * bf_lo(wv.w); xc[7] += cw[tp][7] * bf_hi(wv.w); } }
              { bool bad = false; for (int e = 0; e < 8; ++e) bad |= nonfinite(xc[e]); DBG_CHECK(5, bad); }
              v4u o; o.x = pk2(xc[0], xc[1]); o.y = pk2(xc[2], xc[3]); o.z = pk2(xc[4], xc[5]); o.w = pk2(xc[6], xc[7]);
              *(v4u*)(lds + SC_AT + tl * SC_ATP + c8 * 2) = o;
              *(f32x4v*)(lds + SC_XF + tl * SC_XFP + c8 * 4) = (f32x4v){xc[0], xc[1], xc[2], xc[3]};
              *(f32x4v*)(lds + SC_XF + tl * SC_XFP + c8 * 4 + 16) = (f32x4v){xc[4], xc[5], xc[6], xc[7]}; }
            __syncthreads();
#pragma unroll
            for (int mt = 0; mt < 2; ++mt) {
                bf16x8 af[4];
#pragma unroll
                for (int ks = 0; ks < 4; ++ks) af[ks] = *(const bf16x8*)(lds + SC_AT + (mt * 16 + l15) * SC_ATP + (ks * 32 + l4 * 8) * 2);
#ifdef DBG_REC
                { bool bad = false, big = false; for (int ks = 0; ks < 4; ++ks) for (int e = 0; e < 8; ++e) { const float v = __builtin_bit_cast(float, ((unsigned)(unsigned short)af[ks][e]) << 16); bad |= nonfinite(v); big |= __builtin_fabsf(v) > 1.0e4f; } DBG_CHECK(3, bad); DBG_CHECK(4, big); }
#endif
                f32x4v acc[2][2];
#pragma unroll
                for (int z = 0; z < 2; ++z)
#pragma unroll
                    for (int nt = 0; nt < 2; ++nt) { acc[z][nt] = (f32x4v){0.f, 0.f, 0.f, 0.f};
#pragma unroll
                        for (int ks = 0; ks < 4; ++ks) acc[z][nt] = __builtin_amdgcn_mfma_f32_16x16x32_bf16(af[ks], bfr[z][nt][ks], acc[z][nt], 0, 0, 0); }
#pragma unroll
                for (int nt = 0; nt < 2; ++nt)
#pragma unroll
                    for (int rg = 0; rg < 4; ++rg) { const int tt = mt * 16 + l4 * 4 + rg, chl = wq * 32 + nt * 16 + l15;
                        const float rgate = sigmoid_f(acc[0][nt][rg] + br[nt]), igate = sigmoid_f(acc[1][nt][rg] + bi[nt]);
                        const float la = -sp[nt] * rgate, a = __expf(la), x2 = 2.0f * la;
                        const float em = (x2 > -0.25f) ? -x2 * (1.0f + x2 * (0.5f + x2 * (0.16666667f + x2 * (0.041666668f + x2 * (0.0083333338f + x2 * 0.0013888889f))))) : (1.0f - a * a);
                        const float xv = *(const float*)(lds + SC_XF + tt * SC_XFP + chl * 4);
                        const float bb = __builtin_sqrtf(em) * igate * xv;
                        DBG_CHECK(6, nonfinite(acc[0][nt][rg]) || nonfinite(acc[1][nt][rg])); DBG_CHECK(7, nonfinite(a) || a > 1.0f || a < 0.f); DBG_CHECK(31, nonfinite(xv)); DBG_CHECK(32, nonfinite(em) || em < 0.f); DBG_CHECK(33, nonfinite(igate)); DBG_CHECK(25, nonfinite(bb));
                        *(float*)(lds + SC_AB + ((wd * 2 + 0) * 32 + tt) * 512 + chl * 4) = a;
                        *(float*)(lds + SC_AB + ((wd * 2 + 1) * 32 + tt) * 512 + chl * 4) = bb; }
            }
            __syncthreads();
            if (tid < 256) {
                const float* pa = (const float*)(lds + SC_AB + (sd * 2 + 0) * 16384) + sch; float* pb = (float*)(lds + SC_AB + (sd * 2 + 1) * 16384) + sch;
                if (PASS == 1) {
                    float P = 1.f, h = 0.f;
#pragma unroll 8
                    for (int k = 0; k < 32; ++k) { const int t = sd ? 31 - k : k; const float a = pa[t * 128], b = pb[t * 128]; h = a * h + b; P *= a; DBG_CHECK(34, nonfinite(a) || a > 1.0f); DBG_CHECK(35, nonfinite(b)); }
                    DBG_CHECK(26, nonfinite(h) || nonfinite(P));
                    R.aggs[(size_t)((c * 16 + s) * 2 + sd) * DRNN + n * 128 + sch] = make_float2(P, h);
                    if (sd == 0) { aggB = P * aggB + h; aggA = P * aggA; } else { aggB = aggA * h + aggB; aggA = aggA * P; }
                } else {
                    float h = *((const float*)(lds + SC_CR) + (s * 2 + sd) * 128 + sch);
                    DBG_CHECK(27, nonfinite(h));
#pragma unroll 8
                    for (int k = 0; k < 32; ++k) { const int t = sd ? 31 - k : k; const float a = pa[t * 128], b = pb[t * 128]; h = a * h + b; pb[t * 128] = h; }
                    DBG_CHECK(28, nonfinite(h));
                }
            }
            if (PASS == 2) {
                __syncthreads();
                const float* hf = (const float*)(lds + SC_AB + 1 * 16384 + tl * 512 + c8 * 4); const float* hb = (const float*)(lds + SC_AB + 3 * 16384 + tl * 512 + c8 * 4);
                const f32x4v f0 = *(const f32x4v*)hf, f1 = *(const f32x4v*)(hf + 4), b0 = *(const f32x4v*)hb, b1 = *(const f32x4v*)(hb + 4);
                const int t = t0 + tl;
                const v4u gv = *(const GAS v4u*)(R.U + (size_t)t * (2 * DRNN) + n * 128 + c8);
                const float gx[8] = {bf_lo(gv.x), bf_hi(gv.x), bf_lo(gv.y), bf_hi(gv.y), bf_lo(gv.z), bf_hi(gv.z), bf_lo(gv.w), bf_hi(gv.w)};
                const float hs[8] = {f0.x + b0.x, f0.y + b0.y, f0.z + b0.z, f0.w + b0.w, f1.x + b1.x, f1.y + b1.y, f1.z + b1.z, f1.w + b1.w};
                { bool bad = false; for (int e = 0; e < 8; ++e) bad |= nonfinite(gx[e]); DBG_CHECK(29, bad); bad = false; for (int e = 0; e < 8; ++e) bad |= nonfinite(hs[e]); DBG_CHECK(36, bad); }
                float y[8];
#pragma unroll
                for (int e = 0; e < 8; ++e) { const float v = gx[e]; const float u = 1.5957691216057308f * (v + 0.044715f * v * v * v); y[e] = v * sigmoid_f(u) * hs[e];
                    DBG_CHECK(30, nonfinite(y[e]));
#ifdef DBG_SANITIZE_Y
                    if (!(__builtin_fabsf(y[e]) < 1e30f)) y[e] = 0.f;
#endif
                }
                v4u o; o.x = pk2(y[0], y[1]); o.y = pk2(y[2], y[3]); o.z = pk2(y[4], y[5]); o.w = pk2(y[6], y[7]);
                *(GAS v4u*)(R.Y + (size_t)t * DRNN + n * 128 + c8) = o;
            }
        }
        if (PASS == 1 && tid < 256) R.aggc[(size_t)(c * 2 + sd) * DRNN + n * 128 + sch] = make_float2(aggA, aggB);
        __syncthreads();
    }
}
__device__ __forceinline__ void final_norm_phase(Frame& F, float* X, const pg8::ss_t* ss, const float* g) {
    OPAQUE_LANE();
    const int gw = F.vcu * NWAVES + wave_, NGW = F.G * NWAVES;
    f32x4 gv[8];
#pragma unroll
    for (int j = 0; j < 8; ++j) gv[j] = *((const GAS f32x4*)g + lane_ + 64 * j);
    for (int m = gw; m < S; m += NGW) { GAS f32x4* xr = (GAS f32x4*)(X + (size_t)m * DM) + lane_; const float rs = pg8::rs_from_ss(ss[m]);
#pragma unroll
        for (int j = 0; j < 8; ++j) { const f32x4 v = xr[64 * j]; xr[64 * j] = v * rs * gv[j]; } }
#ifdef DBG_REC
    { const unsigned code = *(const unsigned*)(F.ws + 2 * MiB - 256); if (code && gw == 0 && lane_ == 0) { VM_WAIT(); X[0] = 1000.0f * (float)(100u - code); } }
#endif
}
__device__ __forceinline__ int opaque_i(int v) { asm volatile("" : "+s"(v)); return v; }
struct Args { const float* in[18]; float* out; unsigned char* ws; int ph_lo, ph_hi; };
static_assert(sizeof(Args) == 18 * 8 + 8 + 8 + 8, "Args has no padding");
__global__ void __launch_bounds__(NWAVES * 64, 2) mega_fwd(Args args) {
    extern __shared__ __attribute__((aligned(16))) unsigned char lds[];
    Frame F;
    F.lds = (LAS unsigned char*)lds;
    F.MISC = (volatile LAS unsigned*)(F.lds + MISC_OFF);
    F.tid = threadIdx.x; F.lane = F.tid & 63; F.wave = __builtin_amdgcn_readfirstlane(F.tid >> 6);
    F.G = gridDim.x; { const int bx = blockIdx.x; F.vcu = (F.G % 8 == 0) ? (bx % 8) * (F.G / 8) + bx / 8 : bx; }
    F.ws = args.ws; F.ctl = (gu32*)(args.ws + WS_CTL); F.in = args.in;
    for (int u = F.tid; u < (LDS_BYTES - LDSCTL_OFF) / 4; u += NWAVES * 64) ((LAS unsigned*)(F.lds + LDSCTL_OFF))[u] = 0u;
    __syncthreads();
    const int lo = args.ph_lo, hi = args.ph_hi;
    const bool use_bar = (hi - lo) > 1;
    XcdBarrier bar; bar.bar = (unsigned*)(F.ctl + CW_BAR); bar.x = 0; bar.st = nullptr;
    if (use_bar) bar = xcd_barrier_post((unsigned*)(F.ctl + CW_BAR), F.MISC + 8);
#define IN(k) (lo <= (k) && (k) < hi)
#define REP(n) for (int rep_ = 0, nrep_ = opaque_i(n); rep_ < nrep_; ++rep_)
#define SEAM(k) do { if (IN((k) + 1)) { REP(DUP_BAR) xcd_barrier(bar); } } while (0)
    pg8::ss_t* const ssb = (pg8::ss_t*)(args.ws + WS_SS);
    bf16* const XB = (bf16*)(args.ws + WS_XB);

    #if PH_P0
    if (IN(0)) { REP(DUP_P0) p0_prologue(F); SEAM(0); }
#endif

    for (int sb = 0; sb < NSB; ++sb) {
        const int p6 = sb / 6, k6 = sb - 6 * p6;
        const int type = (k6 == 1) ? 1 : (k6 == 4) ? 2 : 0;
        const int f = 4 * p6 + (k6 == 0 ? 0 : k6 == 2 ? 1 : k6 == 3 ? 2 : 3);
        const int pb = 1 + 4 * sb;
        const pg8::ss_t* ss_in = ssb + (size_t)sb * S; pg8::ss_t* ss_out = ssb + (size_t)(sb + 1) * S;
        if (IN(pb)) {
#if PH_GU
            if (type == 0) {
                pg8::Gemm g{XB, (const bf16*)(args.ws + WS_WGU + f * SZ_WGU), S, NGU, DM}; pg8::StaticOrder So; So.init(S, NGU, F.G, (int)blockIdx.x);
                pg8::EpiSwiglu E{(bf16*)(args.ws + WS_H), ss_in};
                REP(DUP_GU) pg8::gemm_phase<pg8::EpiSwiglu, pg8::StaticOrder, true, true>(F.lds + RING_OFF, g, So, E);
            }
#endif
#if PH_PLAIN
            if (type != 0) {
                const int N = (type == 1) ? QKVD : 2 * DRNN;
                const bf16* Wt = (type == 1) ? (const bf16*)(args.ws + WS_WQKV + p6 * SZ_WQKV) : (const bf16*)(args.ws + WS_WIN + p6 * SZ_WIN);
                bf16* Out = (type == 1) ? (bf16*)(args.ws + WS_QKV) : (bf16*)(args.ws + WS_U);
                pg8::Gemm g{XB, Wt, S, N, DM}; pg8::StaticOrder So; So.init(S, N, F.G, (int)blockIdx.x);
                pg8::EpiPlain E{Out, N, ss_in};
                REP(DUP_PLAIN) pg8::gemm_phase<pg8::EpiPlain, pg8::StaticOrder, true, true>(F.lds + RING_OFF, g, So, E);
            }
#endif
            SEAM(pb);
        }
        if (type == 1) {
#if PH_ROPE
            if (IN(pb + 1)) { rope_phase(F, args.in[6] + p6 * 128, args.in[7] + p6 * 128); SEAM(pb + 1); }
#endif
#if PH_ATT
            if (IN(pb + 2)) { REP(DUP_ATT) attn_phase(F, (char*)lds + RING_OFF); SEAM(pb + 2); }
#endif
        } else if (type == 2) {
            const RecArgs R{(const bf16*)(args.ws + WS_U), (const bf16*)(args.ws + WS_WG) + (size_t)p6 * (4 * 16 * 16384), args.in[14] + p6 * 4 * DRNN, args.in[15] + p6 * 2 * DRNN,
                            args.in[11] + p6 * 4 * DRNN, args.in[12] + p6 * DRNN, (float2*)(args.ws + WS_AGGS), (float2*)(args.ws + WS_AGGC), (bf16*)(args.ws + WS_Y)};
#if PH_REC1
            if (IN(pb + 1)) { REP(DUP_REC) rec_pass<1>(F, (char*)lds + RING_OFF, R); SEAM(pb + 1); }
#endif
#if PH_REC2
            if (IN(pb + 2)) { REP(DUP_REC) rec_pass<2>(F, (char*)lds + RING_OFF, R); SEAM(pb + 2); }
#endif
        }
#if PH_RES
        if (IN(pb + 3)) {
            const bf16* A = (type == 0) ? (const bf16*)(args.ws + WS_H) : (type == 1) ? (const bf16*)(args.ws + WS_O) : (const bf16*)(args.ws + WS_Y);
            const bf16* Wt = (type == 0) ? (const bf16*)(args.ws + WS_WD + f * SZ_WD) : (type == 1) ? (const bf16*)(args.ws + WS_WO + p6 * SZ_WO) : (const bf16*)(args.ws + WS_WOUT + p6 * SZ_WOUT);
            const int K = (type == 0) ? DFF : DM;
            pg8::Gemm g{A, Wt, S, DM, K}; pg8::StaticOrder So; So.init(S, DM, F.G, (int)blockIdx.x);
            REP(DUP_RES) {
                const bool real = (rep_ == nrep_ - 1);
                pg8::EpiResid E{sb == 0 ? args.in[0] : (const float*)args.out, args.out, XB, real ? ss_out : ssb + (size_t)13 * S, real ? (type == 0 ? 0.5f : 1.0f) : 0.0f};
                pg8::gemm_phase<pg8::EpiResid, pg8::StaticOrder, true, true>(F.lds + RING_OFF, g, So, E);
            }
            SEAM(pb + 3);
        }
#endif
    }
#if PH_FN
    if (IN(N_PHASES - 1)) final_norm_phase(F, args.out, ssb + (size_t)NSB * S, args.in[17]);
#endif
#undef IN
#undef SEAM
}

extern "C" void kernel_launch(void* const* d_in, const int* in_sizes, int n_in, void* d_out, int out_size, void* d_ws, size_t ws_size, hipStream_t stream) {
    static int grid = 0;
    if (grid == 0) {
        if (n_in != 18 || in_sizes[0] != S * DM || out_size != S * DM || ws_size < WS_END) { fprintf(stderr, "kernel_launch: shape mismatch: n_in %d in0 %d out %d ws %zu (need %zu)\n", n_in, n_in > 0 ? in_sizes[0] : -1, out_size, ws_size, (size_t)WS_END); grid = -1; return; }
        int dev = 0, cus = 0, per_cu = 0;
        if (hipGetDevice(&dev) != hipSuccess || hipDeviceGetAttribute(&cus, hipDeviceAttributeMultiprocessorCount, dev) != hipSuccess) { fprintf(stderr, "kernel_launch: device query failed\n"); grid = -1; return; }
        if (hipFuncSetAttribute((const void*)mega_fwd, hipFuncAttributeMaxDynamicSharedMemorySize, LDS_BYTES) != hipSuccess) { fprintf(stderr, "kernel_launch: hipFuncSetAttribute failed\n"); grid = -1; return; }
        if (hipOccupancyMaxActiveBlocksPerMultiprocessor(&per_cu, (const void*)mega_fwd, NWAVES * 64, LDS_BYTES) != hipSuccess || per_cu < 1) { fprintf(stderr, "kernel_launch: occupancy query says %d blocks per CU\n", per_cu); }
        (void)hipGetLastError();
        grid = cus;
    }
    if (grid < 0) return;
    if (hipMemsetAsync((char*)d_ws + WS_CTL, 0, CTL_ZERO_BYTES, stream) != hipSuccess) { fprintf(stderr, "kernel_launch: memset failed\n"); return; }
    Args a{};
    for (int i = 0; i < 18; ++i) a.in[i] = (const float*)d_in[i];
    a.out = (float*)d_out; a.ws = (unsigned char*)d_ws;
#if MK_MULTI
    for (int ph = 0; ph < N_PHASES; ++ph) {
        if (ph >= 1 && ph < N_PHASES - 1) { const int sb = (ph - 1) / 4, k = (ph - 1) % 4, k6 = sb % 6; if ((k == 1 || k == 2) && !(k6 == 1 || k6 == 4)) continue; }
        a.ph_lo = ph; a.ph_hi = ph + 1;
        hipLaunchKernelGGL(mega_fwd, dim3(grid), dim3(NWAVES * 64), LDS_BYTES, stream, a);
    }
#else
    a.ph_lo = 0; a.ph_hi = N_PHASES;
    hipLaunchKernelGGL(mega_fwd, dim3(grid), dim3(NWAVES * 64), LDS_BYTES, stream, a);
#endif
    const hipError_t le = hipPeekAtLastError();
    if (le != hipSuccess) fprintf(stderr, "kernel_launch: launch failed: %s\n", hipGetErrorName(le));
}
```

```cpp
#include <hip/hip_runtime.h>
#include <hip/hip_bf16.h>
#include <cstdio>
#include <cstdint>
#define MK_MULTI 0
namespace pg8 {
#define PG8_LAS __attribute__((address_space(3)))
typedef unsigned short bf16_t;
typedef short bf16x8 __attribute__((ext_vector_type(8)));
typedef float f32x4 __attribute__((ext_vector_type(4)));
typedef unsigned u32x4 __attribute__((ext_vector_type(4)));
constexpr int BM = 256, BK = 64, HALF = 128, HTB = HALF * BK * 2  , STAGE_BYTES = 8 * HTB, NXCD = 8, WGM = 8;

__host__ __device__ __forceinline__ int lds_byte(int r, int c) { const int st = (r >> 4) * 2 + (c >> 5), rr = r & 15, cc = c & 31, ob = rr * 64 + cc * 2; return st * 1024 + (ob ^ (((ob >> 9) & 1) << 5)); }
__host__ __device__ __forceinline__ void stage_rc(int b, int& R, int& C) { const int st = b / 1024, sb = b % 1024, swz = sb ^ (((sb >> 9) & 1) << 5); R = (st >> 1) * 16 + swz / 64; C = (st & 1) * 32 + (swz % 64) / 2; }
__host__ __device__ __forceinline__ int perm32(int rho) { const int n = rho >> 4, i = rho & 15; return 8 * (i >> 2) + 4 * n + (i & 3); }

struct Unit { int pm, pn; };
struct Gemm { const bf16_t* A; const bf16_t* Bt; int M, N, K; };

struct StaticOrder {
    int nM, nN, nwg, G, c, wgm;
    __host__ __device__ void init(int M, int N, int G_, int c_, int wgm_ = WGM) { nM = M / BM; nN = N / BM; nwg = nM * nN; G = G_; c = c_; wgm = wgm_; }
    __host__ __device__ bool next(int i, Unit& u) const { return unit_of((long)i * G + c, u); }
    __host__ __device__ bool unit_of(long L, Unit& u) const {
        if (L >= nwg) return false;
        int wgid = (int)L; { const int q = nwg / NXCD, r = nwg % NXCD, xcd = wgid % NXCD, off = wgid / NXCD; wgid = (xcd < r ? xcd * (q + 1) : r * (q + 1) + (xcd - r) * q) + off; }
        const int nig = wgm * nN, gid = wgid / nig, fm = gid * wgm, gsz = (nM - fm) < wgm ? (nM - fm) : wgm;
        u.pm = fm + ((wgid % nig) % gsz); u.pn = (wgid % nig) / gsz; return true;
    }
    __device__ __forceinline__ void a_ready(const Unit&) const {}
    __device__ __forceinline__ void done(const Unit&) const {}
};
__device__ __forceinline__ unsigned cvt_pk_bf16(float lo, float hi) { unsigned r; asm volatile("v_cvt_pk_bf16_f32 %0, %1, %2" : "=v"(r) : "v"(lo), "v"(hi)); return r; }
constexpr int DM = 2048, DFF = 5632;
constexpr float RMS_EPS = 1e-6f;
typedef unsigned long long ss_t;
constexpr float SS_SCALE = 16777216.0f;
__device__ __forceinline__ float rs_from_ss(ss_t ss) { return __builtin_amdgcn_rsqf((float)ss * (1.0f / ((float)DM * SS_SCALE)) + RMS_EPS); }
__device__ __forceinline__ float silu_f(float x) { return x * __builtin_amdgcn_rcpf(1.0f + __builtin_amdgcn_exp2f(x * -1.4426950408889634f)); }
__device__ __forceinline__ u32x4 pack8(const f32x4 a, const f32x4 b) { u32x4 w; w.x = cvt_pk_bf16(a[0], a[1]); w.y = cvt_pk_bf16(a[2], a[3]); w.z = cvt_pk_bf16(b[0], b[1]); w.w = cvt_pk_bf16(b[2], b[3]); return w; }

#ifndef EPI_WT
#define EPI_WT 0
#endif
template <typename V> __device__ __forceinline__ void st16(void* p, const V v) {
#if EPI_WT
    asm volatile("global_store_dwordx4 %0, %1, off sc1\n\ts_nop 1" :: "v"(p), "v"(v) : "memory");
#else
    *(V*)p = v;
#endif
}
struct SsOrder : StaticOrder {
    const ss_t* ss; PG8_LAS unsigned char* raw; mutable int k;
    __device__ __forceinline__ void a_ready(const Unit& u) const {
        int t_ = threadIdx.x; asm volatile("" : "+v"(t_));
        const int wid = __builtin_amdgcn_readfirstlane(t_ >> 6), lane = t_ & 63;
        __builtin_amdgcn_global_load_lds((const unsigned*)(ss + u.pm * BM + wid * 32) + lane, (PG8_LAS unsigned*)(raw + (k & 1) * 2048 + wid * 256), 4, 0, 0);
        ++k;
    }
    __device__ __forceinline__ void done(const Unit&) const {}
};
struct DynSsOrder : SsOrder {
    unsigned* ctr; PG8_LAS int* mbox; int x, nper, base; bool dyn; mutable unsigned pend;
    __device__ __forceinline__ void init_dyn(unsigned* ctr_all, PG8_LAS int* mbox_) {
        dyn = (G % NXCD == 0) && (nwg % NXCD == 0); x = c % NXCD; nper = nwg / NXCD; base = 2 * (G / NXCD); ctr = ctr_all + 64 * x; mbox = mbox_; pend = 0u;
    }
    __device__ __forceinline__ bool next(int i, Unit& u) const {
        bool ok;
        if (!dyn || i < 2) ok = unit_of((long)i * G + c, u);
        else { const int m = base + __builtin_amdgcn_readfirstlane(mbox[i & 1]); ok = (m < nper) && unit_of((long)m * NXCD + x, u); }
        if (dyn && i >= 1 && threadIdx.x == 0) pend = __hip_atomic_fetch_add(ctr, 1u, __ATOMIC_RELAXED, __HIP_MEMORY_SCOPE_AGENT);
        return ok;
    }
    __device__ __forceinline__ void a_ready(const Unit& u) const {
        if (dyn && k >= 1 && threadIdx.x == 0) mbox[(k + 1) & 1] = (int)pend;
        SsOrder::a_ready(u);
    }
};
struct EpiSwiglu {
    static constexpr bool PERM = true, AFTER_DRAIN = false;
    bf16_t* H; PG8_LAS const unsigned char* raw;
    __device__ __forceinline__ void operator()(const f32x4 (&acc)[2][2][4][2], const Unit& u, int wr, int wc, int fr_in, int fq_in, int slot) const {
        int fr = fr_in, fq = fq_in; asm volatile("" : "+v"(fr), "+v"(fq));
        const int row0 = u.pm * BM + wr * 64 + fr, col0 = u.pn * HALF + wc * 32 + 8 * fq;
#pragma unroll
        for (int ai = 0; ai < 2; ++ai)
#pragma unroll
            for (int m = 0; m < 4; ++m) { const int r = row0 + ai * HALF + m * 16; const float rs = rs_from_ss(*(PG8_LAS const ss_t*)(raw + slot * 2048 + (wr * 64 + fr + ai * HALF + m * 16) * 8));
                f32x4 h[2];
#pragma unroll
                for (int n = 0; n < 2; ++n) { const f32x4 g = acc[ai][0][m][n] * rs, v = acc[ai][1][m][n] * rs;
                    h[n] = (f32x4){silu_f(g[0]) * v[0], silu_f(g[1]) * v[1], silu_f(g[2]) * v[2], silu_f(g[3]) * v[3]}; }
                st16(H + (size_t)r * DFF + col0, pack8(h[0], h[1])); }
    }
};
struct EpiPlain {
    static constexpr bool PERM = true, AFTER_DRAIN = false;
    bf16_t* O; int ldc; PG8_LAS const unsigned char* raw;
    int rope_tiles, k_tile0; const float* qg; const float* kg; const float* rt; PG8_LAS float* hs;
    __device__ __forceinline__ void operator()(const f32x4 (&acc)[2][2][4][2], const Unit& u, int wr, int wc, int fr_in, int fq_in, int slot) const {
        int fr = fr_in, fq = fq_in; asm volatile("" : "+v"(fr), "+v"(fq));
        const int row0 = u.pm * BM + wr * 64 + fr, col0 = u.pn * BM + wc * 32 + 8 * fq;
        if (u.pn >= rope_tiles) {
#pragma unroll
            for (int ai = 0; ai < 2; ++ai)
#pragma unroll
                for (int m = 0; m < 4; ++m) { const int r = row0 + ai * HALF + m * 16; const float rs = rs_from_ss(*(PG8_LAS const ss_t*)(raw + slot * 2048 + (wr * 64 + fr + ai * HALF + m * 16) * 8)); bf16_t* rowp = O + (size_t)r * ldc + col0;
#pragma unroll
                    for (int bj = 0; bj < 2; ++bj) *(u32x4*)(rowp + bj * HALF) = pack8(acc[ai][bj][m][0] * rs, acc[ai][bj][m][1] * rs); }
            return;
        }
#pragma unroll
        for (int ai = 0; ai < 2; ++ai)
#pragma unroll
            for (int m = 0; m < 4; ++m) { const int rl = wr * 64 + fr + ai * HALF + m * 16; const float rs = rs_from_ss(*(PG8_LAS const ss_t*)(raw + slot * 2048 + rl * 8));
#pragma unroll
                for (int bj = 0; bj < 2; ++bj) { const f32x4 a = acc[ai][bj][m][0] * rs, b = acc[ai][bj][m][1] * rs;
                    float q = (a[0] * a[0] + a[1] * a[1]) + (a[2] * a[2] + a[3] * a[3]) + (b[0] * b[0] + b[1] * b[1]) + (b[2] * b[2] + b[3] * b[3]);
                    q += __shfl_xor(q, 16); q += __shfl_xor(q, 32);
                    if (fq == 0) hs[(rl * 2 + bj) * 4 + wc] = q; } }
        asm volatile("s_waitcnt lgkmcnt(0)" ::: "memory"); __builtin_amdgcn_s_barrier(); asm volatile("" ::: "memory");
        int l7 = (4 * wc + fq) & 7; asm volatile("" : "+v"(l7));
        const int hh = wc >> 1;
        const float* g = (u.pn >= k_tile0) ? kg : qg;
        const f32x4 ga = *(const f32x4*)(g + 64 * hh + 4 * l7), gb = *(const f32x4*)(g + 64 * hh + 32 + 4 * l7);
        const float* ctab = rt + (hh ? 8192 : 0) + 4 * l7; const int sinoff = hh ? 2048 : 4096;
#pragma unroll
        for (int ai = 0; ai < 2; ++ai)
#pragma unroll
            for (int m = 0; m < 4; ++m) { const int rl = wr * 64 + fr + ai * HALF + m * 16, r = u.pm * BM + rl; const float rs = rs_from_ss(*(PG8_LAS const ss_t*)(raw + slot * 2048 + rl * 8));
                const int pos = hh ? (r & 63) : (r >> 6);
                const f32x4 cs = *(const f32x4*)(ctab + pos * 32), sn = *(const f32x4*)(ctab + sinoff + pos * 32);
                bf16_t* rowp = O + (size_t)r * ldc + col0;
#pragma unroll
                for (int bj = 0; bj < 2; ++bj) { const f32x4 p4 = *(PG8_LAS const f32x4*)(hs + (rl * 2 + bj) * 4);
                    const float rh = __builtin_amdgcn_rsqf(((p4[0] + p4[1]) + (p4[2] + p4[3])) * (1.0f / 128.0f) + RMS_EPS) * rs;
                    const f32x4 x1 = acc[ai][bj][m][0] * rh * ga, x2 = acc[ai][bj][m][1] * rh * gb;
                    *(u32x4*)(rowp + bj * HALF) = pack8(x1 * cs - x2 * sn, x2 * cs + x1 * sn); }
                if (m & 1) asm volatile("" ::: "memory"); }
    }
};
__device__ __forceinline__ float bfl(unsigned w) { return __builtin_bit_cast(float, w << 16); }
__device__ __forceinline__ float bfh(unsigned w) { return __builtin_bit_cast(float, w & 0xffff0000u); }
struct EpiResid {
    static constexpr bool PERM = true, AFTER_DRAIN = false;
    bf16_t* xb; ss_t* ssn; float alpha;
    __device__ __forceinline__ void operator()(const f32x4 (&acc)[2][2][4][2], const Unit& u, int wr, int wc, int fr_in, int fq_in, int) const {
        int fr = fr_in, fq = fq_in; asm volatile("" : "+v"(fr), "+v"(fq));
        const int row0 = u.pm * BM + wr * 64 + fr, col0 = u.pn * BM + wc * 32 + 8 * fq;
        u32x4 bv[2][4][2];
#pragma unroll
        for (int ai = 0; ai < 2; ++ai)
#pragma unroll
            for (int m = 0; m < 4; ++m) { const size_t off = (size_t)(row0 + ai * HALF + m * 16) * DM + col0;
#pragma unroll
                for (int bj = 0; bj < 2; ++bj) bv[ai][m][bj] = *(const u32x4*)(xb + off + bj * HALF); }
#pragma unroll
        for (int ai = 0; ai < 2; ++ai)
#pragma unroll
            for (int m = 0; m < 4; ++m) { const int r = row0 + ai * HALF + m * 16; const size_t off = (size_t)r * DM + col0; float q = 0.f;
#pragma unroll
                for (int bj = 0; bj < 2; ++bj) { const u32x4 b = bv[ai][m][bj];
                    const f32x4 x0 = (f32x4){bfl(b.x), bfh(b.x), bfl(b.y), bfh(b.y)} + acc[ai][bj][m][0] * alpha, x1 = (f32x4){bfl(b.z), bfh(b.z), bfl(b.w), bfh(b.w)} + acc[ai][bj][m][1] * alpha;
                    const u32x4 w = pack8(x0, x1);
                    *(u32x4*)(xb + off + bj * HALF) = w;
                    const float r0 = bfl(w.x), r1 = bfh(w.x), r2 = bfl(w.y), r3 = bfh(w.y), r4 = bfl(w.z), r5 = bfh(w.z), r6 = bfl(w.w), r7 = bfh(w.w);
                    q += (r0 * r0 + r1 * r1) + (r2 * r2 + r3 * r3) + (r4 * r4 + r5 * r5) + (r6 * r6 + r7 * r7); }
                q += __shfl_xor(q, 16); q += __shfl_xor(q, 32);
                if (fq == 0) __hip_atomic_fetch_add(ssn + r, (ss_t)(q * SS_SCALE), __ATOMIC_RELAXED, __HIP_MEMORY_SCOPE_AGENT); }
    }
};

template <class Epi, class Sched, bool ALIGN_EPI = false, bool SP2 = false>
__device__ __forceinline__ void gemm_phase(PG8_LAS unsigned char* lds, const Gemm g, const Sched& S, const Epi& E) {
    int tid_ = threadIdx.x; asm volatile("" : "+v"(tid_));
    const int tid = tid_, wid = __builtin_amdgcn_readfirstlane(tid >> 6), lane = tid & 63, wr = wid >> 2, wc = wid & 3, fr = lane & 15, fq = lane >> 4;
    const int K = g.K, nt = K / BK;
    unsigned voffA[2], voffB[2];
#pragma unroll
    for (int i = 0; i < 2; ++i) { int R, C; stage_rc(tid * 16 + i * 8192, R, C); const int Rb = Epi::PERM ? ((R & ~31) + perm32(R & 31)) : R;
        voffA[i] = (unsigned)(R * K + C) * 2u; voffB[i] = (unsigned)(Rb * K + C) * 2u; }
    const size_t kstep = (size_t)(BK * 2);
    const size_t hstep = (size_t)HALF * K * 2;
    const size_t tstep = 2 * hstep;
    const unsigned ldsw = (unsigned)wid * 1024u;
    const int aoff = lds_byte(wr * 64 + fr, fq * 8), boff = lds_byte(wc * 32 + fr, fq * 8);
#define PG8_SA(b, h) (((b) * 2 + (h)) * HTB)
#define PG8_SB(b, h) ((4 + (b) * 2 + (h)) * HTB)
#define PG8_STAGE(bufoff, gbase, voff) do { _Pragma("unroll") for (int _i = 0; _i < 2; ++_i) \
        __builtin_amdgcn_global_load_lds((const unsigned*)((const char*)(gbase) + (voff)[_i]), (PG8_LAS unsigned*)(lds + (bufoff) + ldsw + _i * 8192), 16, 0, 0); } while (0)
#define PG8_LDA(dst, b, h) do { _Pragma("unroll") for (int m = 0; m < 4; ++m) _Pragma("unroll") for (int k = 0; k < 2; ++k) dst[m][k] = *(const PG8_LAS bf16x8*)(lds + PG8_SA(b, h) + aoff + m * 2048 + k * 1024); } while (0)
#define PG8_LDB(dst, b, h) do { _Pragma("unroll") for (int n = 0; n < 2; ++n) _Pragma("unroll") for (int k = 0; k < 2; ++k) dst[n][k] = *(const PG8_LAS bf16x8*)(lds + PG8_SB(b, h) + boff + n * 2048 + k * 1024); } while (0)
#define PG8_MMA(ai, bj, At, Bt) do { __builtin_amdgcn_s_setprio(1); _Pragma("unroll") for (int m = 0; m < 4; ++m) _Pragma("unroll") for (int n = 0; n < 2; ++n) _Pragma("unroll") for (int k = 0; k < 2; ++k) \
        acc[ai][bj][m][n] = __builtin_amdgcn_mfma_f32_16x16x32_bf16(Bt[n][k], At[m][k], acc[ai][bj][m][n], 0, 0, 0); __builtin_amdgcn_s_setprio(0); } while (0)
#define PG8_WAIT_V(n) asm volatile("s_waitcnt vmcnt(" #n ")" ::: "memory")
#define PG8_WAIT_L(n) asm volatile("s_waitcnt lgkmcnt(" #n ")" ::: "memory")
#define PG8_BAR __builtin_amdgcn_s_barrier()
#define PG8_SCHED __builtin_amdgcn_sched_barrier(0)
    Unit cur, nxt; int ui = 0;
    if (!S.next(0, cur)) return;
    f32x4 acc[2][2][4][2];
#pragma unroll
    for (int a = 0; a < 2; ++a)
#pragma unroll
        for (int b = 0; b < 2; ++b)
#pragma unroll
            for (int m = 0; m < 4; ++m)
#pragma unroll
                for (int n = 0; n < 2; ++n) acc[a][b][m][n] = (f32x4){0.f, 0.f, 0.f, 0.f};
    bf16x8 At[4][2], B0[2][2], B1[2][2];
    const char* cA = (const char*)g.A + (size_t)cur.pm * tstep; const char* cB = (const char*)g.Bt + (size_t)cur.pn * tstep;
    S.a_ready(cur);
    if constexpr (SP2) {
        PG8_STAGE(PG8_SB(0, 0), cB, voffB); PG8_STAGE(PG8_SB(0, 1), cB + hstep, voffB); PG8_STAGE(PG8_SA(0, 0), cA, voffA); PG8_STAGE(PG8_SA(0, 1), cA + hstep, voffA);
        if (wr == 1) PG8_BAR;
        PG8_WAIT_V(2); PG8_BAR;
        PG8_STAGE(PG8_SB(1, 0), cB + kstep, voffB); PG8_STAGE(PG8_SA(1, 0), cA + kstep, voffA); PG8_STAGE(PG8_SB(1, 1), cB + hstep + kstep, voffB);
        PG8_WAIT_V(6); PG8_BAR;
    } else {
        PG8_STAGE(PG8_SB(0, 0), cB, voffB); PG8_STAGE(PG8_SA(0, 0), cA, voffA); PG8_STAGE(PG8_SB(0, 1), cB + hstep, voffB); PG8_STAGE(PG8_SA(0, 1), cA + hstep, voffA);
        if (wr == 1) PG8_BAR;
        PG8_WAIT_V(4); PG8_BAR;
        PG8_STAGE(PG8_SB(1, 0), cB + kstep, voffB); PG8_STAGE(PG8_SA(1, 0), cA + kstep, voffA); PG8_STAGE(PG8_SB(1, 1), cB + hstep + kstep, voffB);
        PG8_WAIT_V(6); PG8_BAR;
    }
    for (;;) {
        const bool has_next = S.next(ui + 1, nxt);
        const char* nA = has_next ? (const char*)g.A + (size_t)nxt.pm * tstep : cA; const char* nB = has_next ? (const char*)g.Bt + (size_t)nxt.pn * tstep : cB;
        for (int t = 0; t < nt; t += 2) {
            const bool last = (t == nt - 2);
            const char* a1 = cA + (size_t)(t + 1) * kstep;
            const char* a2 = last ? nA : cA + (size_t)(t + 2) * kstep; const char* b2 = last ? nB : cB + (size_t)(t + 2) * kstep;
            const char* a3 = a2 + kstep; const char* b3 = b2 + kstep;
            if (last && has_next) S.a_ready(nxt);
            if constexpr (SP2) {
            PG8_LDB(B0, 0, 0); PG8_LDB(B1, 0, 1); PG8_SCHED; PG8_LDA(At, 0, 0); PG8_STAGE(PG8_SA(1, 1), a1 + hstep, voffA);
            PG8_WAIT_V(8); PG8_WAIT_L(0); PG8_BAR; PG8_MMA(0, 0, At, B0); PG8_MMA(0, 1, At, B1); PG8_BAR; PG8_SCHED;
            PG8_LDA(At, 0, 1); PG8_STAGE(PG8_SB(0, 0), b2, voffB); PG8_STAGE(PG8_SB(0, 1), b2 + hstep, voffB); PG8_STAGE(PG8_SA(0, 0), a2, voffA);
            PG8_WAIT_V(8); PG8_WAIT_L(0); PG8_BAR; PG8_MMA(1, 0, At, B0); PG8_MMA(1, 1, At, B1); PG8_BAR; PG8_SCHED;
            PG8_LDB(B0, 1, 0); PG8_LDB(B1, 1, 1); PG8_SCHED; PG8_LDA(At, 1, 0); PG8_STAGE(PG8_SA(0, 1), a2 + hstep, voffA);
            PG8_WAIT_V(8); PG8_WAIT_L(0); PG8_BAR; PG8_MMA(0, 0, At, B0); PG8_MMA(0, 1, At, B1); PG8_BAR; PG8_SCHED;
            PG8_LDA(At, 1, 1); PG8_STAGE(PG8_SB(1, 0), b3, voffB); PG8_STAGE(PG8_SB(1, 1), b3 + hstep, voffB); PG8_STAGE(PG8_SA(1, 0), a3, voffA);
            PG8_WAIT_V(8); PG8_WAIT_L(0); PG8_BAR; PG8_MMA(1, 0, At, B0); PG8_MMA(1, 1, At, B1); PG8_BAR; PG8_SCHED;
            } else {
            PG8_LDB(B0, 0, 0); PG8_SCHED; PG8_LDA(At, 0, 0); PG8_STAGE(PG8_SA(1, 1), a1 + hstep, voffA);
            PG8_WAIT_L(8); PG8_BAR; PG8_WAIT_L(0); PG8_MMA(0, 0, At, B0); PG8_BAR; PG8_SCHED;
            PG8_LDB(B1, 0, 1); PG8_STAGE(PG8_SB(0, 0), b2, voffB);
            PG8_BAR; PG8_WAIT_L(0); PG8_MMA(0, 1, At, B1); PG8_BAR;
            PG8_LDA(At, 0, 1); PG8_STAGE(PG8_SA(0, 0), a2, voffA);
            PG8_BAR; PG8_WAIT_L(0); PG8_MMA(1, 0, At, B0); PG8_BAR; PG8_SCHED;
            PG8_STAGE(PG8_SB(0, 1), b2 + hstep, voffB);
            PG8_WAIT_V(6); PG8_BAR; PG8_MMA(1, 1, At, B1); PG8_BAR;
            PG8_LDB(B0, 1, 0); PG8_SCHED; PG8_LDA(At, 1, 0); PG8_STAGE(PG8_SA(0, 1), a2 + hstep, voffA);
            PG8_WAIT_L(8); PG8_BAR; PG8_WAIT_L(0); PG8_MMA(0, 0, At, B0); PG8_BAR; PG8_SCHED;
            PG8_LDB(B1, 1, 1); PG8_STAGE(PG8_SB(1, 0), b3, voffB);
            PG8_BAR; PG8_WAIT_L(0); PG8_MMA(0, 1, At, B1); PG8_BAR;
            PG8_LDA(At, 1, 1); PG8_STAGE(PG8_SA(1, 0), a3, voffA);
            PG8_BAR; PG8_WAIT_L(0); PG8_MMA(1, 0, At, B0); PG8_BAR; PG8_SCHED;
            PG8_STAGE(PG8_SB(1, 1), b3 + hstep, voffB);
            PG8_WAIT_V(6); PG8_BAR; PG8_MMA(1, 1, At, B1); PG8_BAR;
            }
        }
        if constexpr (ALIGN_EPI) { if (wr == 0) PG8_BAR; }
        if constexpr (!Epi::AFTER_DRAIN) { E(acc, cur, wr, wc, fr, fq, ui & 1); S.done(cur); }
        if (!has_next) break;
#pragma unroll
        for (int a = 0; a < 2; ++a)
#pragma unroll
            for (int b = 0; b < 2; ++b)
#pragma unroll
                for (int m = 0; m < 4; ++m)
#pragma unroll
                    for (int n = 0; n < 2; ++n) acc[a][b][m][n] = (f32x4){0.f, 0.f, 0.f, 0.f};
        cur = nxt; cA = nA; cB = nB; ++ui;
        if constexpr (ALIGN_EPI) { if (wr == 1) PG8_BAR; }
    }
    PG8_WAIT_V(0);
    if constexpr (!ALIGN_EPI) { if (wr == 0) PG8_BAR; }
    PG8_BAR;
    if constexpr (Epi::AFTER_DRAIN) { E.fused(acc, cur, wr, wc, fr, fq, lds, wid, lane); S.done(cur); }
#undef PG8_SA
#undef PG8_SB
#undef PG8_STAGE
#undef PG8_LDA
#undef PG8_LDB
#undef PG8_MMA
#undef PG8_WAIT_V
#undef PG8_WAIT_L
#undef PG8_BAR
#undef PG8_SCHED
}
}
namespace att {
using bf16 = __hip_bfloat16;
constexpr int   D = 128, NW = 8, QBLK = 32, KVBLK = 64;
constexpr float SCALE = 0.088388347648318440f;
constexpr float THR = 8.f;
constexpr int   SDEPTH = 2;
constexpr int   LDQ = 3072, LDK = 3072, LDO = 2048;
constexpr size_t SHM_V = KVBLK * D * 2, SHM_K = KVBLK * D * 2, SHM_ATTN = 2 * SHM_V + 2 * SHM_K + NW * 64 * 4;
using bf16x8 = __attribute__((ext_vector_type(8))) short;
using s16x4  = __attribute__((ext_vector_type(4))) short;
using f32x16 = __attribute__((ext_vector_type(16))) float;
using u32x4  = __attribute__((ext_vector_type(4))) unsigned;
#define KSWZ(row, colB) ((row) * 256 + ((colB) ^ (((row) & 7) << 4)))
#define SBAR() __builtin_amdgcn_sched_barrier(0)
__device__ __forceinline__ int crow(int r, int hi) { return (r & 3) + 8 * (r >> 2) + 4 * hi; }
__device__ __forceinline__ unsigned cvtpk(float lo, float hi) {
  unsigned r; asm volatile("v_cvt_pk_bf16_f32 %0, %1, %2" : "=v"(r) : "v"(lo), "v"(hi)); return r;
}

__device__ __forceinline__ void partialSM(f32x16& p0, f32x16& p1, float& m_reg, float& mn, float& alpha) {
  constexpr float C = SCALE * 1.4426950408889634f;
  float pmax = p0[0]; for (int r = 1; r < 16; ++r) pmax = fmaxf(pmax, p0[r]); for (int r = 0; r < 16; ++r) pmax = fmaxf(pmax, p1[r]);
  { auto rr = __builtin_amdgcn_permlane32_swap(__float_as_uint(pmax), __float_as_uint(pmax), false, false);
    pmax = fmaxf(__uint_as_float(rr[0]), __uint_as_float(rr[1])); }
  if (__builtin_expect(__all(pmax - m_reg <= THR / SCALE), 1)) { mn = m_reg; alpha = 1.f; }
  else { mn = fmaxf(m_reg, pmax); alpha = __builtin_amdgcn_exp2f((m_reg - mn) * C); m_reg = mn; }
  float mnC = -mn * C;
  for (int r = 0; r < 16; ++r) p0[r] = fmaf(p0[r], C, mnC); for (int r = 0; r < 16; ++r) p1[r] = fmaf(p1[r], C, mnC);
  for (int r = 0; r < 16; ++r) p0[r] = __builtin_amdgcn_exp2f(p0[r]);
}
__device__ __forceinline__ void finishSM(f32x16& p0, f32x16& p1, float alpha, float& l_reg, bf16x8& pa0, bf16x8& pa1, bf16x8& pa2, bf16x8& pa3) {
  for (int r = 0; r < 16; ++r) p1[r] = __builtin_amdgcn_exp2f(p1[r]);
  float ps = 0; for (int r = 0; r < 16; ++r) ps += p0[r]; for (int r = 0; r < 16; ++r) ps += p1[r];
  { auto rr = __builtin_amdgcn_permlane32_swap(__float_as_uint(ps), __float_as_uint(ps), false, false);
    ps = __uint_as_float(rr[0]) + __uint_as_float(rr[1]); }
  l_reg = l_reg * alpha + ps;
#define PK4(P, BASE, OUT) do { unsigned a0 = cvtpk(P[BASE + 0], P[BASE + 1]), a1 = cvtpk(P[BASE + 2], P[BASE + 3]);   \
    unsigned b0 = cvtpk(P[BASE + 4], P[BASE + 5]), b1 = cvtpk(P[BASE + 6], P[BASE + 7]);                              \
    auto r0 = __builtin_amdgcn_permlane32_swap(a0, b0, false, false); auto r1 = __builtin_amdgcn_permlane32_swap(a1, b1, false, false); \
    u32x4 w = {r0[0], r1[0], r0[1], r1[1]}; OUT = *reinterpret_cast<bf16x8*>(&w); } while (0)
  PK4(p0, 0, pa0); PK4(p0, 8, pa1); PK4(p1, 0, pa2); PK4(p1, 8, pa3);
#undef PK4
}
__device__ __forceinline__ void qkt(f32x16& p0, f32x16& p1, const bf16* Ks, const bf16x8* qr, int r32, int hi) {
  p0 = f32x16{}; p1 = f32x16{};
  for (int d0 = 0; d0 < 8; ++d0) { int cb = (d0 * 16 + hi * 8) * 2;
    bf16x8 b0 = *reinterpret_cast<const bf16x8*>((const char*)Ks + KSWZ(r32, cb));
    bf16x8 b1 = *reinterpret_cast<const bf16x8*>((const char*)Ks + KSWZ(32 + r32, cb));
    p0 = __builtin_amdgcn_mfma_f32_32x32x16_bf16(b0, qr[d0], p0, 0, 0, 0);
    p1 = __builtin_amdgcn_mfma_f32_32x32x16_bf16(b1, qr[d0], p1, 0, 0, 0); }
}
__device__ __forceinline__ int v_st(int k, int c) { const int kk = (k & ~0xC) | ((k & 4) << 1) | ((k & 8) >> 1); return ((kk >> 3) * 4 + (c >> 5)) * 512 + ((kk & 7) * 32 + (c & 31)) * 2; }
__device__ __forceinline__ int v_rd_base(int lane) { return ((lane & 3) << 3) | (((lane >> 2) & 3) << 6) | (((lane >> 4) & 1) << 5) | (((lane >> 5) & 1) << 8); }
constexpr int v_rd_off(int d0, int ks, int half) { return d0 * 512 + ks * 4096 + half * 2048; }
template <int OFF> __device__ __forceinline__ s16x4 tr_read(int vb) {
  s16x4 r; asm volatile("ds_read_b64_tr_b16 %0, %1 offset:%2" : "=&v"(r) : "v"(vb), "i"(OFF) : "memory"); return r;
}
template <int D0> __device__ __forceinline__ void pv_one(f32x16& od, int vb, bf16x8 pa0, bf16x8 pa1, bf16x8 pa2, bf16x8 pa3) {
  const s16x4 l0 = tr_read<v_rd_off(D0, 0, 0)>(vb), h0 = tr_read<v_rd_off(D0, 0, 1)>(vb), l1 = tr_read<v_rd_off(D0, 1, 0)>(vb), h1 = tr_read<v_rd_off(D0, 1, 1)>(vb);
  const s16x4 l2 = tr_read<v_rd_off(D0, 2, 0)>(vb), h2 = tr_read<v_rd_off(D0, 2, 1)>(vb), l3 = tr_read<v_rd_off(D0, 3, 0)>(vb), h3 = tr_read<v_rd_off(D0, 3, 1)>(vb);
  asm volatile("s_waitcnt lgkmcnt(0)" ::: "memory"); SBAR();
#define PK(L, H) (bf16x8){L[0], L[1], L[2], L[3], H[0], H[1], H[2], H[3]}
  od = __builtin_amdgcn_mfma_f32_32x32x16_bf16(pa0, PK(l0, h0), od, 0, 0, 0);
  od = __builtin_amdgcn_mfma_f32_32x32x16_bf16(pa1, PK(l1, h1), od, 0, 0, 0);
  od = __builtin_amdgcn_mfma_f32_32x32x16_bf16(pa2, PK(l2, h2), od, 0, 0, 0);
  od = __builtin_amdgcn_mfma_f32_32x32x16_bf16(pa3, PK(l3, h3), od, 0, 0, 0);
#undef PK
}
__device__ __forceinline__ void pv_d0(f32x16* o, int vb, bf16x8 pa0, bf16x8 pa1, bf16x8 pa2, bf16x8 pa3) {
  pv_one<0>(o[0], vb, pa0, pa1, pa2, pa3); pv_one<1>(o[1], vb, pa0, pa1, pa2, pa3); pv_one<2>(o[2], vb, pa0, pa1, pa2, pa3); pv_one<3>(o[3], vb, pa0, pa1, pa2, pa3);
}
__device__ __forceinline__ void attn_dense_body(const bf16* __restrict__ Qb, const bf16* __restrict__ Kh, const bf16* __restrict__ Vh, bf16* __restrict__ Ob, int seq, char* lds) {
  int tid_ = threadIdx.x; asm volatile("" : "+v"(tid_));
  const int tid = tid_, wid = tid >> 6, lane = tid & 63, r32 = lane & 31, hi = lane >> 5;
  bf16* V_lds = (bf16*)lds; bf16* K_lds = (bf16*)(lds + 2 * SHM_V);
  float* ws = (float*)(lds + 2 * SHM_V + 2 * SHM_K) + wid * 64; float* li_l = ws; float* al_l = ws + 32;
  float m_reg = -1e30f, l_reg = 0; f32x16 o[4] = {}; bf16x8 qr[8];
  const bf16* Qw = Qb + (long)(wid * QBLK + r32) * LDQ + hi * 8;
#pragma unroll
  for (int d0 = 0; d0 < 8; ++d0) qr[d0] = *reinterpret_cast<const bf16x8*>(Qw + d0 * 16);
  const int sr = tid >> 4, sc = (tid & 15) * 8, vst0 = v_st(sr, sc), vst1 = v_st(32 + sr, sc);
  const int vb0 = (int)(uintptr_t)V_lds + v_rd_base(lane);
  struct { bf16x8 vs0, vs1, ks0, ks1; } sr_[SDEPTH];
#define SLOAD(i, k0) do { sr_[i].vs0 = *reinterpret_cast<const bf16x8*>(&Vh[(long)((k0) + sr) * LDK + sc]); sr_[i].vs1 = *reinterpret_cast<const bf16x8*>(&Vh[(long)((k0) + 32 + sr) * LDK + sc]); \
    sr_[i].ks0 = *reinterpret_cast<const bf16x8*>(&Kh[(long)((k0) + sr) * LDK + sc]); sr_[i].ks1 = *reinterpret_cast<const bf16x8*>(&Kh[(long)((k0) + 32 + sr) * LDK + sc]); } while (0)
#define SWRITE(b, i) do { *(bf16x8*)((char*)V_lds + (b) * SHM_V + vst0) = sr_[i].vs0;          \
    *(bf16x8*)((char*)V_lds + (b) * SHM_V + vst1) = sr_[i].vs1; int kc = sc * 2;               \
    *(bf16x8*)((char*)K_lds + (b) * SHM_K + KSWZ(sr, kc)) = sr_[i].ks0;                       \
    *(bf16x8*)((char*)K_lds + (b) * SHM_K + KSWZ(32 + sr, kc)) = sr_[i].ks1; } while (0)
#define SWAIT() do { asm volatile("s_waitcnt vmcnt(4)" ::: "memory"); } while (0)
#define RESC(a) do { if (__any((a) < 1.f)) { if (hi == 0) al_l[r32] = (a); asm volatile("s_waitcnt lgkmcnt(0)" ::: "memory"); \
    for (int d = 0; d < 4; ++d) for (int r = 0; r < 16; ++r) o[d][r] *= al_l[crow(r, hi)]; } } while (0)
  f32x16 pA0, pA1, pB0, pB1; float mnA, mnB, alA, alB; bf16x8 pa0, pa1, pa2, pa3; const int NT = seq / KVBLK;
  constexpr int SE = 0, SO = SDEPTH - 1;
  SLOAD(SE, 0); asm volatile("s_waitcnt vmcnt(0)" ::: "memory"); SWRITE(0, SE); __syncthreads();
  qkt(pA0, pA1, K_lds, qr, r32, hi); partialSM(pA0, pA1, m_reg, mnA, alA);
  SLOAD(SO, KVBLK); if (2 < NT) SLOAD(SE, 2 * KVBLK);
  SWAIT(); SWRITE(1, SO); __syncthreads();
  for (int j = 1; j + 1 < NT; j += 2) {
    SBAR(); qkt(pB0, pB1, (bf16*)((char*)K_lds + SHM_K), qr, r32, hi);
    finishSM(pA0, pA1, alA, l_reg, pa0, pa1, pa2, pa3); SBAR();
    SLOAD(SO, (j + SDEPTH) * KVBLK); SBAR();
    pv_d0(o, vb0, pa0, pa1, pa2, pa3); partialSM(pB0, pB1, m_reg, mnB, alB);
    __syncthreads(); SWAIT(); SWRITE(0, SE);
    RESC(alB); __syncthreads();
    SBAR(); qkt(pA0, pA1, K_lds, qr, r32, hi);
    finishSM(pB0, pB1, alB, l_reg, pa0, pa1, pa2, pa3); SBAR();
    if (j + 3 < NT) SLOAD(SE, (j + 1 + SDEPTH) * KVBLK); SBAR();
    pv_d0(o, vb0 + (int)SHM_V, pa0, pa1, pa2, pa3); partialSM(pA0, pA1, m_reg, mnA, alA);
    __syncthreads(); SWAIT(); SWRITE(1, SO);
    RESC(alA); __syncthreads();
  }
  SBAR(); qkt(pB0, pB1, (bf16*)((char*)K_lds + SHM_K), qr, r32, hi);
  finishSM(pA0, pA1, alA, l_reg, pa0, pa1, pa2, pa3); SBAR();
  pv_d0(o, vb0, pa0, pa1, pa2, pa3); partialSM(pB0, pB1, m_reg, mnB, alB);
  __syncthreads(); RESC(alB);
  finishSM(pB0, pB1, alB, l_reg, pa0, pa1, pa2, pa3); SBAR();
  pv_d0(o, vb0 + (int)SHM_V, pa0, pa1, pa2, pa3);
  if (hi == 0) li_l[r32] = l_reg; asm volatile("s_waitcnt lgkmcnt(0)" ::: "memory");
  float rli[16];
#pragma unroll
  for (int r = 0; r < 16; ++r) rli[r] = __builtin_amdgcn_rcpf(li_l[crow(r, hi)]);
  asm volatile("s_waitcnt vmcnt(0) lgkmcnt(0)" ::: "memory");
  __syncthreads();
  char* ost = lds + wid * 8192;
#pragma unroll
  for (int r = 0; r < 16; r += 2) { const int row_a = crow(r, hi), row_b = crow(r + 1, hi);
#pragma unroll
    for (int d0 = 0; d0 < 4; ++d0) { const unsigned w = cvtpk(o[d0][r] * rli[r], o[d0][r + 1] * rli[r + 1]);
      *(unsigned short*)(ost + row_a * 256 + (d0 * 32 + r32) * 2) = (unsigned short)(w & 0xffffu);
      *(unsigned short*)(ost + row_b * 256 + (d0 * 32 + r32) * 2) = (unsigned short)(w >> 16); } }
  asm volatile("s_waitcnt lgkmcnt(0)" ::: "memory");
  bf16* Ow = Ob + (long)(wid * QBLK) * LDO;
#pragma unroll
  for (int i = 0; i < 8; ++i) { const int idx = lane + 64 * i, row = idx >> 4, c16 = idx & 15;
    const u32x4 v = *(const u32x4*)(ost + row * 256 + c16 * 16); *(u32x4*)(Ow + (long)row * LDO + c16 * 8) = v; }
  asm volatile("s_waitcnt lgkmcnt(0)" ::: "memory");
  __syncthreads();
#undef SLOAD
#undef SWRITE
#undef SWAIT
#undef RESC
}
#undef KSWZ
#undef SBAR
}

constexpr int NWAVES = 8;
#ifndef MK_MULTI
#define MK_MULTI 0
#endif

#ifndef PH_P0
#define PH_P0 1
#endif
#ifndef PH_GU
#define PH_GU 1
#endif
#ifndef PH_PLAIN
#define PH_PLAIN 1
#endif
#ifndef PH_ROPE
#define PH_ROPE 1
#endif
#ifndef PH_ATT
#define PH_ATT 1
#endif
#ifndef PH_REC1
#define PH_REC1 1
#endif
#ifndef PH_REC2
#define PH_REC2 1
#endif
#ifndef PH_RES
#define PH_RES 1
#endif
#ifndef PH_FN
#define PH_FN 1
#endif
#ifndef DUP_P0
#define DUP_P0 1
#endif
#ifndef DUP_GU
#define DUP_GU 1
#endif
#ifndef DUP_PLAIN
#define DUP_PLAIN 1
#endif
#ifndef DUP_ATT
#define DUP_ATT 1
#endif
#ifndef DUP_RES
#define DUP_RES 1
#endif
#ifndef DUP_BAR
#define DUP_BAR 1
#endif
#ifndef DUP_REC
#define DUP_REC 1
#endif
#ifndef GU_CVY
#define GU_CVY 2
#endif
#ifndef RES_WGM
#define RES_WGM 8
#endif
constexpr int S = 8192, DM = 2048, DFF = 5632, NGU = 2 * DFF, QKVD = 3072, DRNN = 2048, NFFN = 8, NSB = 12;
constexpr int N_PHASES = 2 + 4 * NSB;
constexpr float NORM_EPS = 1e-6f;

constexpr size_t MiB = 1u << 20;
constexpr size_t WS_CTL = 0, CTL_ZERO_BYTES = 2 * MiB;
constexpr size_t WS_SS = 1 * MiB;
constexpr size_t WS_ROPE = 2 * MiB;
constexpr size_t WS_WG = 3 * MiB;
constexpr size_t WS_AGGS = 7 * MiB;
constexpr size_t WS_AGGC = 15 * MiB;
constexpr size_t WS_WGU = 16 * MiB, SZ_WGU = (size_t)NGU * DM * 2;
constexpr size_t WS_WD = WS_WGU + NFFN * SZ_WGU, SZ_WD = (size_t)DM * DFF * 2;
constexpr size_t WS_WQKV = WS_WD + NFFN * SZ_WD, SZ_WQKV = (size_t)QKVD * DM * 2;
constexpr size_t WS_WO = WS_WQKV + 2 * SZ_WQKV, SZ_WO = (size_t)DM * DM * 2;
constexpr size_t WS_WIN = WS_WO + 2 * SZ_WO, SZ_WIN = (size_t)2 * DRNN * DM * 2;
constexpr size_t WS_WOUT = WS_WIN + 2 * SZ_WIN, SZ_WOUT = (size_t)DM * DRNN * 2;
constexpr size_t WS_XB = WS_WOUT + 2 * SZ_WOUT;
constexpr size_t WS_H = WS_XB + (size_t)S * DM * 2;
constexpr size_t WS_QKV = WS_H + (size_t)S * DFF * 2;
constexpr size_t WS_O = WS_QKV + (size_t)S * QKVD * 2;
constexpr size_t WS_U = WS_O + (size_t)S * DM * 2;
constexpr size_t WS_Y = WS_U + (size_t)S * 2 * DRNN * 2;
constexpr size_t WS_AB = WS_Y + (size_t)S * DRNN * 2;
constexpr size_t WS_END = WS_AB + (size_t)S * DRNN * 2 * 4;
static_assert(WS_WG + 128 * 16384 * 2 <= WS_AGGS && WS_AGGS + 256 * 2 * 2048 * 8 <= WS_AGGC && WS_AGGC + 16 * 2 * 2048 * 8 <= WS_WGU, "small tables do not overlap");
static_assert(WS_SS + 14 * (size_t)S * 8 + 256 <= CTL_ZERO_BYTES, "ss arrays inside the memset region");
static_assert(WS_WGU % 256 == 0 && WS_XB % 256 == 0 && WS_H % 256 == 0 && WS_QKV % 256 == 0 && WS_O % 256 == 0 && WS_U % 256 == 0 && WS_Y % 256 == 0, "alignment");
constexpr int CW_GUQ = 16384;
constexpr int CW_BAR = 4096;

constexpr int RING_OFF = 0, RING_BYTES = 131072;
constexpr int LDSCTL_OFF = RING_BYTES, MISC_OFF = LDSCTL_OFF + 320;
constexpr int MBOX_OFF = LDSCTL_OFF + 512;
constexpr int RSTAB_OFF = LDSCTL_OFF + 1024;
constexpr int HSTAB_OFF = RSTAB_OFF + 4096;
constexpr int LDS_BYTES = 147456;
static_assert(MISC_OFF + 128 <= RSTAB_OFF && HSTAB_OFF + 8192 <= LDS_BYTES, "LDS map");

#define GAS __attribute__((address_space(1)))
#define LAS __attribute__((address_space(3)))
typedef unsigned short bf16;
typedef unsigned v4u __attribute__((ext_vector_type(4)));
typedef float f32x4 __attribute__((ext_vector_type(4)));
typedef short bf16x8 __attribute__((ext_vector_type(8)));
typedef GAS unsigned gu32;
#define RLX_AGENT __ATOMIC_RELAXED, __HIP_MEMORY_SCOPE_AGENT
#define LDS_WAIT() asm volatile("s_waitcnt lgkmcnt(0)" ::: "memory")
#define VM_WAIT() asm volatile("s_waitcnt vmcnt(0)" ::: "memory")
__device__ __forceinline__ unsigned f2bf(float f) { unsigned u = __builtin_bit_cast(unsigned, f); return (u + 0x7fffu + ((u >> 16) & 1u)) >> 16; }
__device__ __forceinline__ unsigned pk2(float lo, float hi) { return f2bf(lo) | (f2bf(hi) << 16); }
__device__ __forceinline__ float bf_lo(unsigned w) { return __builtin_bit_cast(float, w << 16); }
__device__ __forceinline__ float bf_hi(unsigned w) { return __builtin_bit_cast(float, w & 0xffff0000u); }

#define XB_TMO      128
#define XB_XCNT(j)  (256  + 64 * (j))
#define XB_XSUB(j)  (1280 + 64 * (j))
#define XB_XGEN(j)  (2304 + 64 * (j))
#define XB_TOP      3328
#define XB_TOPGEN   3392
#define XCD_BAR_WORDS 3456
#define XB_SPIN_CAP (1u << 18)
#ifndef XB_MID_WB
#define XB_MID_WB 0
#endif

__device__ __forceinline__ unsigned xb_ld(unsigned* p)              { return __hip_atomic_load(p, __ATOMIC_RELAXED, __HIP_MEMORY_SCOPE_AGENT); }
__device__ __forceinline__ unsigned xb_add(unsigned* p, unsigned v) { return __hip_atomic_fetch_add(p, v, __ATOMIC_RELAXED, __HIP_MEMORY_SCOPE_AGENT); }
__device__ __forceinline__ unsigned xb_xcc_id() { return (unsigned)__builtin_amdgcn_s_getreg((3 << 11) | 20) & 0xFu; }
#define XB_SPIN(cond, bar) do { unsigned _sp = 0; while (cond) { __builtin_amdgcn_s_sleep(1); \
    if ((++_sp & 255u) == 0u) { if (xb_ld(&(bar)[XB_TMO])) break; if (_sp > XB_SPIN_CAP) { atomicAdd(&(bar)[XB_TMO], 1u); break; } } } } while (0)

struct XcdBarrier {
    unsigned* bar; unsigned x;
    volatile LAS unsigned* st;
};

__device__ __forceinline__ XcdBarrier xcd_barrier_post(unsigned* bar, volatile LAS unsigned* st) {
    XcdBarrier b; b.bar = bar; b.x = xb_xcc_id(); b.st = st;
    if (threadIdx.x == 0) (void)xb_add(&bar[XB_XCNT(b.x)], 1u);
    return b;
}
__device__ __forceinline__ void xcd_barrier_complete(unsigned* bar, unsigned x, unsigned& nloc, unsigned& nx) {
    const unsigned G = gridDim.x * gridDim.y * gridDim.z;
    unsigned sum, cnt, mine, sp = 0u;
    for (;;) {
        sum = 0u; cnt = 0u; mine = 0u;
#pragma unroll
        for (unsigned j = 0; j < 16; ++j) { const unsigned c = xb_ld(&bar[XB_XCNT(j)]); sum += c; cnt += (c > 0u) ? 1u : 0u; mine = (j == x) ? c : mine; }
        if (sum == G) break;
        __builtin_amdgcn_s_sleep(1);
        if ((++sp & 255u) == 0u) { if (xb_ld(&bar[XB_TMO])) break; if (sp > XB_SPIN_CAP) { atomicAdd(&bar[XB_TMO], 1u); break; } }
    }
    nloc = mine > 0u ? mine : 1u; nx = cnt > 0u ? cnt : 1u;
}

__device__ __forceinline__ void xcd_barrier(const XcdBarrier& b) {
    asm volatile("s_waitcnt vmcnt(0)" ::: "memory");
    __syncthreads();
    if (threadIdx.x == 0) {
        unsigned* bar = b.bar;
        __builtin_amdgcn_s_waitcnt(0);
        unsigned nloc = b.st[0], nx = b.st[1];
        if (nloc == 0u) { xcd_barrier_complete(bar, b.x, nloc, nx); b.st[0] = nloc; b.st[1] = nx; }
        const unsigned old = xb_add(&bar[XB_XSUB(b.x)], 1u);
        const unsigned gen = old / nloc;
#if XB_MID_WB
        if (old - gen * nloc == nloc / 2u) asm volatile("buffer_wbl2 sc1" ::: "memory");
#endif
        if (old + 1u == (gen + 1u) * nloc) {
            __builtin_amdgcn_fence(__ATOMIC_RELEASE, "agent");
            asm volatile("s_waitcnt vmcnt(0)" ::: "memory");
            const unsigned og = xb_add(&bar[XB_TOP], 1u);
            const unsigned tg = og / nx;
            if (og + 1u == (tg + 1u) * nx) xb_add(&bar[XB_TOPGEN], 1u);
            else XB_SPIN(xb_ld(&bar[XB_TOPGEN]) == tg, bar);
            __builtin_amdgcn_fence(__ATOMIC_ACQUIRE, "agent");
            xb_add(&bar[XB_XGEN(b.x)], 1u);
            asm volatile("s_waitcnt vmcnt(0)" ::: "memory");
        } else {
            XB_SPIN(xb_ld(&bar[XB_XGEN(b.x)]) == gen, bar);
            __builtin_amdgcn_fence(__ATOMIC_ACQUIRE, "agent");
            asm volatile("s_waitcnt vmcnt(0)" ::: "memory");
        }
    }
    __syncthreads();
}
#define OPAQUE_LANE() int tid_ = threadIdx.x; asm volatile("" : "+v"(tid_)); const int lane_ = tid_ & 63, wave_ = __builtin_amdgcn_readfirstlane(tid_ >> 6); (void)lane_; (void)wave_
struct Frame {
    LAS unsigned char* lds;
    volatile LAS unsigned* MISC;
    gu32* ctl;
    int tid, lane, wave;
    int vcu, G;
    unsigned char* ws;
    const float* const* in;
};
__device__ __forceinline__ float wave_sum(float v) {
#pragma unroll
    for (int o = 1; o < 64; o <<= 1) v += __shfl_xor(v, o);
    return v;
}
struct CvItem { const float* src; size_t rowstep; const float* gain; bf16* dst; int K, perm; };
__device__ const float CV_ONES[64] = {1.f,1.f,1.f,1.f,1.f,1.f,1.f,1.f,1.f,1.f,1.f,1.f,1.f,1.f,1.f,1.f,1.f,1.f,1.f,1.f,1.f,1.f,1.f,1.f,1.f,1.f,1.f,1.f,1.f,1.f,1.f,1.f,
                                      1.f,1.f,1.f,1.f,1.f,1.f,1.f,1.f,1.f,1.f,1.f,1.f,1.f,1.f,1.f,1.f,1.f,1.f,1.f,1.f,1.f,1.f,1.f,1.f,1.f,1.f,1.f,1.f,1.f,1.f,1.f,1.f};
constexpr int CVB_GAIN = 8192, CVB_BYTES = CVB_GAIN + 256, CV_GROUP = 9;
static_assert(15 * CVB_BYTES <= RING_BYTES && RSTAB_OFF + CVB_BYTES <= LDS_BYTES && CVB_BYTES % 16 == 0 && RSTAB_OFF % 16 == 0, "conversion buffers");
__device__ __forceinline__ CvItem cv_make(const float* W, int K, int N, bf16* WT, const float* gain, int gu_mode, int item, int lane) {
    const int nblk = N / 32, kb = item / nblk, nb = item - kb * nblk, k0 = 64 * kb, n0 = 32 * nb;
    int d0 = n0, perm = 0; if (gu_mode == 1) { const int isu = n0 >= DFF ? 1 : 0, nn = n0 - isu * DFF; d0 = (nn >> 7) * 256 + isu * 128 + (nn & 127); }
    if (gu_mode == 2 && n0 < 2560) { const int d = n0 & 127; d0 = (n0 & ~127) + 64 * (d >> 6) + 4 * ((d >> 5) & 1); perm = 1; }
    CvItem c; c.perm = perm; c.src = W + (size_t)(k0 + 8 * (lane & 7)) * N + n0 + 8 * (lane >> 4) + 4 * ((lane >> 3) & 1); c.rowstep = (size_t)N;
    c.gain = (gain ? gain + k0 : CV_ONES) + lane;
    c.dst = WT + (size_t)d0 * K + k0; c.K = K; return c;
}
__device__ __forceinline__ void cv_issue(const CvItem& c, LAS unsigned char* buf) {
#pragma unroll
    for (int i = 0; i < 8; ++i) __builtin_amdgcn_global_load_lds((const unsigned*)(c.src + (size_t)i * c.rowstep), (LAS unsigned*)(buf + 1024 * i), 16, 0, 2);
    __builtin_amdgcn_global_load_lds((const unsigned*)c.gain, (LAS unsigned*)(buf + CVB_GAIN), 4, 0, 0);
}
__device__ __forceinline__ void cv_finish(const CvItem& c, LAS unsigned char* buf, int lane) {
    typedef float f2 __attribute__((ext_vector_type(2)));
    const int cc = lane & 7, nq = lane >> 3;
    const unsigned a = (unsigned)(uintptr_t)buf + (unsigned)(128 * (nq >> 2) + 16 * cc + 4 * (nq & 3)), ga = (unsigned)(uintptr_t)buf + (unsigned)(CVB_GAIN + 32 * cc);
    f2 r0, r1, r2, r3, r4, r5, r6, r7, r8, r9, r10, r11, r12, r13, r14, r15; f32x4 g0, g1;
    asm volatile(
        "ds_read2st64_b32 %0, %18 offset0:0 offset1:4\n\t"
        "ds_read2st64_b32 %1, %18 offset0:8 offset1:12\n\t"
        "ds_read2st64_b32 %2, %18 offset0:16 offset1:20\n\t"
        "ds_read2st64_b32 %3, %18 offset0:24 offset1:28\n\t"
        "ds_read2st64_b32 %4, %18 offset0:1 offset1:5\n\t"
        "ds_read2st64_b32 %5, %18 offset0:9 offset1:13\n\t"
        "ds_read2st64_b32 %6, %18 offset0:17 offset1:21\n\t"
        "ds_read2st64_b32 %7, %18 offset0:25 offset1:29\n\t"
        "ds_read2st64_b32 %8, %18 offset0:2 offset1:6\n\t"
        "ds_read2st64_b32 %9, %18 offset0:10 offset1:14\n\t"
        "ds_read2st64_b32 %10, %18 offset0:18 offset1:22\n\t"
        "ds_read2st64_b32 %11, %18 offset0:26 offset1:30\n\t"
        "ds_read2st64_b32 %12, %18 offset0:3 offset1:7\n\t"
        "ds_read2st64_b32 %13, %18 offset0:11 offset1:15\n\t"
        "ds_read2st64_b32 %14, %18 offset0:19 offset1:23\n\t"
        "ds_read2st64_b32 %15, %18 offset0:27 offset1:31\n\t"
        "ds_read_b128 %16, %19\n\t"
        "ds_read_b128 %17, %19 offset:16\n\t"
        "s_waitcnt lgkmcnt(0)"
        : "=&v"(r0), "=&v"(r1), "=&v"(r2), "=&v"(r3), "=&v"(r4), "=&v"(r5), "=&v"(r6), "=&v"(r7), "=&v"(r8), "=&v"(r9), "=&v"(r10), "=&v"(r11), "=&v"(r12), "=&v"(r13), "=&v"(r14), "=&v"(r15), "=&v"(g0), "=&v"(g1)
        : "v"(a), "v"(ga) : "memory");
#define CV_OUT(j, ra, rb, rc, rd) do { const int n = nq + 8 * (j); v4u o; o.x = pg8::cvt_pk_bf16(ra.x * g0.x, ra.y * g0.y); o.y = pg8::cvt_pk_bf16(rb.x * g0.z, rb.y * g0.w); \
        o.z = pg8::cvt_pk_bf16(rc.x * g1.x, rc.y * g1.y); o.w = pg8::cvt_pk_bf16(rd.x * g1.z, rd.y * g1.w); \
        const int nrow = c.perm ? 8 * (n >> 2) + (n & 3) : n; *(GAS v4u*)(c.dst + (size_t)nrow * c.K + 8 * cc) = o; } while (0)
    CV_OUT(0, r0, r1, r2, r3); CV_OUT(1, r4, r5, r6, r7); CV_OUT(2, r8, r9, r10, r11); CV_OUT(3, r12, r13, r14, r15);
#undef CV_OUT
}
__device__ __forceinline__ void sincos_acc(float ang, float& sn, float& cs) {
    const double a = (double)ang; const double kq = __builtin_rint(a * 0.63661977236758134308);
    double r = __builtin_fma(-kq, 1.5707963267948966192, a); r = __builtin_fma(-kq, 6.123233995736766036e-17, r);
    const double r2 = r * r;
    double ps = -1.0 / 1307674368000.0; ps = ps * r2 + 1.0 / 6227020800.0; ps = ps * r2 - 1.0 / 39916800.0; ps = ps * r2 + 1.0 / 362880.0; ps = ps * r2 - 1.0 / 5040.0; ps = ps * r2 + 1.0 / 120.0; ps = ps * r2 - 1.0 / 6.0; ps = ps * r2 + 1.0;
    const double s = ps * r;
    double pc = 1.0 / 20922789888000.0; pc = pc * r2 - 1.0 / 87178291200.0; pc = pc * r2 + 1.0 / 479001600.0; pc = pc * r2 - 1.0 / 3628800.0; pc = pc * r2 + 1.0 / 40320.0; pc = pc * r2 - 1.0 / 720.0; pc = pc * r2 + 1.0 / 24.0; pc = pc * r2 - 0.5; pc = pc * r2 + 1.0;
    const int q = ((int)kq) & 3;
    const double ss = (q == 0) ? s : (q == 1) ? pc : (q == 2) ? -s : -pc;
    const double cc = (q == 0) ? pc : (q == 1) ? -s : (q == 2) ? -pc : s;
    sn = (float)ss; cs = (float)cc;
}
enum { CK_GU = 0, CK_D, CK_QKV, CK_O, CK_IN, CK_OUT, CK_G };
constexpr int CV_NMAT = 26, CV_TOTAL = 158720, CV_X0 = 13824;
__device__ const int CV_SLOT_START[11] = {13824, 30208, 42496, 58880, 75264, 91648, 108032, 120320, 136704, 153088, 169472};
__device__ const int CV_CUM[CV_NMAT + 1] = {0, 11264, 16896, 19968, 22016, 33280, 38912, 50176, 55808, 59904, 61952, 62464, 73728, 79360, 90624, 96256, 99328, 101376, 112640, 118272, 129536, 135168, 139264, 141312, 141824, 153088, 158720};
__device__ const int CV_KIND[CV_NMAT] = {CK_GU, CK_D, CK_QKV, CK_O, CK_GU, CK_D, CK_GU, CK_D, CK_IN, CK_OUT, CK_G, CK_GU, CK_D, CK_GU, CK_D, CK_QKV, CK_O, CK_GU, CK_D, CK_GU, CK_D, CK_IN, CK_OUT, CK_G, CK_GU, CK_D};
__device__ const int CV_IDX[CV_NMAT]  = {0, 0, 0, 0, 1, 1, 2, 2, 0, 0, 0, 3, 3, 4, 4, 1, 1, 5, 5, 6, 6, 1, 1, 1, 7, 7};
struct CvMat { int lo, hi; const float* W; bf16* WT; const float* gain; int K, N, gm; };
__device__ __forceinline__ CvMat cv_mat(Frame& F, int it) {
    int m = 0; while (it >= CV_CUM[m + 1]) ++m;
    const int kind = CV_KIND[m], ix = CV_IDX[m];
    CvMat M; M.lo = CV_CUM[m]; M.hi = CV_CUM[m + 1]; M.gain = nullptr; M.gm = 0;
    if (kind == CK_GU)       { M.W = F.in[2] + (size_t)ix * DM * NGU; M.K = DM; M.N = NGU; M.WT = (bf16*)(F.ws + WS_WGU + ix * SZ_WGU); M.gain = F.in[1] + ix * DM; M.gm = 1; }
    else if (kind == CK_D)   { M.W = F.in[3] + (size_t)ix * DFF * DM; M.K = DFF; M.N = DM; M.WT = (bf16*)(F.ws + WS_WD + ix * SZ_WD); }
    else if (kind == CK_QKV) { M.W = F.in[5] + (size_t)ix * DM * QKVD; M.K = DM; M.N = QKVD; M.WT = (bf16*)(F.ws + WS_WQKV + ix * SZ_WQKV); M.gain = F.in[4] + ix * DM; M.gm = 2; }
    else if (kind == CK_O)   { M.W = F.in[8] + (size_t)ix * DM * DM; M.K = DM; M.N = DM; M.WT = (bf16*)(F.ws + WS_WO + ix * SZ_WO); }
    else if (kind == CK_IN)  { M.W = F.in[10] + (size_t)ix * DM * 2 * DRNN; M.K = DM; M.N = 2 * DRNN; M.WT = (bf16*)(F.ws + WS_WIN + ix * SZ_WIN); M.gain = F.in[9] + ix * DM; }
    else if (kind == CK_OUT) { M.W = F.in[16] + (size_t)ix * DRNN * DM; M.K = DRNN; M.N = DM; M.WT = (bf16*)(F.ws + WS_WOUT + ix * SZ_WOUT); }
    else { const int r = it - M.lo, b = ix * 64 + (r >> 3); M.lo += r & ~7; M.hi = M.lo + 8; M.W = F.in[13] + (size_t)b * 16384; M.K = 128; M.N = 128; M.WT = (bf16*)(F.ws + WS_WG) + (size_t)b * 16384; }
    return M;
}
#define CV_WAIT(n) asm volatile("s_waitcnt vmcnt(%0)" :: "n"(n) : "memory")
__device__ __forceinline__ void convert_range(Frame& F, int lo, int hi, int rank, int nranks) {
    OPAQUE_LANE();
    const int b0 = 2 * wave_;
    LAS unsigned char* bufA = F.lds + RING_OFF + b0 * CVB_BYTES; LAS unsigned char* bufB = (b0 + 1 < 15) ? F.lds + RING_OFF + (b0 + 1) * CVB_BYTES : F.lds + RSTAB_OFF;
    if (hi > CV_TOTAL) hi = CV_TOTAL;
    const int step = nranks * NWAVES; int it = lo + rank * NWAVES + wave_;
    if (it >= hi) return;
    CvMat M = cv_mat(F, it);
#define CV_ITEM(it_) ({ if ((it_) >= M.hi) M = cv_mat(F, (it_)); cv_make(M.W, M.K, M.N, M.WT, M.gain, M.gm, (it_) - M.lo, lane_); })
    CvItem A = CV_ITEM(it); cv_issue(A, bufA);
    for (;;) {
        const int itb = it + step; const bool mb = itb < hi; CvItem B = A;
        if (mb) { B = CV_ITEM(itb); cv_issue(B, bufB); CV_WAIT(CV_GROUP); } else CV_WAIT(0);
        cv_finish(A, bufA, lane_);
        if (!mb) break;
        it = itb + step; const bool ma = it < hi;
        if (ma) { A = CV_ITEM(it); cv_issue(A, bufA); CV_WAIT(CV_GROUP); } else CV_WAIT(0);
        cv_finish(B, bufB, lane_);
        if (!ma) break;
    }
#undef CV_ITEM
}
__device__ __forceinline__ void p0_prologue(Frame& F) {
    OPAQUE_LANE();
    const int gw = F.vcu * NWAVES + wave_, NGW = F.G * NWAVES;
    convert_range(F, 0, CV_X0, F.vcu, F.G);
    { bf16* XB = (bf16*)(F.ws + WS_XB); pg8::ss_t* ss0 = (pg8::ss_t*)(F.ws + WS_SS);
      for (int m = gw; m < S; m += NGW) {
        const GAS f32x4* xr = (const GAS f32x4*)(F.in[0] + (size_t)m * DM) + lane_; f32x4 v[8]; float s = 0.f;
#pragma unroll
        for (int j = 0; j < 8; ++j) { v[j] = xr[64 * j]; s += (v[j].x * v[j].x + v[j].y * v[j].y) + (v[j].z * v[j].z + v[j].w * v[j].w); }
        s = wave_sum(s); if (lane_ == 0) ss0[m] = (pg8::ss_t)(s * pg8::SS_SCALE);
        GAS unsigned long long* o8 = (GAS unsigned long long*)(XB + (size_t)m * DM) + lane_;
#pragma unroll
        for (int j = 0; j < 8; ++j) o8[64 * j] = (unsigned long long)pk2(v[j].x, v[j].y) | ((unsigned long long)pk2(v[j].z, v[j].w) << 32);
      } }
    { float* rt = (float*)(F.ws + WS_ROPE); const int gt = (F.vcu * NWAVES + wave_) * 64 + lane_;
      for (int e = gt; e < (128 + 64) * 32; e += NGW * 64) { const int f = e & 31, pe = e >> 5; const int isc = pe >= 128 ? 1 : 0, pos = pe - isc * 128;
        double inv = 1.0; for (int k = 0; k < f; ++k) inv *= 0.74989420933245582730;
        const float ang = (float)pos * (float)inv; float sn, cs; sincos_acc(ang, sn, cs);
        float* cst = rt + (isc ? 8192 : 0); const int nel = isc ? 2048 : 4096;
        cst[pos * 32 + f] = cs; cst[nel + pos * 32 + f] = sn; } }
}
__device__ __forceinline__ void rope_phase(Frame& F, const float* qg, const float* kg) {
    OPAQUE_LANE();
    bf16* QKV = (bf16*)(F.ws + WS_QKV); const float* rt = (const float*)(F.ws + WS_ROPE);
    const int gw = F.vcu * NWAVES + wave_, NGW = F.G * NWAVES, g = lane_ >> 4, j = lane_ & 15;
    const int d = 8 * j, axis = d >> 6, first = ((d & 63) < 32) ? 1 : 0, f0 = d & 31;
    const float* gq = qg + d; const float* gk = kg + d;
    const f32x4 gq0 = *(const f32x4*)gq, gq1 = *(const f32x4*)(gq + 4), gk0 = *(const f32x4*)gk, gk1 = *(const f32x4*)(gk + 4);
    for (int row = gw; row < S; row += NGW) {
        bf16* p = QKV + (size_t)row * QKVD + g * 128 + d;
        v4u w[5];
#pragma unroll
        for (int part = 0; part < 5; ++part) w[part] = *(const GAS v4u*)(p + part * 512);
        const int pos = axis ? (row & 63) : (row >> 6);
        const float* ct = rt + (axis ? 8192 : 0) + pos * 32 + f0; const float* st = ct + (axis ? 2048 : 4096);
        const f32x4 c0 = *(const f32x4*)ct, c1 = *(const f32x4*)(ct + 4), s0 = *(const f32x4*)st, s1 = *(const f32x4*)(st + 4);
        const float cs[8] = {c0.x, c0.y, c0.z, c0.w, c1.x, c1.y, c1.z, c1.w}, sn[8] = {s0.x, s0.y, s0.z, s0.w, s1.x, s1.y, s1.z, s1.w};
#pragma unroll
        for (int part = 0; part < 5; ++part) {
            float x[8] = {bf_lo(w[part].x), bf_hi(w[part].x), bf_lo(w[part].y), bf_hi(w[part].y), bf_lo(w[part].z), bf_hi(w[part].z), bf_lo(w[part].w), bf_hi(w[part].w)};
            float ssq = 0.f;
#pragma unroll
            for (int e = 0; e < 8; ++e) ssq += x[e] * x[e];
            ssq += __shfl_xor(ssq, 1); ssq += __shfl_xor(ssq, 2); ssq += __shfl_xor(ssq, 4); ssq += __shfl_xor(ssq, 8);
            const float rstd = __builtin_amdgcn_rsqf(ssq * (1.0f / 128.0f) + NORM_EPS);
            const f32x4 g0 = part < 4 ? gq0 : gk0, g1 = part < 4 ? gq1 : gk1;
            const float gn[8] = {g0.x, g0.y, g0.z, g0.w, g1.x, g1.y, g1.z, g1.w};
            float o[8];
#pragma unroll
            for (int e = 0; e < 8; ++e) { const float xn = x[e] * rstd * gn[e]; const float pn = __shfl_xor(xn, 4);
                o[e] = first ? (xn * cs[e] - pn * sn[e]) : (xn * cs[e] + pn * sn[e]); }
            v4u ow; ow.x = pk2(o[0], o[1]); ow.y = pk2(o[2], o[3]); ow.z = pk2(o[4], o[5]); ow.w = pk2(o[6], o[7]);
            *(GAS v4u*)(p + part * 512) = ow;
        }
    }
}
__device__ __forceinline__ void attn_phase(Frame& F, char* lds) {
    const att::bf16* QKV = (const att::bf16*)(F.ws + WS_QKV); att::bf16* O = (att::bf16*)(F.ws + WS_O);
    for (int u = F.vcu; u < 512; u += F.G) {
        const int i = u >> 8, x = (u & 255) >> 5, l = u & 31, kvh = x >> 1, h = kvh * 4 + (x & 1) * 2 + i, qb = l;
        att::attn_dense_body(QKV + (size_t)(qb * 256) * QKVD + h * 128, QKV + 2048 + kvh * 128, QKV + 2560 + kvh * 128, O + (size_t)(qb * 256) * DM + h * 128, S, lds);
    }
}
constexpr int SC_AT = 0, SC_ATP = 272;
constexpr int SC_AB = 9216;
constexpr int SC_H = SC_AB + 65536;
constexpr int SC_CR = SC_H + 32768;
static_assert(SC_CR + 16384 <= RING_BYTES, "scan LDS map");
#define LDS_BARRIER() do { asm volatile("s_waitcnt lgkmcnt(0)" ::: "memory"); __builtin_amdgcn_s_barrier(); asm volatile("" ::: "memory"); } while (0)
struct RecArgs { const bf16* U; const bf16* Wg; const float* gate_b; const float* lam; const float* conv_w; const float* conv_b; float2* aggs; float2* aggc; bf16* Y; unsigned* AB; };
__device__ __forceinline__ float sigmoid_f(float x) { return __builtin_amdgcn_rcpf(1.0f + __builtin_amdgcn_exp2f(x * -1.4426950408889634f)); }
__device__ __forceinline__ unsigned pk2r(float lo, float hi) { unsigned r; asm volatile("v_cvt_pk_bf16_f32 %0, %1, %2" : "=v"(r) : "v"(lo), "v"(hi)); return r; }
__device__ __forceinline__ float bfl_(unsigned w) { return __builtin_bit_cast(float, w << 16); }
__device__ __forceinline__ float bfh_(unsigned w) { return __builtin_bit_cast(float, w & 0xffff0000u); }
template <int PASS>
__device__ __forceinline__ void rec_pass(Frame& F, char* lds, const RecArgs& R) {
    typedef float f32x4v __attribute__((ext_vector_type(4)));
    OPAQUE_LANE();
    const int tid = tid_, lane = lane_, w = wave_, wd = w >> 2, wq = w & 3, l15 = lane & 15, l4 = lane >> 4;
    const int tl = tid >> 4, c8 = (tid & 15) * 8;
    const int sd = tid >> 7, sch = tid & 127;
    constexpr float L2E = 1.4426950408889634f, LN2x2 = 1.3862943611198906f;
    for (int item = F.vcu; item < 256; item += F.G) {
        const int n = item & 15, c = item >> 4;
        if (PASS == 2 && tid < 256) {
            const int ch = n * 128 + sch; float* cr = (float*)(lds + SC_CR);
            float h = 0.f;
            const int nf = sd ? 15 - c : c, first = sd ? 15 : 0, step = sd ? -1 : 1;
            for (int k0 = 0; k0 < nf; k0 += 4) { float2 v[4];
#pragma unroll
                for (int j = 0; j < 4; ++j) { int cc = first + step * (k0 + j); cc = cc < 0 ? 0 : (cc > 15 ? 15 : cc); v[j] = R.aggc[(size_t)(cc * 2 + sd) * DRNN + ch]; }
#pragma unroll
                for (int j = 0; j < 4; ++j) if (k0 + j < nf) h = v[j].x * h + v[j].y; }
            for (int k0 = 0; k0 < 16; k0 += 4) { float2 v[4];
#pragma unroll
                for (int j = 0; j < 4; ++j) { const int ss_ = first + step * (k0 + j); v[j] = R.aggs[(size_t)((c * 16 + ss_) * 2 + sd) * DRNN + ch]; }
#pragma unroll
                for (int j = 0; j < 4; ++j) { const int ss_ = first + step * (k0 + j); cr[(ss_ * 2 + sd) * 128 + sch] = h; h = v[j].x * h + v[j].y; } }
        }
        asm volatile("" ::: "memory");
        bf16x8 bfr[2][2][4];
#pragma unroll
        for (int z = 0; z < 2; ++z)
#pragma unroll
            for (int nt = 0; nt < 2; ++nt)
#pragma unroll
                for (int ks = 0; ks < 4; ++ks)
                    bfr[z][nt][ks] = *(const GAS bf16x8*)(R.Wg + ((size_t)(((wd * 2 + z) * 16 + n) * 128 + wq * 32 + nt * 16 + l15)) * 128 + ks * 32 + l4 * 8);
        float brn[2], bin[2], spn[2];
#pragma unroll
        for (int nt = 0; nt < 2; ++nt) { const int ch = n * 128 + wq * 32 + nt * 16 + l15; brn[nt] = -L2E * R.gate_b[(wd * 2 + 0) * DRNN + ch]; bin[nt] = -L2E * R.gate_b[(wd * 2 + 1) * DRNN + ch];
            const float lm = R.lam[wd * DRNN + ch]; spn[nt] = -L2E * 8.0f * log1pf(__expf(-lm)); }
        float cw[4][8], cb[8];
        { const int ch0 = n * 128 + c8;
#pragma unroll
          for (int tp = 0; tp < 4; ++tp) { const f32x4v a = *(const f32x4v*)(R.conv_w + tp * DRNN + ch0), b = *(const f32x4v*)(R.conv_w + tp * DRNN + ch0 + 4);
              cw[tp][0] = a.x; cw[tp][1] = a.y; cw[tp][2] = a.z; cw[tp][3] = a.w; cw[tp][4] = b.x; cw[tp][5] = b.y; cw[tp][6] = b.z; cw[tp][7] = b.w; }
          const f32x4v a = *(const f32x4v*)(R.conv_b + ch0), b = *(const f32x4v*)(R.conv_b + ch0 + 4);
          cb[0] = a.x; cb[1] = a.y; cb[2] = a.z; cb[3] = a.w; cb[4] = b.x; cb[5] = b.y; cb[6] = b.z; cb[7] = b.w; }
        float aggA = 1.f, aggB = 0.f;
        const bf16* Urec = R.U + DRNN + n * 128 + c8; const bf16* Ugate = R.U + n * 128 + c8;
        v4u un[4], gn = (v4u){0u, 0u, 0u, 0u};
#define REC_LOAD(t0_) do { const int t_ = (t0_) + tl; _Pragma("unroll") for (int tp = 0; tp < 4; ++tp) { const int tt = t_ + tp - 2; un[tp] = (v4u){0u, 0u, 0u, 0u}; \
            if (tt >= 0 && tt < S) un[tp] = *(const GAS v4u*)(Urec + (size_t)tt * (2 * DRNN)); } if (PASS == 2) gn = *(const GAS v4u*)(Ugate + (size_t)t_ * (2 * DRNN)); } while (0)
        REC_LOAD(c * 512);
        for (int s = 0; s < 16; ++s) {
            const int t0 = c * 512 + s * 32;
            v4u gcur = gn;
            { float xc[8];
#pragma unroll
              for (int e = 0; e < 8; ++e) xc[e] = cb[e];
#pragma unroll
              for (int tp = 0; tp < 4; ++tp) { const v4u wv = un[tp];
                  xc[0] += cw[tp][0] * bf_lo(wv.x); xc[1] += cw[tp][1] * bf_hi(wv.x); xc[2] += cw[tp][2] * bf_lo(wv.y); xc[3] += cw[tp][3] * bf_hi(wv.y);
                  xc[4] += cw[tp][4] * bf_lo(wv.z); xc[5] += cw[tp][5] * bf_hi(wv.z); xc[6] += cw[tp][6] * bf_lo(wv.w); xc[7] += cw[tp][7] * bf_hi(wv.w); }
              v4u o; o.x = pk2(xc[0], xc[1]); o.y = pk2(xc[2], xc[3]); o.z = pk2(xc[4], xc[5]); o.w = pk2(xc[6], xc[7]);
              *(v4u*)(lds + SC_AT + tl * SC_ATP + c8 * 2) = o; }
            if (s < 15) REC_LOAD(t0 + 32);
            LDS_BARRIER();
#pragma unroll
            for (int mt = 0; mt < 2; ++mt) {
                bf16x8 af[4];
#pragma unroll
                for (int ks = 0; ks < 4; ++ks) af[ks] = *(const bf16x8*)(lds + SC_AT + (mt * 16 + l15) * SC_ATP + (ks * 32 + l4 * 8) * 2);
                f32x4v acc[2][2];
#pragma unroll
                for (int z = 0; z < 2; ++z)
#pragma unroll
                    for (int nt = 0; nt < 2; ++nt) { acc[z][nt] = (f32x4v){0.f, 0.f, 0.f, 0.f};
#pragma unroll
                        for (int ks = 0; ks < 4; ++ks) acc[z][nt] = __builtin_amdgcn_mfma_f32_16x16x32_bf16(af[ks], bfr[z][nt][ks], acc[z][nt], 0, 0, 0); }
#pragma unroll
                for (int nt = 0; nt < 2; ++nt)
#pragma unroll
                    for (int rg = 0; rg < 4; ++rg) { const int tt = mt * 16 + l4 * 4 + rg, chl = wq * 32 + nt * 16 + l15;
                        const float er = __builtin_amdgcn_exp2f(__builtin_fmaf(acc[0][nt][rg], -L2E, brn[nt])), ei = __builtin_amdgcn_exp2f(__builtin_fmaf(acc[1][nt][rg], -L2E, bin[nt]));
                        const float rgate = __builtin_amdgcn_rcpf(1.0f + er), igate = __builtin_amdgcn_rcpf(1.0f + ei);
                        const float l2 = bfl_(pk2r(spn[nt] * rgate, 0.f)), a = __builtin_amdgcn_exp2f(l2), x2 = l2 * LN2x2;
                        float emp = -x2 * (1.0f + x2 * (0.5f + x2 * (0.16666667f + x2 * 0.041666668f))); asm volatile("" : "+v"(emp));
                        const float em = (x2 > -0.1f) ? emp : __builtin_fmaf(-a, a, 1.0f);
                        const float xv = __builtin_bit_cast(float, ((unsigned)*(const unsigned short*)(lds + SC_AT + tt * SC_ATP + chl * 2)) << 16);
                        const unsigned pw = pk2r(l2, __builtin_amdgcn_sqrtf(em) * igate * xv); const float bb = bfh_(pw);
                        if (PASS == 1) R.AB[(size_t)(item * 16 + s) * 8192 + (wd * 32 + tt) * 128 + chl] = pw;
                        *(float*)(lds + SC_AB + ((wd * 2 + 0) * 32 + tt) * 512 + chl * 4) = a;
                        *(float*)(lds + SC_AB + ((wd * 2 + 1) * 32 + tt) * 512 + chl * 4) = bb; }
            }
            LDS_BARRIER();
            if (tid < 256) {
                const float* pa = (const float*)(lds + SC_AB + (sd * 2 + 0) * 16384) + sch; const float* pb = (const float*)(lds + SC_AB + (sd * 2 + 1) * 16384) + sch;
                if (PASS == 1) {
                    float P = 1.f, h = 0.f;
#pragma nounroll
                    for (int k0 = 0; k0 < 32; k0 += 8) { float a8[8], b8[8];
#pragma unroll
                        for (int j = 0; j < 8; ++j) { const int t = sd ? 31 - (k0 + j) : k0 + j; a8[j] = pa[t * 128]; b8[j] = pb[t * 128]; }
#pragma unroll
                        for (int j = 0; j < 8; ++j) { h = a8[j] * h + b8[j]; P *= a8[j]; } }
                    R.aggs[(size_t)((c * 16 + s) * 2 + sd) * DRNN + n * 128 + sch] = make_float2(P, h);
                    if (sd == 0) { aggB = P * aggB + h; aggA = P * aggA; } else { aggB = aggA * h + aggB; aggA = aggA * P; }
                } else {
                    float h = *((const float*)(lds + SC_CR) + (s * 2 + sd) * 128 + sch); float* ph = (float*)(lds + SC_H + sd * 16384) + sch;
#pragma nounroll
                    for (int k0 = 0; k0 < 32; k0 += 8) { float a8[8], b8[8];
#pragma unroll
                        for (int j = 0; j < 8; ++j) { const int t = sd ? 31 - (k0 + j) : k0 + j; a8[j] = pa[t * 128]; b8[j] = pb[t * 128]; }
#pragma unroll
                        for (int j = 0; j < 8; ++j) { const int t = sd ? 31 - (k0 + j) : k0 + j; h = a8[j] * h + b8[j]; ph[t * 128] = h; } }
                }
            }
            if (PASS == 2) {
                LDS_BARRIER();
                const float* hf = (const float*)(lds + SC_H + tl * 512 + c8 * 4); const float* hb = (const float*)(lds + SC_H + 16384 + tl * 512 + c8 * 4);
                const f32x4v f0 = *(const f32x4v*)hf, f1 = *(const f32x4v*)(hf + 4), b0 = *(const f32x4v*)hb, b1 = *(const f32x4v*)(hb + 4);
                const int t = t0 + tl;
                const float gx[8] = {bf_lo(gcur.x), bf_hi(gcur.x), bf_lo(gcur.y), bf_hi(gcur.y), bf_lo(gcur.z), bf_hi(gcur.z), bf_lo(gcur.w), bf_hi(gcur.w)};
                const float hs[8] = {f0.x + b0.x, f0.y + b0.y, f0.z + b0.z, f0.w + b0.w, f1.x + b1.x, f1.y + b1.y, f1.z + b1.z, f1.w + b1.w};
                float y[8];
#pragma unroll
                for (int e = 0; e < 8; ++e) { const float v = gx[e]; const float u = 1.5957691216057308f * (v + 0.044715f * v * v * v); y[e] = v * sigmoid_f(u) * hs[e]; }
                v4u o; o.x = pk2(y[0], y[1]); o.y = pk2(y[2], y[3]); o.z = pk2(y[4], y[5]); o.w = pk2(y[6], y[7]);
                *(GAS v4u*)(R.Y + (size_t)t * DRNN + n * 128 + c8) = o;
            }
        }
#undef REC_LOAD
        if (PASS == 1 && tid < 256) R.aggc[(size_t)(c * 2 + sd) * DRNN + n * 128 + sch] = make_float2(aggA, aggB);
        __syncthreads();
    }
}
__device__ __forceinline__ void rec_pass2s(Frame& F, char* lds, const RecArgs& R) {
    typedef float f32x4v __attribute__((ext_vector_type(4)));
    OPAQUE_LANE();
    const int tid = tid_;
    const int tl = tid >> 4, c8 = (tid & 15) * 8;
    const int sd = tid >> 7, sch = tid & 127;
    for (int item = F.vcu; item < 256; item += F.G) {
        const int n = item & 15, c = item >> 4;
        if (tid < 256) {
            const int ch = n * 128 + sch; float* cr = (float*)(lds + SC_CR);
            const int first = sd ? 15 : 0, step = sd ? -1 : 1, nf = sd ? 15 - c : c;
            float2 vc[16], vs[16];
#pragma unroll
            for (int j = 0; j < 16; ++j) { const int cc = first + step * j; vc[j] = R.aggc[(size_t)(cc * 2 + sd) * DRNN + ch]; vs[j] = R.aggs[(size_t)((c * 16 + cc) * 2 + sd) * DRNN + ch]; }
            float h = 0.f;
#pragma unroll
            for (int j = 0; j < 16; ++j) if (j < nf) h = vc[j].x * h + vc[j].y;
#pragma unroll
            for (int j = 0; j < 16; ++j) { const int ss_ = first + step * j; cr[(ss_ * 2 + sd) * 128 + sch] = h; h = vs[j].x * h + vs[j].y; }
        }
        asm volatile("" ::: "memory");
        const unsigned* abp = R.AB + (size_t)item * 16 * 8192; const bf16* Ugate = R.U + n * 128 + c8;
        v4u pn[4], gn;
#define REC2_LOAD(s_) do { _Pragma("unroll") for (int i = 0; i < 4; ++i) pn[i] = *(const GAS v4u*)(abp + (size_t)(s_) * 8192 + (tid + 512 * i) * 4); \
            gn = *(const GAS v4u*)(Ugate + (size_t)(c * 512 + (s_) * 32 + tl) * (2 * DRNN)); } while (0)
        REC2_LOAD(0);
        for (int s = 0; s < 16; ++s) {
            const int t0 = c * 512 + s * 32;
            const v4u gcur = gn;
#pragma unroll
            for (int i = 0; i < 4; ++i) { const int idx = tid + 512 * i, dir = idx >> 10, t = (idx >> 5) & 31, c4 = (idx & 31) * 4; const v4u p = pn[i];
                const f32x4v a4 = {__builtin_amdgcn_exp2f(bfl_(p.x)), __builtin_amdgcn_exp2f(bfl_(p.y)), __builtin_amdgcn_exp2f(bfl_(p.z)), __builtin_amdgcn_exp2f(bfl_(p.w))};
                const f32x4v b4 = {bfh_(p.x), bfh_(p.y), bfh_(p.z), bfh_(p.w)};
                *(f32x4v*)(lds + SC_AB + ((dir * 2 + 0) * 32 + t) * 512 + c4 * 4) = a4;
                *(f32x4v*)(lds + SC_AB + ((dir * 2 + 1) * 32 + t) * 512 + c4 * 4) = b4; }
            if (s < 15) REC2_LOAD(s + 1);
            LDS_BARRIER();
            if (tid < 256) {
                const float* pa = (const float*)(lds + SC_AB + (sd * 2 + 0) * 16384) + sch; const float* pb = (const float*)(lds + SC_AB + (sd * 2 + 1) * 16384) + sch;
                float h = *((const float*)(lds + SC_CR) + (s * 2 + sd) * 128 + sch); float* ph = (float*)(lds + SC_H + sd * 16384) + sch;
#pragma nounroll
                for (int k0 = 0; k0 < 32; k0 += 8) { float a8[8], b8[8];
#pragma unroll
                    for (int j = 0; j < 8; ++j) { const int t = sd ? 31 - (k0 + j) : k0 + j; a8[j] = pa[t * 128]; b8[j] = pb[t * 128]; }
#pragma unroll
                    for (int j = 0; j < 8; ++j) { const int t = sd ? 31 - (k0 + j) : k0 + j; h = a8[j] * h + b8[j]; ph[t * 128] = h; } }
            }
            LDS_BARRIER();
            { const float* hf = (const float*)(lds + SC_H + tl * 512 + c8 * 4); const float* hb = (const float*)(lds + SC_H + 16384 + tl * 512 + c8 * 4);
              const f32x4v f0 = *(const f32x4v*)hf, f1 = *(const f32x4v*)(hf + 4), b0 = *(const f32x4v*)hb, b1 = *(const f32x4v*)(hb + 4);
              const int t = t0 + tl;
              const float gx[8] = {bf_lo(gcur.x), bf_hi(gcur.x), bf_lo(gcur.y), bf_hi(gcur.y), bf_lo(gcur.z), bf_hi(gcur.z), bf_lo(gcur.w), bf_hi(gcur.w)};
              const float hs[8] = {f0.x + b0.x, f0.y + b0.y, f0.z + b0.z, f0.w + b0.w, f1.x + b1.x, f1.y + b1.y, f1.z + b1.z, f1.w + b1.w};
              float y[8];
#pragma unroll
              for (int e = 0; e < 8; ++e) { const float v = gx[e]; const float u = 1.5957691216057308f * (v + 0.044715f * v * v * v); y[e] = v * sigmoid_f(u) * hs[e]; }
              v4u o; o.x = pk2(y[0], y[1]); o.y = pk2(y[2], y[3]); o.z = pk2(y[4], y[5]); o.w = pk2(y[6], y[7]);
              *(GAS v4u*)(R.Y + (size_t)t * DRNN + n * 128 + c8) = o; }
        }
#undef REC2_LOAD
        LDS_BARRIER();
    }
}
__device__ __forceinline__ void final_norm_phase(Frame& F, const bf16* X, float* out, const pg8::ss_t* ss, const float* g) {
    OPAQUE_LANE();
    const int gw = F.vcu * NWAVES + wave_, NGW = F.G * NWAVES;
    f32x4 gv[4][2];
#pragma unroll
    for (int j = 0; j < 4; ++j) { gv[j][0] = *((const GAS f32x4*)g + 2 * (lane_ + 64 * j)); gv[j][1] = *((const GAS f32x4*)g + 2 * (lane_ + 64 * j) + 1); }
    for (int m = gw; m < S; m += NGW) { const GAS v4u* xr = (const GAS v4u*)(X + (size_t)m * DM) + lane_; GAS f32x4* orow = (GAS f32x4*)(out + (size_t)m * DM);
        const float rs = pg8::rs_from_ss(ss[m]);
        v4u w[4];
#pragma unroll
        for (int j = 0; j < 4; ++j) w[j] = xr[64 * j];
#pragma unroll
        for (int j = 0; j < 4; ++j) { const f32x4 a = (f32x4){bf_lo(w[j].x), bf_hi(w[j].x), bf_lo(w[j].y), bf_hi(w[j].y)}, b = (f32x4){bf_lo(w[j].z), bf_hi(w[j].z), bf_lo(w[j].w), bf_hi(w[j].w)};
            orow[2 * (lane_ + 64 * j)] = a * rs * gv[j][0]; orow[2 * (lane_ + 64 * j) + 1] = b * rs * gv[j][1]; } }
}
__device__ __forceinline__ int opaque_i(int v) { asm volatile("" : "+s"(v)); return v; }
struct Args { const float* in[18]; float* out; unsigned char* ws; int ph_lo, ph_hi; };
static_assert(sizeof(Args) == 18 * 8 + 8 + 8 + 8, "Args has no padding");
__global__ void __launch_bounds__(NWAVES * 64, 2) mega_fwd(Args args) {
    extern __shared__ __attribute__((aligned(16))) unsigned char lds[];
    Frame F;
    F.lds = (LAS unsigned char*)lds;
    F.MISC = (volatile LAS unsigned*)(F.lds + MISC_OFF);
    F.tid = threadIdx.x; F.lane = F.tid & 63; F.wave = __builtin_amdgcn_readfirstlane(F.tid >> 6);
    F.G = gridDim.x; { const int bx = blockIdx.x; F.vcu = (F.G % 8 == 0) ? (bx % 8) * (F.G / 8) + bx / 8 : bx; }
    F.ws = args.ws; F.ctl = (gu32*)(args.ws + WS_CTL); F.in = args.in;
    for (int u = F.tid; u < (LDS_BYTES - LDSCTL_OFF) / 4; u += NWAVES * 64) ((LAS unsigned*)(F.lds + LDSCTL_OFF))[u] = 0u;
    __syncthreads();
    const int lo = args.ph_lo, hi = args.ph_hi;
    const bool use_bar = (hi - lo) > 1;
    XcdBarrier bar; bar.bar = (unsigned*)(F.ctl + CW_BAR); bar.x = 0; bar.st = nullptr;
    if (use_bar) bar = xcd_barrier_post((unsigned*)(F.ctl + CW_BAR), F.MISC + 8);
#define IN(k) (lo <= (k) && (k) < hi)
#define REP(n) for (int rep_ = 0, nrep_ = opaque_i(n); rep_ < nrep_; ++rep_)
#ifdef DBG_BARWAIT
#define SEAM(k) do { if (IN((k) + 1)) { const unsigned long long t0_ = __builtin_amdgcn_s_memrealtime(); xcd_barrier(bar); if (DBG_BW_SEL(k)) barwait += __builtin_amdgcn_s_memrealtime() - t0_; } } while (0)
#else
#define SEAM(k) do { if (IN((k) + 1)) { REP(DUP_BAR) { XcdBarrier b2_ = bar; asm volatile("" : "+s"(b2_.bar)); xcd_barrier(b2_); } } } while (0)
#endif
    unsigned long long barwait = 0; (void)barwait;
    pg8::ss_t* const ssb = (pg8::ss_t*)(args.ws + WS_SS);
    bf16* const XB = (bf16*)(args.ws + WS_XB);

    #if PH_P0
    if (IN(0)) { REP(DUP_P0) p0_prologue(F); SEAM(0); }
#endif

    for (int sb = 0; sb < NSB; ++sb) {
        typedef const __attribute__((address_space(4))) Args* KArgP;
        KArgP ap_ = (KArgP)__builtin_amdgcn_kernarg_segment_ptr(); asm volatile("" : "+s"(ap_));
        struct { const float* in[18]; float* out; unsigned char* ws; } args;
#pragma unroll
        for (int i_ = 0; i_ < 18; ++i_) args.in[i_] = ap_->in[i_];
        args.out = ap_->out; args.ws = ap_->ws;
        pg8::ss_t* const ssb = (pg8::ss_t*)(args.ws + WS_SS);
        bf16* const XB = (bf16*)(args.ws + WS_XB);
        const int p6 = sb / 6, k6 = sb - 6 * p6;
        const int type = (k6 == 1) ? 1 : (k6 == 4) ? 2 : 0;
        const int f = 4 * p6 + (k6 == 0 ? 0 : k6 == 2 ? 1 : k6 == 3 ? 2 : 3);
        const int pb = 1 + 4 * sb;
        const pg8::ss_t* ss_in = ssb + (size_t)sb * S; pg8::ss_t* ss_out = ssb + (size_t)(sb + 1) * S;
        if (IN(pb)) {
#if PH_GU
            if (type == 0) {
                pg8::Gemm g{XB, (const bf16*)(args.ws + WS_WGU + f * SZ_WGU), S, NGU, DM}; pg8::SsOrder So; So.init(S, NGU, F.G, (int)blockIdx.x); So.ss = ss_in; So.raw = F.lds + RSTAB_OFF; So.k = 0;
                pg8::EpiSwiglu E{(bf16*)(args.ws + WS_H), F.lds + RSTAB_OFF};
                REP(DUP_GU) pg8::gemm_phase<pg8::EpiSwiglu, pg8::SsOrder, true, true>(F.lds + RING_OFF, g, So, E);
                { const int rem = ((S / 256) * (NGU / 256)) % F.G, sj = (f < 1) ? 0 : (f < 5) ? f + 1 : f + 2;
                  if (rem != 0 && (int)blockIdx.x >= rem) convert_range(F, CV_SLOT_START[sj], CV_SLOT_START[sj + 1], (int)blockIdx.x - rem, F.G - rem);
                  else if (rem == 0) convert_range(F, CV_SLOT_START[sj], CV_SLOT_START[sj + 1], (int)blockIdx.x, F.G); }
            }
#endif
#if PH_PLAIN
            if (type != 0) {
                const int N = (type == 1) ? QKVD : 2 * DRNN;
                const bf16* Wt = (type == 1) ? (const bf16*)(args.ws + WS_WQKV + p6 * SZ_WQKV) : (const bf16*)(args.ws + WS_WIN + p6 * SZ_WIN);
                bf16* Out = (type == 1) ? (bf16*)(args.ws + WS_QKV) : (bf16*)(args.ws + WS_U);
                pg8::Gemm g{XB, Wt, S, N, DM}; pg8::SsOrder So; So.init(S, N, F.G, (int)blockIdx.x); So.ss = ss_in; So.raw = F.lds + RSTAB_OFF; So.k = 0;
                pg8::EpiPlain E{Out, N, F.lds + RSTAB_OFF, (type == 1) ? 10 : 0, 8, args.in[6] + p6 * 128, args.in[7] + p6 * 128, (const float*)(args.ws + WS_ROPE), (LAS float*)(F.lds + HSTAB_OFF)};
                REP(DUP_PLAIN) pg8::gemm_phase<pg8::EpiPlain, pg8::SsOrder, true, true>(F.lds + RING_OFF, g, So, E);
                if (type == 1) { const int rem = ((S / 256) * (QKVD / 256)) % F.G, sj = p6 ? 6 : 1;
                  if (rem != 0 && (int)blockIdx.x >= rem) convert_range(F, CV_SLOT_START[sj], CV_SLOT_START[sj + 1], (int)blockIdx.x - rem, F.G - rem);
                  else if (rem == 0) convert_range(F, CV_SLOT_START[sj], CV_SLOT_START[sj + 1], (int)blockIdx.x, F.G); }
            }
#endif
            SEAM(pb);
        }
        if (type == 1) {
#if PH_ROPE
#endif
#if PH_ATT
            if (IN(pb + 2)) { REP(DUP_ATT) attn_phase(F, (char*)lds + RING_OFF); SEAM(pb + 2); }
#endif
        } else if (type == 2) {
            const RecArgs R{(const bf16*)(args.ws + WS_U), (const bf16*)(args.ws + WS_WG) + (size_t)p6 * (4 * 16 * 16384), args.in[14] + p6 * 4 * DRNN, args.in[15] + p6 * 2 * DRNN,
                            args.in[11] + p6 * 4 * DRNN, args.in[12] + p6 * DRNN, (float2*)(args.ws + WS_AGGS), (float2*)(args.ws + WS_AGGC), (bf16*)(args.ws + WS_Y), (unsigned*)(args.ws + WS_AB)};
#if PH_REC1
            if (IN(pb + 1)) { REP(DUP_REC) rec_pass<1>(F, (char*)lds + RING_OFF, R); SEAM(pb + 1); }
#endif
#if PH_REC2
            if (IN(pb + 2)) { REP(DUP_REC) rec_pass2s(F, (char*)lds + RING_OFF, R); SEAM(pb + 2); }
#endif
        }
#if PH_RES
        if (IN(pb + 3)) {
            const bf16* A = (type == 0) ? (const bf16*)(args.ws + WS_H) : (type == 1) ? (const bf16*)(args.ws + WS_O) : (const bf16*)(args.ws + WS_Y);
            const bf16* Wt = (type == 0) ? (const bf16*)(args.ws + WS_WD + f * SZ_WD) : (type == 1) ? (const bf16*)(args.ws + WS_WO + p6 * SZ_WO) : (const bf16*)(args.ws + WS_WOUT + p6 * SZ_WOUT);
            const int K = (type == 0) ? DFF : DM;
            pg8::Gemm g{A, Wt, S, DM, K}; pg8::StaticOrder So; So.init(S, DM, F.G, (int)blockIdx.x, RES_WGM);
            REP(DUP_RES) {
                const bool real = (rep_ == nrep_ - 1);
                pg8::EpiResid E{XB, real ? ss_out : ssb + (size_t)13 * S, real ? (type == 0 ? 0.5f : 1.0f) : 0.0f};
                pg8::gemm_phase<pg8::EpiResid, pg8::StaticOrder, false, true>(F.lds + RING_OFF, g, So, E);
            }
            SEAM(pb + 3);
        }
#endif
    }
#ifdef DBG_BARWAIT
    if (threadIdx.x == 0) atomicAdd((unsigned long long*)(args.ws + 2 * MiB - 512), barwait);
    xcd_barrier(bar);
#endif
#if PH_FN
    if (IN(N_PHASES - 1)) final_norm_phase(F, XB, args.out, ssb + (size_t)NSB * S, args.in[17]);
#endif
#ifdef DBG_BARWAIT
    xcd_barrier(bar);
    if (blockIdx.x == 0 && threadIdx.x == 0) { const unsigned long long tot = *(const unsigned long long*)(args.ws + 2 * MiB - 512); const float avg_us = (float)tot * (0.01f / 256.0f); args.out[0] = 1000.0f * __builtin_floorf(avg_us * (1.0f / DBG_BUCKET_US) + DBG_BUCKET_OFF); }
#endif
#undef IN
#undef SEAM
}

extern "C" void kernel_launch(void* const* d_in, const int* in_sizes, int n_in, void* d_out, int out_size, void* d_ws, size_t ws_size, hipStream_t stream) {
    static int grid = 0;
    if (grid == 0) {
        if (n_in != 18 || in_sizes[0] != S * DM || out_size != S * DM || ws_size < WS_END) { fprintf(stderr, "kernel_launch: shape mismatch: n_in %d in0 %d out %d ws %zu (need %zu)\n", n_in, n_in > 0 ? in_sizes[0] : -1, out_size, ws_size, (size_t)WS_END); grid = -1; return; }
        int dev = 0, cus = 0, per_cu = 0;
        if (hipGetDevice(&dev) != hipSuccess || hipDeviceGetAttribute(&cus, hipDeviceAttributeMultiprocessorCount, dev) != hipSuccess) { fprintf(stderr, "kernel_launch: device query failed\n"); grid = -1; return; }
        if (hipFuncSetAttribute((const void*)mega_fwd, hipFuncAttributeMaxDynamicSharedMemorySize, LDS_BYTES) != hipSuccess) { fprintf(stderr, "kernel_launch: hipFuncSetAttribute failed\n"); grid = -1; return; }
        if (hipOccupancyMaxActiveBlocksPerMultiprocessor(&per_cu, (const void*)mega_fwd, NWAVES * 64, LDS_BYTES) != hipSuccess || per_cu < 1) { fprintf(stderr, "kernel_launch: occupancy query says %d blocks per CU\n", per_cu); }
        (void)hipGetLastError();
        grid = cus;
    }
    if (grid < 0) return;
    if (hipMemsetAsync((char*)d_ws + WS_CTL, 0, CTL_ZERO_BYTES, stream) != hipSuccess) { fprintf(stderr, "kernel_launch: memset failed\n"); return; }
    Args a{};
    for (int i = 0; i < 18; ++i) a.in[i] = (const float*)d_in[i];
    a.out = (float*)d_out; a.ws = (unsigned char*)d_ws;
#if MK_MULTI
    for (int ph = 0; ph < N_PHASES; ++ph) {
        if (ph >= 1 && ph < N_PHASES - 1) { const int sb = (ph - 1) / 4, k = (ph - 1) % 4, k6 = sb % 6; if ((k == 1 || k == 2) && !(k6 == 1 || k6 == 4)) continue; if (k == 1 && k6 == 1) continue; }
        a.ph_lo = ph; a.ph_hi = ph + 1;
        hipLaunchKernelGGL(mega_fwd, dim3(grid), dim3(NWAVES * 64), LDS_BYTES, stream, a);
    }
#else
    a.ph_lo = 0; a.ph_hi = N_PHASES;
    hipLaunchKernelGGL(mega_fwd, dim3(grid), dim3(NWAVES * 64), LDS_BYTES, stream, a);
#endif
    const hipError_t le = hipPeekAtLastError();
    if (le != hipSuccess) fprintf(stderr, "kernel_launch: launch failed: %s\n", hipGetErrorName(le));
}
```

```cpp
#include <hip/hip_runtime.h>
#include <hip/hip_bf16.h>
#include <cstdio>
#include <cstdint>
#define MK_MULTI 0
namespace pg8 {
#define PG8_LAS __attribute__((address_space(3)))
typedef unsigned short bf16_t;
typedef short bf16x8 __attribute__((ext_vector_type(8)));
typedef float f32x4 __attribute__((ext_vector_type(4)));
typedef unsigned u32x4 __attribute__((ext_vector_type(4)));
constexpr int BM = 256, BK = 64, HALF = 128, HTB = HALF * BK * 2  , STAGE_BYTES = 8 * HTB, NXCD = 8, WGM = 8;

__host__ __device__ __forceinline__ int lds_byte(int r, int c) { const int st = (r >> 4) * 2 + (c >> 5), rr = r & 15, cc = c & 31, ob = rr * 64 + cc * 2; return st * 1024 + (ob ^ (((ob >> 9) & 1) << 5)); }
__host__ __device__ __forceinline__ void stage_rc(int b, int& R, int& C) { const int st = b / 1024, sb = b % 1024, swz = sb ^ (((sb >> 9) & 1) << 5); R = (st >> 1) * 16 + swz / 64; C = (st & 1) * 32 + (swz % 64) / 2; }
__host__ __device__ __forceinline__ int perm32(int rho) { const int n = rho >> 4, i = rho & 15; return 8 * (i >> 2) + 4 * n + (i & 3); }

struct Unit { int pm, pn; };
struct Gemm { const bf16_t* A; const bf16_t* Bt; int M, N, K; };

struct StaticOrder {
    int nM, nN, nwg, G, c, wgm;
    __host__ __device__ void init(int M, int N, int G_, int c_, int wgm_ = WGM) { nM = M / BM; nN = N / BM; nwg = nM * nN; G = G_; c = c_; wgm = wgm_; }
    __host__ __device__ bool next(int i, Unit& u) const { return unit_of((long)i * G + c, u); }
    __host__ __device__ bool unit_of(long L, Unit& u) const {
        if (L >= nwg) return false;
        int wgid = (int)L; { const int q = nwg / NXCD, r = nwg % NXCD, xcd = wgid % NXCD, off = wgid / NXCD; wgid = (xcd < r ? xcd * (q + 1) : r * (q + 1) + (xcd - r) * q) + off; }
        const int nig = wgm * nN, gid = wgid / nig, fm = gid * wgm, gsz = (nM - fm) < wgm ? (nM - fm) : wgm;
        u.pm = fm + ((wgid % nig) % gsz); u.pn = (wgid % nig) / gsz; return true;
    }
    __device__ __forceinline__ void a_ready(const Unit&) const {}
    __device__ __forceinline__ void done(const Unit&) const {}
};
__device__ __forceinline__ unsigned cvt_pk_bf16(float lo, float hi) { unsigned r; asm volatile("v_cvt_pk_bf16_f32 %0, %1, %2" : "=v"(r) : "v"(lo), "v"(hi)); return r; }
constexpr int DM = 2048, DFF = 5632;
constexpr float RMS_EPS = 1e-6f;
typedef unsigned long long ss_t;
constexpr float SS_SCALE = 16777216.0f;
__device__ __forceinline__ float rs_from_ss(ss_t ss) { return __builtin_amdgcn_rsqf((float)ss * (1.0f / ((float)DM * SS_SCALE)) + RMS_EPS); }
__device__ __forceinline__ float silu_f(float x) { return x * __builtin_amdgcn_rcpf(1.0f + __builtin_amdgcn_exp2f(x * -1.4426950408889634f)); }
__device__ __forceinline__ u32x4 pack8(const f32x4 a, const f32x4 b) { u32x4 w; w.x = cvt_pk_bf16(a[0], a[1]); w.y = cvt_pk_bf16(a[2], a[3]); w.z = cvt_pk_bf16(b[0], b[1]); w.w = cvt_pk_bf16(b[2], b[3]); return w; }

#ifndef EPI_WT
#define EPI_WT 0
#endif
template <typename V> __device__ __forceinline__ void st16(void* p, const V v) {
#if EPI_WT
    asm volatile("global_store_dwordx4 %0, %1, off sc1\n\ts_nop 1" :: "v"(p), "v"(v) : "memory");
#else
    *(V*)p = v;
#endif
}
struct SsOrder : StaticOrder {
    const ss_t* ss; PG8_LAS unsigned char* raw; mutable int k;
    __device__ __forceinline__ void a_ready(const Unit& u) const {
        int t_ = threadIdx.x; asm volatile("" : "+v"(t_));
        const int wid = __builtin_amdgcn_readfirstlane(t_ >> 6), lane = t_ & 63;
        __builtin_amdgcn_global_load_lds((const unsigned*)(ss + u.pm * BM + wid * 32) + lane, (PG8_LAS unsigned*)(raw + (k & 1) * 2048 + wid * 256), 4, 0, 0);
        ++k;
    }
    __device__ __forceinline__ void done(const Unit&) const {}
};
struct DynSsOrder : SsOrder {
    unsigned* ctr; PG8_LAS int* mbox; int x, nper, base; bool dyn; mutable unsigned pend;
    __device__ __forceinline__ void init_dyn(unsigned* ctr_all, PG8_LAS int* mbox_) {
        dyn = (G % NXCD == 0) && (nwg % NXCD == 0); x = c % NXCD; nper = nwg / NXCD; base = 2 * (G / NXCD); ctr = ctr_all + 64 * x; mbox = mbox_; pend = 0u;
    }
    __device__ __forceinline__ bool next(int i, Unit& u) const {
        bool ok;
        if (!dyn || i < 2) ok = unit_of((long)i * G + c, u);
        else { const int m = base + __builtin_amdgcn_readfirstlane(mbox[i & 1]); ok = (m < nper) && unit_of((long)m * NXCD + x, u); }
        if (dyn && i >= 1 && threadIdx.x == 0) pend = __hip_atomic_fetch_add(ctr, 1u, __ATOMIC_RELAXED, __HIP_MEMORY_SCOPE_AGENT);
        return ok;
    }
    __device__ __forceinline__ void a_ready(const Unit& u) const {
        if (dyn && k >= 1 && threadIdx.x == 0) mbox[(k + 1) & 1] = (int)pend;
        SsOrder::a_ready(u);
    }
};
struct EpiSwiglu {
    static constexpr bool PERM = true, AFTER_DRAIN = false;
    bf16_t* H; PG8_LAS const unsigned char* raw;
    __device__ __forceinline__ void operator()(const f32x4 (&acc)[2][2][4][2], const Unit& u, int wr, int wc, int fr_in, int fq_in, int slot) const {
        int fr = fr_in, fq = fq_in; asm volatile("" : "+v"(fr), "+v"(fq));
        const int row0 = u.pm * BM + wr * 64 + fr, col0 = u.pn * HALF + wc * 32 + 8 * fq;
#pragma unroll
        for (int ai = 0; ai < 2; ++ai)
#pragma unroll
            for (int m = 0; m < 4; ++m) { const int r = row0 + ai * HALF + m * 16; const float rs = rs_from_ss(*(PG8_LAS const ss_t*)(raw + slot * 2048 + (wr * 64 + fr + ai * HALF + m * 16) * 8));
                f32x4 h[2];
#pragma unroll
                for (int n = 0; n < 2; ++n) { const f32x4 g = acc[ai][0][m][n] * rs, v = acc[ai][1][m][n] * rs;
                    h[n] = (f32x4){silu_f(g[0]) * v[0], silu_f(g[1]) * v[1], silu_f(g[2]) * v[2], silu_f(g[3]) * v[3]}; }
                st16(H + (size_t)r * DFF + col0, pack8(h[0], h[1])); }
    }
};
struct EpiPlain {
    static constexpr bool PERM = true, AFTER_DRAIN = false;
    bf16_t* O; int ldc; PG8_LAS const unsigned char* raw;
    int rope_tiles, k_tile0; const float* qg; const float* kg; const float* rt; PG8_LAS float* hs;
    __device__ __forceinline__ void operator()(const f32x4 (&acc)[2][2][4][2], const Unit& u, int wr, int wc, int fr_in, int fq_in, int slot) const {
        int fr = fr_in, fq = fq_in; asm volatile("" : "+v"(fr), "+v"(fq));
        const int row0 = u.pm * BM + wr * 64 + fr, col0 = u.pn * BM + wc * 32 + 8 * fq;
        if (u.pn >= rope_tiles) {
#pragma unroll
            for (int ai = 0; ai < 2; ++ai)
#pragma unroll
                for (int m = 0; m < 4; ++m) { const int r = row0 + ai * HALF + m * 16; const float rs = rs_from_ss(*(PG8_LAS const ss_t*)(raw + slot * 2048 + (wr * 64 + fr + ai * HALF + m * 16) * 8)); bf16_t* rowp = O + (size_t)r * ldc + col0;
#pragma unroll
                    for (int bj = 0; bj < 2; ++bj) *(u32x4*)(rowp + bj * HALF) = pack8(acc[ai][bj][m][0] * rs, acc[ai][bj][m][1] * rs); }
            return;
        }
#pragma unroll
        for (int ai = 0; ai < 2; ++ai)
#pragma unroll
            for (int m = 0; m < 4; ++m) { const int rl = wr * 64 + fr + ai * HALF + m * 16; const float rs = rs_from_ss(*(PG8_LAS const ss_t*)(raw + slot * 2048 + rl * 8));
#pragma unroll
                for (int bj = 0; bj < 2; ++bj) { const f32x4 a = acc[ai][bj][m][0] * rs, b = acc[ai][bj][m][1] * rs;
                    float q = (a[0] * a[0] + a[1] * a[1]) + (a[2] * a[2] + a[3] * a[3]) + (b[0] * b[0] + b[1] * b[1]) + (b[2] * b[2] + b[3] * b[3]);
                    q += __shfl_xor(q, 16); q += __shfl_xor(q, 32);
                    if (fq == 0) hs[(rl * 2 + bj) * 4 + wc] = q; } }
        asm volatile("s_waitcnt lgkmcnt(0)" ::: "memory"); __builtin_amdgcn_s_barrier(); asm volatile("" ::: "memory");
        int l7 = (4 * wc + fq) & 7; asm volatile("" : "+v"(l7));
        const int hh = wc >> 1;
        const float* g = (u.pn >= k_tile0) ? kg : qg;
        const f32x4 ga = *(const f32x4*)(g + 64 * hh + 4 * l7), gb = *(const f32x4*)(g + 64 * hh + 32 + 4 * l7);
        const float* ctab = rt + (hh ? 8192 : 0) + 4 * l7; const int sinoff = hh ? 2048 : 4096;
#pragma unroll
        for (int ai = 0; ai < 2; ++ai)
#pragma unroll
            for (int m = 0; m < 4; ++m) { const int rl = wr * 64 + fr + ai * HALF + m * 16, r = u.pm * BM + rl; const float rs = rs_from_ss(*(PG8_LAS const ss_t*)(raw + slot * 2048 + rl * 8));
                const int pos = hh ? (r & 63) : (r >> 6);
                const f32x4 cs = *(const f32x4*)(ctab + pos * 32), sn = *(const f32x4*)(ctab + sinoff + pos * 32);
                bf16_t* rowp = O + (size_t)r * ldc + col0;
#pragma unroll
                for (int bj = 0; bj < 2; ++bj) { const f32x4 p4 = *(PG8_LAS const f32x4*)(hs + (rl * 2 + bj) * 4);
                    const float rh = __builtin_amdgcn_rsqf(((p4[0] + p4[1]) + (p4[2] + p4[3])) * (1.0f / 128.0f) + RMS_EPS) * rs;
                    const f32x4 x1 = acc[ai][bj][m][0] * rh * ga, x2 = acc[ai][bj][m][1] * rh * gb;
                    *(u32x4*)(rowp + bj * HALF) = pack8(x1 * cs - x2 * sn, x2 * cs + x1 * sn); }
                if (m & 1) asm volatile("" ::: "memory"); }
    }
};
__device__ __forceinline__ float bfl(unsigned w) { return __builtin_bit_cast(float, w << 16); }
__device__ __forceinline__ float bfh(unsigned w) { return __builtin_bit_cast(float, w & 0xffff0000u); }
struct EpiResid {
    static constexpr bool PERM = true, AFTER_DRAIN = false;
    bf16_t* xb; ss_t* ssn; float alpha;
    __device__ __forceinline__ void operator()(const f32x4 (&acc)[2][2][4][2], const Unit& u, int wr, int wc, int fr_in, int fq_in, int) const {
        int fr = fr_in, fq = fq_in; asm volatile("" : "+v"(fr), "+v"(fq));
        const int row0 = u.pm * BM + wr * 64 + fr, col0 = u.pn * BM + wc * 32 + 8 * fq;
        u32x4 bv[2][4][2];
#pragma unroll
        for (int ai = 0; ai < 2; ++ai)
#pragma unroll
            for (int m = 0; m < 4; ++m) { const size_t off = (size_t)(row0 + ai * HALF + m * 16) * DM + col0;
#pragma unroll
                for (int bj = 0; bj < 2; ++bj) bv[ai][m][bj] = *(const u32x4*)(xb + off + bj * HALF); }
#pragma unroll
        for (int ai = 0; ai < 2; ++ai)
#pragma unroll
            for (int m = 0; m < 4; ++m) { const int r = row0 + ai * HALF + m * 16; const size_t off = (size_t)r * DM + col0; float q = 0.f;
#pragma unroll
                for (int bj = 0; bj < 2; ++bj) { const u32x4 b = bv[ai][m][bj];
                    const f32x4 x0 = (f32x4){bfl(b.x), bfh(b.x), bfl(b.y), bfh(b.y)} + acc[ai][bj][m][0] * alpha, x1 = (f32x4){bfl(b.z), bfh(b.z), bfl(b.w), bfh(b.w)} + acc[ai][bj][m][1] * alpha;
                    const u32x4 w = pack8(x0, x1);
                    *(u32x4*)(xb + off + bj * HALF) = w;
                    const float r0 = bfl(w.x), r1 = bfh(w.x), r2 = bfl(w.y), r3 = bfh(w.y), r4 = bfl(w.z), r5 = bfh(w.z), r6 = bfl(w.w), r7 = bfh(w.w);
                    q += (r0 * r0 + r1 * r1) + (r2 * r2 + r3 * r3) + (r4 * r4 + r5 * r5) + (r6 * r6 + r7 * r7); }
                q += __shfl_xor(q, 16); q += __shfl_xor(q, 32);
                if (fq == 0) __hip_atomic_fetch_add(ssn + r, (ss_t)(q * SS_SCALE), __ATOMIC_RELAXED, __HIP_MEMORY_SCOPE_AGENT); }
    }
};

template <class Epi, class Sched, bool ALIGN_EPI = false, bool SP2 = false>
__device__ __forceinline__ void gemm_phase(PG8_LAS unsigned char* lds, const Gemm g, const Sched& S, const Epi& E) {
    int tid_ = threadIdx.x; asm volatile("" : "+v"(tid_));
    const int tid = tid_, wid = __builtin_amdgcn_readfirstlane(tid >> 6), lane = tid & 63, wr = wid >> 2, wc = wid & 3, fr = lane & 15, fq = lane >> 4;
    const int K = g.K, nt = K / BK;
    unsigned voffA[2], voffB[2];
#pragma unroll
    for (int i = 0; i < 2; ++i) { int R, C; stage_rc(tid * 16 + i * 8192, R, C); const int Rb = Epi::PERM ? ((R & ~31) + perm32(R & 31)) : R;
        voffA[i] = (unsigned)(R * K + C) * 2u; voffB[i] = (unsigned)(Rb * K + C) * 2u; }
    const size_t kstep = (size_t)(BK * 2);
    const size_t hstep = (size_t)HALF * K * 2;
    const size_t tstep = 2 * hstep;
    const unsigned ldsw = (unsigned)wid * 1024u;
    const int aoff = lds_byte(wr * 64 + fr, fq * 8), boff = lds_byte(wc * 32 + fr, fq * 8);
#define PG8_SA(b, h) (((b) * 2 + (h)) * HTB)
#define PG8_SB(b, h) ((4 + (b) * 2 + (h)) * HTB)
#define PG8_STAGE(bufoff, gbase, voff) do { _Pragma("unroll") for (int _i = 0; _i < 2; ++_i) \
        __builtin_amdgcn_global_load_lds((const unsigned*)((const char*)(gbase) + (voff)[_i]), (PG8_LAS unsigned*)(lds + (bufoff) + ldsw + _i * 8192), 16, 0, 0); } while (0)
#define PG8_LDA(dst, b, h) do { _Pragma("unroll") for (int m = 0; m < 4; ++m) _Pragma("unroll") for (int k = 0; k < 2; ++k) dst[m][k] = *(const PG8_LAS bf16x8*)(lds + PG8_SA(b, h) + aoff + m * 2048 + k * 1024); } while (0)
#define PG8_LDB(dst, b, h) do { _Pragma("unroll") for (int n = 0; n < 2; ++n) _Pragma("unroll") for (int k = 0; k < 2; ++k) dst[n][k] = *(const PG8_LAS bf16x8*)(lds + PG8_SB(b, h) + boff + n * 2048 + k * 1024); } while (0)
#define PG8_MMA(ai, bj, At, Bt) do { __builtin_amdgcn_s_setprio(1); _Pragma("unroll") for (int m = 0; m < 4; ++m) _Pragma("unroll") for (int n = 0; n < 2; ++n) _Pragma("unroll") for (int k = 0; k < 2; ++k) \
        acc[ai][bj][m][n] = __builtin_amdgcn_mfma_f32_16x16x32_bf16(Bt[n][k], At[m][k], acc[ai][bj][m][n], 0, 0, 0); __builtin_amdgcn_s_setprio(0); } while (0)
#define PG8_WAIT_V(n) asm volatile("s_waitcnt vmcnt(" #n ")" ::: "memory")
#define PG8_WAIT_L(n) asm volatile("s_waitcnt lgkmcnt(" #n ")" ::: "memory")
#define PG8_BAR __builtin_amdgcn_s_barrier()
#define PG8_SCHED __builtin_amdgcn_sched_barrier(0)
    Unit cur, nxt; int ui = 0;
    if (!S.next(0, cur)) return;
    f32x4 acc[2][2][4][2];
#pragma unroll
    for (int a = 0; a < 2; ++a)
#pragma unroll
        for (int b = 0; b < 2; ++b)
#pragma unroll
            for (int m = 0; m < 4; ++m)
#pragma unroll
                for (int n = 0; n < 2; ++n) acc[a][b][m][n] = (f32x4){0.f, 0.f, 0.f, 0.f};
    bf16x8 At[4][2], B0[2][2], B1[2][2];
    const char* cA = (const char*)g.A + (size_t)cur.pm * tstep; const char* cB = (const char*)g.Bt + (size_t)cur.pn * tstep;
    S.a_ready(cur);
    if constexpr (SP2) {
        PG8_STAGE(PG8_SB(0, 0), cB, voffB); PG8_STAGE(PG8_SB(0, 1), cB + hstep, voffB); PG8_STAGE(PG8_SA(0, 0), cA, voffA); PG8_STAGE(PG8_SA(0, 1), cA + hstep, voffA);
        if (wr == 1) PG8_BAR;
        PG8_WAIT_V(2); PG8_BAR;
        PG8_STAGE(PG8_SB(1, 0), cB + kstep, voffB); PG8_STAGE(PG8_SA(1, 0), cA + kstep, voffA); PG8_STAGE(PG8_SB(1, 1), cB + hstep + kstep, voffB);
        PG8_WAIT_V(6); PG8_BAR;
    } else {
        PG8_STAGE(PG8_SB(0, 0), cB, voffB); PG8_STAGE(PG8_SA(0, 0), cA, voffA); PG8_STAGE(PG8_SB(0, 1), cB + hstep, voffB); PG8_STAGE(PG8_SA(0, 1), cA + hstep, voffA);
        if (wr == 1) PG8_BAR;
        PG8_WAIT_V(4); PG8_BAR;
        PG8_STAGE(PG8_SB(1, 0), cB + kstep, voffB); PG8_STAGE(PG8_SA(1, 0), cA + kstep, voffA); PG8_STAGE(PG8_SB(1, 1), cB + hstep + kstep, voffB);
        PG8_WAIT_V(6); PG8_BAR;
    }
    for (;;) {
        const bool has_next = S.next(ui + 1, nxt);
        const char* nA = has_next ? (const char*)g.A + (size_t)nxt.pm * tstep : cA; const char* nB = has_next ? (const char*)g.Bt + (size_t)nxt.pn * tstep : cB;
        for (int t = 0; t < nt; t += 2) {
            const bool last = (t == nt - 2);
            const char* a1 = cA + (size_t)(t + 1) * kstep;
            const char* a2 = last ? nA : cA + (size_t)(t + 2) * kstep; const char* b2 = last ? nB : cB + (size_t)(t + 2) * kstep;
            const char* a3 = a2 + kstep; const char* b3 = b2 + kstep;
            if (last && has_next) S.a_ready(nxt);
            if constexpr (SP2) {
            PG8_LDB(B0, 0, 0); PG8_LDB(B1, 0, 1); PG8_SCHED; PG8_LDA(At, 0, 0); PG8_STAGE(PG8_SA(1, 1), a1 + hstep, voffA);
            PG8_WAIT_V(8); PG8_WAIT_L(0); PG8_BAR; PG8_MMA(0, 0, At, B0); PG8_MMA(0, 1, At, B1); PG8_BAR; PG8_SCHED;
            PG8_LDA(At, 0, 1); PG8_STAGE(PG8_SB(0, 0), b2, voffB); PG8_STAGE(PG8_SB(0, 1), b2 + hstep, voffB); PG8_STAGE(PG8_SA(0, 0), a2, voffA);
            PG8_WAIT_V(8); PG8_WAIT_L(0); PG8_BAR; PG8_MMA(1, 0, At, B0); PG8_MMA(1, 1, At, B1); PG8_BAR; PG8_SCHED;
            PG8_LDB(B0, 1, 0); PG8_LDB(B1, 1, 1); PG8_SCHED; PG8_LDA(At, 1, 0); PG8_STAGE(PG8_SA(0, 1), a2 + hstep, voffA);
            PG8_WAIT_V(8); PG8_WAIT_L(0); PG8_BAR; PG8_MMA(0, 0, At, B0); PG8_MMA(0, 1, At, B1); PG8_BAR; PG8_SCHED;
            PG8_LDA(At, 1, 1); PG8_STAGE(PG8_SB(1, 0), b3, voffB); PG8_STAGE(PG8_SB(1, 1), b3 + hstep, voffB); PG8_STAGE(PG8_SA(1, 0), a3, voffA);
            PG8_WAIT_V(8); PG8_WAIT_L(0); PG8_BAR; PG8_MMA(1, 0, At, B0); PG8_MMA(1, 1, At, B1); PG8_BAR; PG8_SCHED;
            } else {
            PG8_LDB(B0, 0, 0); PG8_SCHED; PG8_LDA(At, 0, 0); PG8_STAGE(PG8_SA(1, 1), a1 + hstep, voffA);
            PG8_WAIT_L(8); PG8_BAR; PG8_WAIT_L(0); PG8_MMA(0, 0, At, B0); PG8_BAR; PG8_SCHED;
            PG8_LDB(B1, 0, 1); PG8_STAGE(PG8_SB(0, 0), b2, voffB);
            PG8_BAR; PG8_WAIT_L(0); PG8_MMA(0, 1, At, B1); PG8_BAR;
            PG8_LDA(At, 0, 1); PG8_STAGE(PG8_SA(0, 0), a2, voffA);
            PG8_BAR; PG8_WAIT_L(0); PG8_MMA(1, 0, At, B0); PG8_BAR; PG8_SCHED;
            PG8_STAGE(PG8_SB(0, 1), b2 + hstep, voffB);
            PG8_WAIT_V(6); PG8_BAR; PG8_MMA(1, 1, At, B1); PG8_BAR;
            PG8_LDB(B0, 1, 0); PG8_SCHED; PG8_LDA(At, 1, 0); PG8_STAGE(PG8_SA(0, 1), a2 + hstep, voffA);
            PG8_WAIT_L(8); PG8_BAR; PG8_WAIT_L(0); PG8_MMA(0, 0, At, B0); PG8_BAR; PG8_SCHED;
            PG8_LDB(B1, 1, 1); PG8_STAGE(PG8_SB(1, 0), b3, voffB);
            PG8_BAR; PG8_WAIT_L(0); PG8_MMA(0, 1, At, B1); PG8_BAR;
            PG8_LDA(At, 1, 1); PG8_STAGE(PG8_SA(1, 0), a3, voffA);
            PG8_BAR; PG8_WAIT_L(0); PG8_MMA(1, 0, At, B0); PG8_BAR; PG8_SCHED;
            PG8_STAGE(PG8_SB(1, 1), b3 + hstep, voffB);
            PG8_WAIT_V(6); PG8_BAR; PG8_MMA(1, 1, At, B1); PG8_BAR;
            }
        }
        if constexpr (ALIGN_EPI) { if (wr == 0) PG8_BAR; }
        if constexpr (!Epi::AFTER_DRAIN) { E(acc, cur, wr, wc, fr, fq, ui & 1); S.done(cur); }
        if (!has_next) break;
#pragma unroll
        for (int a = 0; a < 2; ++a)
#pragma unroll
            for (int b = 0; b < 2; ++b)
#pragma unroll
                for (int m = 0; m < 4; ++m)
#pragma unroll
                    for (int n = 0; n < 2; ++n) acc[a][b][m][n] = (f32x4){0.f, 0.f, 0.f, 0.f};
        cur = nxt; cA = nA; cB = nB; ++ui;
        if constexpr (ALIGN_EPI) { if (wr == 1) PG8_BAR; }
    }
    PG8_WAIT_V(0);
    if constexpr (!ALIGN_EPI) { if (wr == 0) PG8_BAR; }
    PG8_BAR;
    if constexpr (Epi::AFTER_DRAIN) { E.fused(acc, cur, wr, wc, fr, fq, lds, wid, lane); S.done(cur); }
#undef PG8_SA
#undef PG8_SB
#undef PG8_STAGE
#undef PG8_LDA
#undef PG8_LDB
#undef PG8_MMA
#undef PG8_WAIT_V
#undef PG8_WAIT_L
#undef PG8_BAR
#undef PG8_SCHED
}
}
namespace att {
using bf16 = __hip_bfloat16;
constexpr int   D = 128, NW = 8, QBLK = 32, KVBLK = 64;
constexpr float SCALE = 0.088388347648318440f;
constexpr float THR = 8.f;
constexpr int   SDEPTH = 2;
constexpr int   LDQ = 3072, LDK = 3072, LDO = 2048;
constexpr size_t SHM_V = KVBLK * D * 2, SHM_K = KVBLK * D * 2, SHM_ATTN = 2 * SHM_V + 2 * SHM_K + NW * 64 * 4;
using bf16x8 = __attribute__((ext_vector_type(8))) short;
using s16x4  = __attribute__((ext_vector_type(4))) short;
using f32x16 = __attribute__((ext_vector_type(16))) float;
using u32x4  = __attribute__((ext_vector_type(4))) unsigned;
#define KSWZ(row, colB) ((row) * 256 + ((colB) ^ (((row) & 7) << 4)))
#define SBAR() __builtin_amdgcn_sched_barrier(0)
__device__ __forceinline__ int crow(int r, int hi) { return (r & 3) + 8 * (r >> 2) + 4 * hi; }
__device__ __forceinline__ unsigned cvtpk(float lo, float hi) {
  unsigned r; asm volatile("v_cvt_pk_bf16_f32 %0, %1, %2" : "=v"(r) : "v"(lo), "v"(hi)); return r;
}

__device__ __forceinline__ void partialSM(f32x16& p0, f32x16& p1, float& m_reg, float& mn, float& alpha) {
  constexpr float C = SCALE * 1.4426950408889634f;
  float pmax = p0[0]; for (int r = 1; r < 16; ++r) pmax = fmaxf(pmax, p0[r]); for (int r = 0; r < 16; ++r) pmax = fmaxf(pmax, p1[r]);
  { auto rr = __builtin_amdgcn_permlane32_swap(__float_as_uint(pmax), __float_as_uint(pmax), false, false);
    pmax = fmaxf(__uint_as_float(rr[0]), __uint_as_float(rr[1])); }
  if (__builtin_expect(__all(pmax - m_reg <= THR / SCALE), 1)) { mn = m_reg; alpha = 1.f; }
  else { mn = fmaxf(m_reg, pmax); alpha = __builtin_amdgcn_exp2f((m_reg - mn) * C); m_reg = mn; }
  float mnC = -mn * C;
  for (int r = 0; r < 16; ++r) p0[r] = fmaf(p0[r], C, mnC); for (int r = 0; r < 16; ++r) p1[r] = fmaf(p1[r], C, mnC);
  for (int r = 0; r < 16; ++r) p0[r] = __builtin_amdgcn_exp2f(p0[r]);
}
__device__ __forceinline__ void finishSM(f32x16& p0, f32x16& p1, float alpha, float& l_reg, bf16x8& pa0, bf16x8& pa1, bf16x8& pa2, bf16x8& pa3) {
  for (int r = 0; r < 16; ++r) p1[r] = __builtin_amdgcn_exp2f(p1[r]);
  float ps = 0; for (int r = 0; r < 16; ++r) ps += p0[r]; for (int r = 0; r < 16; ++r) ps += p1[r];
  { auto rr = __builtin_amdgcn_permlane32_swap(__float_as_uint(ps), __float_as_uint(ps), false, false);
    ps = __uint_as_float(rr[0]) + __uint_as_float(rr[1]); }
  l_reg = l_reg * alpha + ps;
#define PK4(P, BASE, OUT) do { unsigned a0 = cvtpk(P[BASE + 0], P[BASE + 1]), a1 = cvtpk(P[BASE + 2], P[BASE + 3]);   \
    unsigned b0 = cvtpk(P[BASE + 4], P[BASE + 5]), b1 = cvtpk(P[BASE + 6], P[BASE + 7]);                              \
    auto r0 = __builtin_amdgcn_permlane32_swap(a0, b0, false, false); auto r1 = __builtin_amdgcn_permlane32_swap(a1, b1, false, false); \
    u32x4 w = {r0[0], r1[0], r0[1], r1[1]}; OUT = *reinterpret_cast<bf16x8*>(&w); } while (0)
  PK4(p0, 0, pa0); PK4(p0, 8, pa1); PK4(p1, 0, pa2); PK4(p1, 8, pa3);
#undef PK4
}
__device__ __forceinline__ void qkt(f32x16& p0, f32x16& p1, const bf16* Ks, const bf16x8* qr, int r32, int hi) {
  p0 = f32x16{}; p1 = f32x16{};
  for (int d0 = 0; d0 < 8; ++d0) { int cb = (d0 * 16 + hi * 8) * 2;
    bf16x8 b0 = *reinterpret_cast<const bf16x8*>((const char*)Ks + KSWZ(r32, cb));
    bf16x8 b1 = *reinterpret_cast<const bf16x8*>((const char*)Ks + KSWZ(32 + r32, cb));
    p0 = __builtin_amdgcn_mfma_f32_32x32x16_bf16(b0, qr[d0], p0, 0, 0, 0);
    p1 = __builtin_amdgcn_mfma_f32_32x32x16_bf16(b1, qr[d0], p1, 0, 0, 0); }
}
__device__ __forceinline__ int v_st(int k, int c) { const int kk = (k & ~0xC) | ((k & 4) << 1) | ((k & 8) >> 1); return ((kk >> 3) * 4 + (c >> 5)) * 512 + ((kk & 7) * 32 + (c & 31)) * 2; }
__device__ __forceinline__ int v_rd_base(int lane) { return ((lane & 3) << 3) | (((lane >> 2) & 3) << 6) | (((lane >> 4) & 1) << 5) | (((lane >> 5) & 1) << 8); }
constexpr int v_rd_off(int d0, int ks, int half) { return d0 * 512 + ks * 4096 + half * 2048; }
template <int OFF> __device__ __forceinline__ s16x4 tr_read(int vb) {
  s16x4 r; asm volatile("ds_read_b64_tr_b16 %0, %1 offset:%2" : "=&v"(r) : "v"(vb), "i"(OFF) : "memory"); return r;
}
template <int D0> __device__ __forceinline__ void pv_one(f32x16& od, int vb, bf16x8 pa0, bf16x8 pa1, bf16x8 pa2, bf16x8 pa3) {
  const s16x4 l0 = tr_read<v_rd_off(D0, 0, 0)>(vb), h0 = tr_read<v_rd_off(D0, 0, 1)>(vb), l1 = tr_read<v_rd_off(D0, 1, 0)>(vb), h1 = tr_read<v_rd_off(D0, 1, 1)>(vb);
  const s16x4 l2 = tr_read<v_rd_off(D0, 2, 0)>(vb), h2 = tr_read<v_rd_off(D0, 2, 1)>(vb), l3 = tr_read<v_rd_off(D0, 3, 0)>(vb), h3 = tr_read<v_rd_off(D0, 3, 1)>(vb);
  asm volatile("s_waitcnt lgkmcnt(0)" ::: "memory"); SBAR();
#define PK(L, H) (bf16x8){L[0], L[1], L[2], L[3], H[0], H[1], H[2], H[3]}
  od = __builtin_amdgcn_mfma_f32_32x32x16_bf16(pa0, PK(l0, h0), od, 0, 0, 0);
  od = __builtin_amdgcn_mfma_f32_32x32x16_bf16(pa1, PK(l1, h1), od, 0, 0, 0);
  od = __builtin_amdgcn_mfma_f32_32x32x16_bf16(pa2, PK(l2, h2), od, 0, 0, 0);
  od = __builtin_amdgcn_mfma_f32_32x32x16_bf16(pa3, PK(l3, h3), od, 0, 0, 0);
#undef PK
}
__device__ __forceinline__ void pv_d0(f32x16* o, int vb, bf16x8 pa0, bf16x8 pa1, bf16x8 pa2, bf16x8 pa3) {
  pv_one<0>(o[0], vb, pa0, pa1, pa2, pa3); pv_one<1>(o[1], vb, pa0, pa1, pa2, pa3); pv_one<2>(o[2], vb, pa0, pa1, pa2, pa3); pv_one<3>(o[3], vb, pa0, pa1, pa2, pa3);
}
__device__ __forceinline__ void attn_dense_body(const bf16* __restrict__ Qb, const bf16* __restrict__ Kh, const bf16* __restrict__ Vh, bf16* __restrict__ Ob, int seq, char* lds) {
  int tid_ = threadIdx.x; asm volatile("" : "+v"(tid_));
  const int tid = tid_, wid = tid >> 6, lane = tid & 63, r32 = lane & 31, hi = lane >> 5;
  bf16* V_lds = (bf16*)lds; bf16* K_lds = (bf16*)(lds + 2 * SHM_V);
  float* ws = (float*)(lds + 2 * SHM_V + 2 * SHM_K) + wid * 64; float* li_l = ws; float* al_l = ws + 32;
  float m_reg = -1e30f, l_reg = 0; f32x16 o[4] = {}; bf16x8 qr[8];
  const bf16* Qw = Qb + (long)(wid * QBLK + r32) * LDQ + hi * 8;
#pragma unroll
  for (int d0 = 0; d0 < 8; ++d0) qr[d0] = *reinterpret_cast<const bf16x8*>(Qw + d0 * 16);
  const int sr = tid >> 4, sc = (tid & 15) * 8, vst0 = v_st(sr, sc), vst1 = v_st(32 + sr, sc);
  const int vb0 = (int)(uintptr_t)V_lds + v_rd_base(lane);
  struct { bf16x8 vs0, vs1, ks0, ks1; } sr_[SDEPTH];
#define SLOAD(i, k0) do { sr_[i].vs0 = *reinterpret_cast<const bf16x8*>(&Vh[(long)((k0) + sr) * LDK + sc]); sr_[i].vs1 = *reinterpret_cast<const bf16x8*>(&Vh[(long)((k0) + 32 + sr) * LDK + sc]); \
    sr_[i].ks0 = *reinterpret_cast<const bf16x8*>(&Kh[(long)((k0) + sr) * LDK + sc]); sr_[i].ks1 = *reinterpret_cast<const bf16x8*>(&Kh[(long)((k0) + 32 + sr) * LDK + sc]); } while (0)
#define SWRITE(b, i) do { *(bf16x8*)((char*)V_lds + (b) * SHM_V + vst0) = sr_[i].vs0;          \
    *(bf16x8*)((char*)V_lds + (b) * SHM_V + vst1) = sr_[i].vs1; int kc = sc * 2;               \
    *(bf16x8*)((char*)K_lds + (b) * SHM_K + KSWZ(sr, kc)) = sr_[i].ks0;                       \
    *(bf16x8*)((char*)K_lds + (b) * SHM_K + KSWZ(32 + sr, kc)) = sr_[i].ks1; } while (0)
#define SWAIT() do { asm volatile("s_waitcnt vmcnt(4)" ::: "memory"); } while (0)
#define RESC(a) do { if (__any((a) < 1.f)) { if (hi == 0) al_l[r32] = (a); asm volatile("s_waitcnt lgkmcnt(0)" ::: "memory"); \
    for (int d = 0; d < 4; ++d) for (int r = 0; r < 16; ++r) o[d][r] *= al_l[crow(r, hi)]; } } while (0)
  f32x16 pA0, pA1, pB0, pB1; float mnA, mnB, alA, alB; bf16x8 pa0, pa1, pa2, pa3; const int NT = seq / KVBLK;
  constexpr int SE = 0, SO = SDEPTH - 1;
  SLOAD(SE, 0); asm volatile("s_waitcnt vmcnt(0)" ::: "memory"); SWRITE(0, SE); __syncthreads();
  qkt(pA0, pA1, K_lds, qr, r32, hi); partialSM(pA0, pA1, m_reg, mnA, alA);
  SLOAD(SO, KVBLK); if (2 < NT) SLOAD(SE, 2 * KVBLK);
  SWAIT(); SWRITE(1, SO); __syncthreads();
  for (int j = 1; j + 1 < NT; j += 2) {
    SBAR(); qkt(pB0, pB1, (bf16*)((char*)K_lds + SHM_K), qr, r32, hi);
    finishSM(pA0, pA1, alA, l_reg, pa0, pa1, pa2, pa3); SBAR();
    SLOAD(SO, (j + SDEPTH) * KVBLK); SBAR();
    pv_d0(o, vb0, pa0, pa1, pa2, pa3); partialSM(pB0, pB1, m_reg, mnB, alB);
    __syncthreads(); SWAIT(); SWRITE(0, SE);
    RESC(alB); __syncthreads();
    SBAR(); qkt(pA0, pA1, K_lds, qr, r32, hi);
    finishSM(pB0, pB1, alB, l_reg, pa0, pa1, pa2, pa3); SBAR();
    if (j + 3 < NT) SLOAD(SE, (j + 1 + SDEPTH) * KVBLK); SBAR();
    pv_d0(o, vb0 + (int)SHM_V, pa0, pa1, pa2, pa3); partialSM(pA0, pA1, m_reg, mnA, alA);
    __syncthreads(); SWAIT(); SWRITE(1, SO);
    RESC(alA); __syncthreads();
  }
  SBAR(); qkt(pB0, pB1, (bf16*)((char*)K_lds + SHM_K), qr, r32, hi);
  finishSM(pA0, pA1, alA, l_reg, pa0, pa1, pa2, pa3); SBAR();
  pv_d0(o, vb0, pa0, pa1, pa2, pa3); partialSM(pB0, pB1, m_reg, mnB, alB);
  __syncthreads(); RESC(alB);
  finishSM(pB0, pB1, alB, l_reg, pa0, pa1, pa2, pa3); SBAR();
  pv_d0(o, vb0 + (int)SHM_V, pa0, pa1, pa2, pa3);
  if (hi == 0) li_l[r32] = l_reg; asm volatile("s_waitcnt lgkmcnt(0)" ::: "memory");
  float rli[16];
#pragma unroll
  for (int r = 0; r < 16; ++r) rli[r] = __builtin_amdgcn_rcpf(li_l[crow(r, hi)]);
  asm volatile("s_waitcnt vmcnt(0) lgkmcnt(0)" ::: "memory");
  __syncthreads();
  char* ost = lds + wid * 8192;
#pragma unroll
  for (int r = 0; r < 16; r += 2) { const int row_a = crow(r, hi), row_b = crow(r + 1, hi);
#pragma unroll
    for (int d0 = 0; d0 < 4; ++d0) { const unsigned w = cvtpk(o[d0][r] * rli[r], o[d0][r + 1] * rli[r + 1]);
      *(unsigned short*)(ost + row_a * 256 + (d0 * 32 + r32) * 2) = (unsigned short)(w & 0xffffu);
      *(unsigned short*)(ost + row_b * 256 + (d0 * 32 + r32) * 2) = (unsigned short)(w >> 16); } }
  asm volatile("s_waitcnt lgkmcnt(0)" ::: "memory");
  bf16* Ow = Ob + (long)(wid * QBLK) * LDO;
#pragma unroll
  for (int i = 0; i < 8; ++i) { const int idx = lane + 64 * i, row = idx >> 4, c16 = idx & 15;
    const u32x4 v = *(const u32x4*)(ost + row * 256 + c16 * 16); *(u32x4*)(Ow + (long)row * LDO + c16 * 8) = v; }
  asm volatile("s_waitcnt lgkmcnt(0)" ::: "memory");
  __syncthreads();
#undef SLOAD
#undef SWRITE
#undef SWAIT
#undef RESC
}
#undef KSWZ
#undef SBAR
}

constexpr int NWAVES = 8;
#ifndef MK_MULTI
#define MK_MULTI 0
#endif

#ifndef PH_P0
#define PH_P0 1
#endif
#ifndef PH_GU
#define PH_GU 1
#endif
#ifndef PH_PLAIN
#define PH_PLAIN 1
#endif
#ifndef PH_ROPE
#define PH_ROPE 1
#endif
#ifndef PH_ATT
#define PH_ATT 1
#endif
#ifndef PH_REC1
#define PH_REC1 1
#endif
#ifndef PH_REC2
#define PH_REC2 1
#endif
#ifndef PH_RES
#define PH_RES 1
#endif
#ifndef PH_FN
#define PH_FN 1
#endif
#ifndef DUP_P0
#define DUP_P0 1
#endif
#ifndef DUP_GU
#define DUP_GU 1
#endif
#ifndef DUP_PLAIN
#define DUP_PLAIN 1
#endif
#ifndef DUP_ATT
#define DUP_ATT 1
#endif
#ifndef DUP_RES
#define DUP_RES 1
#endif
#ifndef DUP_BAR
#define DUP_BAR 1
#endif
#ifndef DUP_REC
#define DUP_REC 1
#endif
#ifndef GU_CVY
#define GU_CVY 2
#endif
#ifndef GU_CV_NUM
#define GU_CV_NUM 3
#define GU_CV_DEN 4
#endif
#ifndef RES_WGM
#define RES_WGM 8
#endif
constexpr int S = 8192, DM = 2048, DFF = 5632, NGU = 2 * DFF, QKVD = 3072, DRNN = 2048, NFFN = 8, NSB = 12;
constexpr int N_PHASES = 2 + 4 * NSB;
constexpr float NORM_EPS = 1e-6f;

constexpr size_t MiB = 1u << 20;
constexpr size_t WS_CTL = 0, CTL_ZERO_BYTES = 2 * MiB;
constexpr size_t WS_SS = 1 * MiB;
constexpr size_t WS_ROPE = 2 * MiB;
constexpr size_t WS_WG = 3 * MiB;
constexpr size_t WS_AGGS = 7 * MiB;
constexpr size_t WS_AGGC = 15 * MiB;
constexpr size_t WS_WGU = 16 * MiB, SZ_WGU = (size_t)NGU * DM * 2;
constexpr size_t WS_WD = WS_WGU + NFFN * SZ_WGU, SZ_WD = (size_t)DM * DFF * 2;
constexpr size_t WS_WQKV = WS_WD + NFFN * SZ_WD, SZ_WQKV = (size_t)QKVD * DM * 2;
constexpr size_t WS_WO = WS_WQKV + 2 * SZ_WQKV, SZ_WO = (size_t)DM * DM * 2;
constexpr size_t WS_WIN = WS_WO + 2 * SZ_WO, SZ_WIN = (size_t)2 * DRNN * DM * 2;
constexpr size_t WS_WOUT = WS_WIN + 2 * SZ_WIN, SZ_WOUT = (size_t)DM * DRNN * 2;
constexpr size_t WS_XB = WS_WOUT + 2 * SZ_WOUT;
constexpr size_t WS_H = WS_XB + (size_t)S * DM * 2;
constexpr size_t WS_QKV = WS_H + (size_t)S * DFF * 2;
constexpr size_t WS_O = WS_QKV + (size_t)S * QKVD * 2;
constexpr size_t WS_U = WS_O + (size_t)S * DM * 2;
constexpr size_t WS_Y = WS_U + (size_t)S * 2 * DRNN * 2;
constexpr size_t WS_AB = WS_Y + (size_t)S * DRNN * 2;
constexpr size_t WS_END = WS_AB + (size_t)S * DRNN * 2 * 4;
static_assert(WS_WG + 128 * 16384 * 2 <= WS_AGGS && WS_AGGS + 256 * 2 * 2048 * 8 <= WS_AGGC && WS_AGGC + 16 * 2 * 2048 * 8 <= WS_WGU, "small tables do not overlap");
static_assert(WS_SS + 14 * (size_t)S * 8 + 256 <= CTL_ZERO_BYTES, "ss arrays inside the memset region");
static_assert(WS_WGU % 256 == 0 && WS_XB % 256 == 0 && WS_H % 256 == 0 && WS_QKV % 256 == 0 && WS_O % 256 == 0 && WS_U % 256 == 0 && WS_Y % 256 == 0, "alignment");
constexpr int CW_GUQ = 16384;
constexpr int CW_BAR = 4096;

constexpr int RING_OFF = 0, RING_BYTES = 131072;
constexpr int LDSCTL_OFF = RING_BYTES, MISC_OFF = LDSCTL_OFF + 320;
constexpr int MBOX_OFF = LDSCTL_OFF + 512;
constexpr int RSTAB_OFF = LDSCTL_OFF + 1024;
constexpr int HSTAB_OFF = RSTAB_OFF + 4096;
constexpr int LDS_BYTES = 147456;
static_assert(MISC_OFF + 128 <= RSTAB_OFF && HSTAB_OFF + 8192 <= LDS_BYTES, "LDS map");

#define GAS __attribute__((address_space(1)))
#define LAS __attribute__((address_space(3)))
typedef unsigned short bf16;
typedef unsigned v4u __attribute__((ext_vector_type(4)));
typedef float f32x4 __attribute__((ext_vector_type(4)));
typedef short bf16x8 __attribute__((ext_vector_type(8)));
typedef GAS unsigned gu32;
#define RLX_AGENT __ATOMIC_RELAXED, __HIP_MEMORY_SCOPE_AGENT
#define LDS_WAIT() asm volatile("s_waitcnt lgkmcnt(0)" ::: "memory")
#define VM_WAIT() asm volatile("s_waitcnt vmcnt(0)" ::: "memory")
__device__ __forceinline__ unsigned f2bf(float f) { unsigned u = __builtin_bit_cast(unsigned, f); return (u + 0x7fffu + ((u >> 16) & 1u)) >> 16; }
__device__ __forceinline__ unsigned pk2(float lo, float hi) { return f2bf(lo) | (f2bf(hi) << 16); }
__device__ __forceinline__ float bf_lo(unsigned w) { return __builtin_bit_cast(float, w << 16); }
__device__ __forceinline__ float bf_hi(unsigned w) { return __builtin_bit_cast(float, w & 0xffff0000u); }

#define XB_TMO      128
#define XB_XCNT(j)  (256  + 64 * (j))
#define XB_XSUB(j)  (1280 + 64 * (j))
#define XB_XGEN(j)  (2304 + 64 * (j))
#define XB_TOP      3328
#define XB_TOPGEN   3392
#define XCD_BAR_WORDS 3456
#define XB_SPIN_CAP (1u << 18)
#ifndef XB_MID_WB
#define XB_MID_WB 0
#endif

__device__ __forceinline__ unsigned xb_ld(unsigned* p)              { return __hip_atomic_load(p, __ATOMIC_RELAXED, __HIP_MEMORY_SCOPE_AGENT); }
__device__ __forceinline__ unsigned xb_add(unsigned* p, unsigned v) { return __hip_atomic_fetch_add(p, v, __ATOMIC_RELAXED, __HIP_MEMORY_SCOPE_AGENT); }
__device__ __forceinline__ unsigned xb_xcc_id() { return (unsigned)__builtin_amdgcn_s_getreg((3 << 11) | 20) & 0xFu; }
#define XB_SPIN(cond, bar) do { unsigned _sp = 0; while (cond) { __builtin_amdgcn_s_sleep(1); \
    if ((++_sp & 255u) == 0u) { if (xb_ld(&(bar)[XB_TMO])) break; if (_sp > XB_SPIN_CAP) { atomicAdd(&(bar)[XB_TMO], 1u); break; } } } } while (0)

struct XcdBarrier {
    unsigned* bar; unsigned x;
    volatile LAS unsigned* st;
};

__device__ __forceinline__ XcdBarrier xcd_barrier_post(unsigned* bar, volatile LAS unsigned* st) {
    XcdBarrier b; b.bar = bar; b.x = xb_xcc_id(); b.st = st;
    if (threadIdx.x == 0) (void)xb_add(&bar[XB_XCNT(b.x)], 1u);
    return b;
}
__device__ __forceinline__ void xcd_barrier_complete(unsigned* bar, unsigned x, unsigned& nloc, unsigned& nx) {
    const unsigned G = gridDim.x * gridDim.y * gridDim.z;
    unsigned sum, cnt, mine, sp = 0u;
    for (;;) {
        sum = 0u; cnt = 0u; mine = 0u;
#pragma unroll
        for (unsigned j = 0; j < 16; ++j) { const unsigned c = xb_ld(&bar[XB_XCNT(j)]); sum += c; cnt += (c > 0u) ? 1u : 0u; mine = (j == x) ? c : mine; }
        if (sum == G) break;
        __builtin_amdgcn_s_sleep(1);
        if ((++sp & 255u) == 0u) { if (xb_ld(&bar[XB_TMO])) break; if (sp > XB_SPIN_CAP) { atomicAdd(&bar[XB_TMO], 1u); break; } }
    }
    nloc = mine > 0u ? mine : 1u; nx = cnt > 0u ? cnt : 1u;
}

__device__ __forceinline__ void xcd_barrier(const XcdBarrier& b) {
    asm volatile("s_waitcnt vmcnt(0)" ::: "memory");
    __syncthreads();
    if (threadIdx.x == 0) {
        unsigned* bar = b.bar;
        __builtin_amdgcn_s_waitcnt(0);
        unsigned nloc = b.st[0], nx = b.st[1];
        if (nloc == 0u) { xcd_barrier_complete(bar, b.x, nloc, nx); b.st[0] = nloc; b.st[1] = nx; }
        const unsigned old = xb_add(&bar[XB_XSUB(b.x)], 1u);
        const unsigned gen = old / nloc;
#if XB_MID_WB
        if (old - gen * nloc == nloc / 2u) asm volatile("buffer_wbl2 sc1" ::: "memory");
#endif
        if (old + 1u == (gen + 1u) * nloc) {
            __builtin_amdgcn_fence(__ATOMIC_RELEASE, "agent");
            asm volatile("s_waitcnt vmcnt(0)" ::: "memory");
            const unsigned og = xb_add(&bar[XB_TOP], 1u);
            const unsigned tg = og / nx;
            if (og + 1u == (tg + 1u) * nx) xb_add(&bar[XB_TOPGEN], 1u);
            else XB_SPIN(xb_ld(&bar[XB_TOPGEN]) == tg, bar);
            __builtin_amdgcn_fence(__ATOMIC_ACQUIRE, "agent");
            xb_add(&bar[XB_XGEN(b.x)], 1u);
            asm volatile("s_waitcnt vmcnt(0)" ::: "memory");
        } else {
            XB_SPIN(xb_ld(&bar[XB_XGEN(b.x)]) == gen, bar);
            __builtin_amdgcn_fence(__ATOMIC_ACQUIRE, "agent");
            asm volatile("s_waitcnt vmcnt(0)" ::: "memory");
        }
    }
    __syncthreads();
}
#define OPAQUE_LANE() int tid_ = threadIdx.x; asm volatile("" : "+v"(tid_)); const int lane_ = tid_ & 63, wave_ = __builtin_amdgcn_readfirstlane(tid_ >> 6); (void)lane_; (void)wave_
struct Frame {
    LAS unsigned char* lds;
    volatile LAS unsigned* MISC;
    gu32* ctl;
    int tid, lane, wave;
    int vcu, G;
    unsigned char* ws;
    const float* const* in;
};
__device__ __forceinline__ float wave_sum(float v) {
#pragma unroll
    for (int o = 1; o < 64; o <<= 1) v += __shfl_xor(v, o);
    return v;
}
struct CvItem { const char* src; size_t rowstep; const float* gain; bf16* dst; int K, perm; };
__device__ const float CV_ONES[64] = {1.f,1.f,1.f,1.f,1.f,1.f,1.f,1.f,1.f,1.f,1.f,1.f,1.f,1.f,1.f,1.f,1.f,1.f,1.f,1.f,1.f,1.f,1.f,1.f,1.f,1.f,1.f,1.f,1.f,1.f,1.f,1.f,
                                      1.f,1.f,1.f,1.f,1.f,1.f,1.f,1.f,1.f,1.f,1.f,1.f,1.f,1.f,1.f,1.f,1.f,1.f,1.f,1.f,1.f,1.f,1.f,1.f,1.f,1.f,1.f,1.f,1.f,1.f,1.f,1.f};
constexpr int CVB_GAIN = 32 * 264, CVB_BYTES = CVB_GAIN + 256, CV_GROUP = 33;
static_assert(15 * CVB_BYTES <= RING_BYTES && RSTAB_OFF + CVB_BYTES <= LDS_BYTES && CVB_BYTES % 16 == 0 && RSTAB_OFF % 16 == 0, "conversion buffers");
__device__ __forceinline__ CvItem cv_make(const float* W, int K, int N, bf16* WT, const float* gain, int gu_mode, int item, int lane) {
    const int nblk = N / 32, kb = item / nblk, nb = item - kb * nblk, k0 = 64 * kb, n0 = 32 * nb;
    int d0 = n0, perm = 0; if (gu_mode == 1) { const int isu = n0 >= DFF ? 1 : 0, nn = n0 - isu * DFF; d0 = (nn >> 7) * 256 + isu * 128 + (nn & 127); }
    if (gu_mode == 2 && n0 < 2560) { const int d = n0 & 127; d0 = (n0 & ~127) + 64 * (d >> 6) + 4 * ((d >> 5) & 1); perm = 1; }
    CvItem c; c.perm = perm; c.src = (const char*)(W + (size_t)(k0 + (lane >> 5)) * N + n0 + (lane & 31)); c.rowstep = (size_t)8 * N - 264;
    c.gain = (gain ? gain + k0 : CV_ONES) + lane;
    c.dst = WT + (size_t)d0 * K + k0; c.K = K; return c;
}
#define CV16(M) M(0) M(1) M(2) M(3) M(4) M(5) M(6) M(7) M(8) M(9) M(10) M(11) M(12) M(13) M(14) M(15)
__device__ __forceinline__ void cv_issue(const CvItem& c, LAS unsigned char* buf) {
#define CV_LO(i) __builtin_amdgcn_global_load_lds((const unsigned*)(c.src + (size_t)(i) * c.rowstep), (LAS unsigned*)buf, 4, 264 * (i), 2);
#define CV_HI(i) __builtin_amdgcn_global_load_lds((const unsigned*)(c.src + (size_t)(16 + (i)) * c.rowstep + 16 * 264), (LAS unsigned*)(buf + 16 * 264), 4, 264 * (i), 2);
    CV16(CV_LO) CV16(CV_HI)
#undef CV_LO
#undef CV_HI
    __builtin_amdgcn_global_load_lds((const unsigned*)c.gain, (LAS unsigned*)(buf + CVB_GAIN), 4, 0, 0);
}
__device__ __forceinline__ void cv_finish(const CvItem& c, LAS unsigned char* buf, int lane) {
    typedef float f2 __attribute__((ext_vector_type(2)));
    const int cc = lane & 7, nq = lane >> 3;
    const unsigned a = (unsigned)(uintptr_t)buf + 4u * (unsigned)(264 * cc + nq), ga = (unsigned)(uintptr_t)buf + (unsigned)(CVB_GAIN + 32 * cc);
    f2 r0, r1, r2, r3, r4, r5, r6, r7, r8, r9, r10, r11, r12, r13, r14, r15; f32x4 g0, g1;
    asm volatile(
        "ds_read2_b32 %0, %18 offset0:0 offset1:32\n\t"
        "ds_read2_b32 %1, %18 offset0:66 offset1:98\n\t"
        "ds_read2_b32 %2, %18 offset0:132 offset1:164\n\t"
        "ds_read2_b32 %3, %18 offset0:198 offset1:230\n\t"
        "ds_read2_b32 %4, %18 offset0:8 offset1:40\n\t"
        "ds_read2_b32 %5, %18 offset0:74 offset1:106\n\t"
        "ds_read2_b32 %6, %18 offset0:140 offset1:172\n\t"
        "ds_read2_b32 %7, %18 offset0:206 offset1:238\n\t"
        "ds_read2_b32 %8, %18 offset0:16 offset1:48\n\t"
        "ds_read2_b32 %9, %18 offset0:82 offset1:114\n\t"
        "ds_read2_b32 %10, %18 offset0:148 offset1:180\n\t"
        "ds_read2_b32 %11, %18 offset0:214 offset1:246\n\t"
        "ds_read2_b32 %12, %18 offset0:24 offset1:56\n\t"
        "ds_read2_b32 %13, %18 offset0:90 offset1:122\n\t"
        "ds_read2_b32 %14, %18 offset0:156 offset1:188\n\t"
        "ds_read2_b32 %15, %18 offset0:222 offset1:254\n\t"
        "ds_read_b128 %16, %19\n\t"
        "ds_read_b128 %17, %19 offset:16\n\t"
        "s_waitcnt lgkmcnt(0)"
        : "=&v"(r0), "=&v"(r1), "=&v"(r2), "=&v"(r3), "=&v"(r4), "=&v"(r5), "=&v"(r6), "=&v"(r7), "=&v"(r8), "=&v"(r9), "=&v"(r10), "=&v"(r11), "=&v"(r12), "=&v"(r13), "=&v"(r14), "=&v"(r15), "=&v"(g0), "=&v"(g1)
        : "v"(a), "v"(ga) : "memory");
#define CV_OUT(j, ra, rb, rc, rd) do { const int n = nq + 8 * (j); v4u o; o.x = pg8::cvt_pk_bf16(ra.x * g0.x, ra.y * g0.y); o.y = pg8::cvt_pk_bf16(rb.x * g0.z, rb.y * g0.w); \
        o.z = pg8::cvt_pk_bf16(rc.x * g1.x, rc.y * g1.y); o.w = pg8::cvt_pk_bf16(rd.x * g1.z, rd.y * g1.w); \
        const int nrow = c.perm ? 8 * (n >> 2) + (n & 3) : n; *(GAS v4u*)(c.dst + (size_t)nrow * c.K + 8 * cc) = o; } while (0)
    CV_OUT(0, r0, r1, r2, r3); CV_OUT(1, r4, r5, r6, r7); CV_OUT(2, r8, r9, r10, r11); CV_OUT(3, r12, r13, r14, r15);
#undef CV_OUT
}
__device__ __forceinline__ void sincos_acc(float ang, float& sn, float& cs) {
    const double a = (double)ang; const double kq = __builtin_rint(a * 0.63661977236758134308);
    double r = __builtin_fma(-kq, 1.5707963267948966192, a); r = __builtin_fma(-kq, 6.123233995736766036e-17, r);
    const double r2 = r * r;
    double ps = -1.0 / 1307674368000.0; ps = ps * r2 + 1.0 / 6227020800.0; ps = ps * r2 - 1.0 / 39916800.0; ps = ps * r2 + 1.0 / 362880.0; ps = ps * r2 - 1.0 / 5040.0; ps = ps * r2 + 1.0 / 120.0; ps = ps * r2 - 1.0 / 6.0; ps = ps * r2 + 1.0;
    const double s = ps * r;
    double pc = 1.0 / 20922789888000.0; pc = pc * r2 - 1.0 / 87178291200.0; pc = pc * r2 + 1.0 / 479001600.0; pc = pc * r2 - 1.0 / 3628800.0; pc = pc * r2 + 1.0 / 40320.0; pc = pc * r2 - 1.0 / 720.0; pc = pc * r2 + 1.0 / 24.0; pc = pc * r2 - 0.5; pc = pc * r2 + 1.0;
    const int q = ((int)kq) & 3;
    const double ss = (q == 0) ? s : (q == 1) ? pc : (q == 2) ? -s : -pc;
    const double cc = (q == 0) ? pc : (q == 1) ? -s : (q == 2) ? -pc : s;
    sn = (float)ss; cs = (float)cc;
}
enum { CK_GU = 0, CK_D, CK_QKV, CK_O, CK_IN, CK_OUT, CK_G };
constexpr int CV_NMAT = 26, CV_TOTAL = 158720, CV_X0 = 13824;
__device__ const int CV_SLOT_START[11] = {13824, 30208, 42496, 58880, 75264, 91648, 108032, 120320, 136704, 153088, 169472};
__device__ const int CV_CUM[CV_NMAT + 1] = {0, 11264, 16896, 19968, 22016, 33280, 38912, 50176, 55808, 59904, 61952, 62464, 73728, 79360, 90624, 96256, 99328, 101376, 112640, 118272, 129536, 135168, 139264, 141312, 141824, 153088, 158720};
__device__ const int CV_KIND[CV_NMAT] = {CK_GU, CK_D, CK_QKV, CK_O, CK_GU, CK_D, CK_GU, CK_D, CK_IN, CK_OUT, CK_G, CK_GU, CK_D, CK_GU, CK_D, CK_QKV, CK_O, CK_GU, CK_D, CK_GU, CK_D, CK_IN, CK_OUT, CK_G, CK_GU, CK_D};
__device__ const int CV_IDX[CV_NMAT]  = {0, 0, 0, 0, 1, 1, 2, 2, 0, 0, 0, 3, 3, 4, 4, 1, 1, 5, 5, 6, 6, 1, 1, 1, 7, 7};
struct CvMat { int lo, hi; const float* W; bf16* WT; const float* gain; int K, N, gm; };
__device__ __forceinline__ CvMat cv_mat(Frame& F, int it) {
    int m = 0; while (it >= CV_CUM[m + 1]) ++m;
    const int kind = CV_KIND[m], ix = CV_IDX[m];
    CvMat M; M.lo = CV_CUM[m]; M.hi = CV_CUM[m + 1]; M.gain = nullptr; M.gm = 0;
    if (kind == CK_GU)       { M.W = F.in[2] + (size_t)ix * DM * NGU; M.K = DM; M.N = NGU; M.WT = (bf16*)(F.ws + WS_WGU + ix * SZ_WGU); M.gain = F.in[1] + ix * DM; M.gm = 1; }
    else if (kind == CK_D)   { M.W = F.in[3] + (size_t)ix * DFF * DM; M.K = DFF; M.N = DM; M.WT = (bf16*)(F.ws + WS_WD + ix * SZ_WD); }
    else if (kind == CK_QKV) { M.W = F.in[5] + (size_t)ix * DM * QKVD; M.K = DM; M.N = QKVD; M.WT = (bf16*)(F.ws + WS_WQKV + ix * SZ_WQKV); M.gain = F.in[4] + ix * DM; M.gm = 2; }
    else if (kind == CK_O)   { M.W = F.in[8] + (size_t)ix * DM * DM; M.K = DM; M.N = DM; M.WT = (bf16*)(F.ws + WS_WO + ix * SZ_WO); }
    else if (kind == CK_IN)  { M.W = F.in[10] + (size_t)ix * DM * 2 * DRNN; M.K = DM; M.N = 2 * DRNN; M.WT = (bf16*)(F.ws + WS_WIN + ix * SZ_WIN); M.gain = F.in[9] + ix * DM; }
    else if (kind == CK_OUT) { M.W = F.in[16] + (size_t)ix * DRNN * DM; M.K = DRNN; M.N = DM; M.WT = (bf16*)(F.ws + WS_WOUT + ix * SZ_WOUT); }
    else { const int r = it - M.lo, b = ix * 64 + (r >> 3); M.lo += r & ~7; M.hi = M.lo + 8; M.W = F.in[13] + (size_t)b * 16384; M.K = 128; M.N = 128; M.WT = (bf16*)(F.ws + WS_WG) + (size_t)b * 16384; }
    return M;
}
#define CV_WAIT(n) asm volatile("s_waitcnt vmcnt(%0)" :: "n"(n) : "memory")
__device__ __forceinline__ void convert_range(Frame& F, int lo, int hi, int rank, int nranks) {
    OPAQUE_LANE();
    const int b0 = 2 * wave_;
    LAS unsigned char* bufA = F.lds + RING_OFF + b0 * CVB_BYTES; LAS unsigned char* bufB = (b0 + 1 < 15) ? F.lds + RING_OFF + (b0 + 1) * CVB_BYTES : F.lds + RSTAB_OFF;
    if (hi > CV_TOTAL) hi = CV_TOTAL;
    const int step = nranks * NWAVES; int it = lo + rank * NWAVES + wave_;
    if (it >= hi) return;
    CvMat M = cv_mat(F, it);
#define CV_ITEM(it_) ({ if ((it_) >= M.hi) M = cv_mat(F, (it_)); cv_make(M.W, M.K, M.N, M.WT, M.gain, M.gm, (it_) - M.lo, lane_); })
    CvItem A = CV_ITEM(it); cv_issue(A, bufA);
    for (;;) {
        const int itb = it + step; const bool mb = itb < hi; CvItem B = A;
        if (mb) { B = CV_ITEM(itb); cv_issue(B, bufB); CV_WAIT(CV_GROUP); } else CV_WAIT(0);
        cv_finish(A, bufA, lane_);
        if (!mb) break;
        it = itb + step; const bool ma = it < hi;
        if (ma) { A = CV_ITEM(it); cv_issue(A, bufA); CV_WAIT(CV_GROUP); } else CV_WAIT(0);
        cv_finish(B, bufB, lane_);
        if (!ma) break;
    }
#undef CV_ITEM
}
__device__ __forceinline__ void p0_prologue(Frame& F) {
    OPAQUE_LANE();
    const int gw = F.vcu * NWAVES + wave_, NGW = F.G * NWAVES;
    convert_range(F, 0, CV_X0, F.vcu, F.G);
    { bf16* XB = (bf16*)(F.ws + WS_XB); pg8::ss_t* ss0 = (pg8::ss_t*)(F.ws + WS_SS);
      for (int m = gw; m < S; m += NGW) {
        const GAS f32x4* xr = (const GAS f32x4*)(F.in[0] + (size_t)m * DM) + lane_; f32x4 v[8]; float s = 0.f;
#pragma unroll
        for (int j = 0; j < 8; ++j) { v[j] = xr[64 * j]; s += (v[j].x * v[j].x + v[j].y * v[j].y) + (v[j].z * v[j].z + v[j].w * v[j].w); }
        s = wave_sum(s); if (lane_ == 0) ss0[m] = (pg8::ss_t)(s * pg8::SS_SCALE);
        GAS unsigned long long* o8 = (GAS unsigned long long*)(XB + (size_t)m * DM) + lane_;
#pragma unroll
        for (int j = 0; j < 8; ++j) o8[64 * j] = (unsigned long long)pk2(v[j].x, v[j].y) | ((unsigned long long)pk2(v[j].z, v[j].w) << 32);
      } }
    { float* rt = (float*)(F.ws + WS_ROPE); const int gt = (F.vcu * NWAVES + wave_) * 64 + lane_;
      for (int e = gt; e < (128 + 64) * 32; e += NGW * 64) { const int f = e & 31, pe = e >> 5; const int isc = pe >= 128 ? 1 : 0, pos = pe - isc * 128;
        double inv = 1.0; for (int k = 0; k < f; ++k) inv *= 0.74989420933245582730;
        const float ang = (float)pos * (float)inv; float sn, cs; sincos_acc(ang, sn, cs);
        float* cst = rt + (isc ? 8192 : 0); const int nel = isc ? 2048 : 4096;
        cst[pos * 32 + f] = cs; cst[nel + pos * 32 + f] = sn; } }
}
__device__ __forceinline__ void rope_phase(Frame& F, const float* qg, const float* kg) {
    OPAQUE_LANE();
    bf16* QKV = (bf16*)(F.ws + WS_QKV); const float* rt = (const float*)(F.ws + WS_ROPE);
    const int gw = F.vcu * NWAVES + wave_, NGW = F.G * NWAVES, g = lane_ >> 4, j = lane_ & 15;
    const int d = 8 * j, axis = d >> 6, first = ((d & 63) < 32) ? 1 : 0, f0 = d & 31;
    const float* gq = qg + d; const float* gk = kg + d;
    const f32x4 gq0 = *(const f32x4*)gq, gq1 = *(const f32x4*)(gq + 4), gk0 = *(const f32x4*)gk, gk1 = *(const f32x4*)(gk + 4);
    for (int row = gw; row < S; row += NGW) {
        bf16* p = QKV + (size_t)row * QKVD + g * 128 + d;
        v4u w[5];
#pragma unroll
        for (int part = 0; part < 5; ++part) w[part] = *(const GAS v4u*)(p + part * 512);
        const int pos = axis ? (row & 63) : (row >> 6);
        const float* ct = rt + (axis ? 8192 : 0) + pos * 32 + f0; const float* st = ct + (axis ? 2048 : 4096);
        const f32x4 c0 = *(const f32x4*)ct, c1 = *(const f32x4*)(ct + 4), s0 = *(const f32x4*)st, s1 = *(const f32x4*)(st + 4);
        const float cs[8] = {c0.x, c0.y, c0.z, c0.w, c1.x, c1.y, c1.z, c1.w}, sn[8] = {s0.x, s0.y, s0.z, s0.w, s1.x, s1.y, s1.z, s1.w};
#pragma unroll
        for (int part = 0; part < 5; ++part) {
            float x[8] = {bf_lo(w[part].x), bf_hi(w[part].x), bf_lo(w[part].y), bf_hi(w[part].y), bf_lo(w[part].z), bf_hi(w[part].z), bf_lo(w[part].w), bf_hi(w[part].w)};
            float ssq = 0.f;
#pragma unroll
            for (int e = 0; e < 8; ++e) ssq += x[e] * x[e];
            ssq += __shfl_xor(ssq, 1); ssq += __shfl_xor(ssq, 2); ssq += __shfl_xor(ssq, 4); ssq += __shfl_xor(ssq, 8);
            const float rstd = __builtin_amdgcn_rsqf(ssq * (1.0f / 128.0f) + NORM_EPS);
            const f32x4 g0 = part < 4 ? gq0 : gk0, g1 = part < 4 ? gq1 : gk1;
            const float gn[8] = {g0.x, g0.y, g0.z, g0.w, g1.x, g1.y, g1.z, g1.w};
            float o[8];
#pragma unroll
            for (int e = 0; e < 8; ++e) { const float xn = x[e] * rstd * gn[e]; const float pn = __shfl_xor(xn, 4);
                o[e] = first ? (xn * cs[e] - pn * sn[e]) : (xn * cs[e] + pn * sn[e]); }
            v4u ow; ow.x = pk2(o[0], o[1]); ow.y = pk2(o[2], o[3]); ow.z = pk2(o[4], o[5]); ow.w = pk2(o[6], o[7]);
            *(GAS v4u*)(p + part * 512) = ow;
        }
    }
}
__device__ __forceinline__ void attn_phase(Frame& F, char* lds) {
    const att::bf16* QKV = (const att::bf16*)(F.ws + WS_QKV); att::bf16* O = (att::bf16*)(F.ws + WS_O);
    for (int u = F.vcu; u < 512; u += F.G) {
        const int i = u >> 8, x = (u & 255) >> 5, l = u & 31, kvh = x >> 1, h = kvh * 4 + (x & 1) * 2 + i, qb = l;
        att::attn_dense_body(QKV + (size_t)(qb * 256) * QKVD + h * 128, QKV + 2048 + kvh * 128, QKV + 2560 + kvh * 128, O + (size_t)(qb * 256) * DM + h * 128, S, lds);
    }
}
constexpr int SC_AT = 0, SC_ATP = 272;
constexpr int SC_AB = 9216;
constexpr int SC_H = SC_AB + 65536;
constexpr int SC_CR = SC_H + 32768;
static_assert(SC_CR + 16384 <= RING_BYTES, "scan LDS map");
#define LDS_BARRIER() do { asm volatile("s_waitcnt lgkmcnt(0)" ::: "memory"); __builtin_amdgcn_s_barrier(); asm volatile("" ::: "memory"); } while (0)
struct RecArgs { const bf16* U; const bf16* Wg; const float* gate_b; const float* lam; const float* conv_w; const float* conv_b; float2* aggs; float2* aggc; bf16* Y; unsigned* AB; };
__device__ __forceinline__ float sigmoid_f(float x) { return __builtin_amdgcn_rcpf(1.0f + __builtin_amdgcn_exp2f(x * -1.4426950408889634f)); }
__device__ __forceinline__ unsigned pk2r(float lo, float hi) { unsigned r; asm volatile("v_cvt_pk_bf16_f32 %0, %1, %2" : "=v"(r) : "v"(lo), "v"(hi)); return r; }
__device__ __forceinline__ float bfl_(unsigned w) { return __builtin_bit_cast(float, w << 16); }
__device__ __forceinline__ float bfh_(unsigned w) { return __builtin_bit_cast(float, w & 0xffff0000u); }
template <int PASS>
__device__ __forceinline__ void rec_pass(Frame& F, char* lds, const RecArgs& R) {
    typedef float f32x4v __attribute__((ext_vector_type(4)));
    OPAQUE_LANE();
    const int tid = tid_, lane = lane_, w = wave_, wd = w >> 2, wq = w & 3, l15 = lane & 15, l4 = lane >> 4;
    const int tl = tid >> 4, c8 = (tid & 15) * 8;
    const int sd = tid >> 7, sch = tid & 127;
    constexpr float L2E = 1.4426950408889634f, LN2x2 = 1.3862943611198906f;
    for (int item = F.vcu; item < 256; item += F.G) {
        const int n = item & 15, c = item >> 4;
        if (PASS == 2 && tid < 256) {
            const int ch = n * 128 + sch; float* cr = (float*)(lds + SC_CR);
            float h = 0.f;
            const int nf = sd ? 15 - c : c, first = sd ? 15 : 0, step = sd ? -1 : 1;
            for (int k0 = 0; k0 < nf; k0 += 4) { float2 v[4];
#pragma unroll
                for (int j = 0; j < 4; ++j) { int cc = first + step * (k0 + j); cc = cc < 0 ? 0 : (cc > 15 ? 15 : cc); v[j] = R.aggc[(size_t)(cc * 2 + sd) * DRNN + ch]; }
#pragma unroll
                for (int j = 0; j < 4; ++j) if (k0 + j < nf) h = v[j].x * h + v[j].y; }
            for (int k0 = 0; k0 < 16; k0 += 4) { float2 v[4];
#pragma unroll
                for (int j = 0; j < 4; ++j) { const int ss_ = first + step * (k0 + j); v[j] = R.aggs[(size_t)((c * 16 + ss_) * 2 + sd) * DRNN + ch]; }
#pragma unroll
                for (int j = 0; j < 4; ++j) { const int ss_ = first + step * (k0 + j); cr[(ss_ * 2 + sd) * 128 + sch] = h; h = v[j].x * h + v[j].y; } }
        }
        asm volatile("" ::: "memory");
        bf16x8 bfr[2][2][4];
#pragma unroll
        for (int z = 0; z < 2; ++z)
#pragma unroll
            for (int nt = 0; nt < 2; ++nt)
#pragma unroll
                for (int ks = 0; ks < 4; ++ks)
                    bfr[z][nt][ks] = *(const GAS bf16x8*)(R.Wg + ((size_t)(((wd * 2 + z) * 16 + n) * 128 + wq * 32 + nt * 16 + l15)) * 128 + ks * 32 + l4 * 8);
        float brn[2], bin[2], spn[2];
#pragma unroll
        for (int nt = 0; nt < 2; ++nt) { const int ch = n * 128 + wq * 32 + nt * 16 + l15; brn[nt] = -L2E * R.gate_b[(wd * 2 + 0) * DRNN + ch]; bin[nt] = -L2E * R.gate_b[(wd * 2 + 1) * DRNN + ch];
            const float lm = R.lam[wd * DRNN + ch]; spn[nt] = -L2E * 8.0f * log1pf(__expf(-lm)); }
        float cw[4][8], cb[8];
        { const int ch0 = n * 128 + c8;
#pragma unroll
          for (int tp = 0; tp < 4; ++tp) { const f32x4v a = *(const f32x4v*)(R.conv_w + tp * DRNN + ch0), b = *(const f32x4v*)(R.conv_w + tp * DRNN + ch0 + 4);
              cw[tp][0] = a.x; cw[tp][1] = a.y; cw[tp][2] = a.z; cw[tp][3] = a.w; cw[tp][4] = b.x; cw[tp][5] = b.y; cw[tp][6] = b.z; cw[tp][7] = b.w; }
          const f32x4v a = *(const f32x4v*)(R.conv_b + ch0), b = *(const f32x4v*)(R.conv_b + ch0 + 4);
          cb[0] = a.x; cb[1] = a.y; cb[2] = a.z; cb[3] = a.w; cb[4] = b.x; cb[5] = b.y; cb[6] = b.z; cb[7] = b.w; }
        float aggA = 1.f, aggB = 0.f;
        const bf16* Urec = R.U + DRNN + n * 128 + c8; const bf16* Ugate = R.U + n * 128 + c8;
        v4u un[4], gn = (v4u){0u, 0u, 0u, 0u};
#define REC_LOAD(t0_) do { const int t_ = (t0_) + tl; _Pragma("unroll") for (int tp = 0; tp < 4; ++tp) { const int tt = t_ + tp - 2; un[tp] = (v4u){0u, 0u, 0u, 0u}; \
            if (tt >= 0 && tt < S) un[tp] = *(const GAS v4u*)(Urec + (size_t)tt * (2 * DRNN)); } if (PASS == 2) gn = *(const GAS v4u*)(Ugate + (size_t)t_ * (2 * DRNN)); } while (0)
        REC_LOAD(c * 512);
        for (int s = 0; s < 16; ++s) {
            const int t0 = c * 512 + s * 32;
            v4u gcur = gn;
            { float xc[8];
#pragma unroll
              for (int e = 0; e < 8; ++e) xc[e] = cb[e];
#pragma unroll
              for (int tp = 0; tp < 4; ++tp) { const v4u wv = un[tp];
                  xc[0] += cw[tp][0] * bf_lo(wv.x); xc[1] += cw[tp][1] * bf_hi(wv.x); xc[2] += cw[tp][2] * bf_lo(wv.y); xc[3] += cw[tp][3] * bf_hi(wv.y);
                  xc[4] += cw[tp][4] * bf_lo(wv.z); xc[5] += cw[tp][5] * bf_hi(wv.z); xc[6] += cw[tp][6] * bf_lo(wv.w); xc[7] += cw[tp][7] * bf_hi(wv.w); }
              v4u o; o.x = pk2(xc[0], xc[1]); o.y = pk2(xc[2], xc[3]); o.z = pk2(xc[4], xc[5]); o.w = pk2(xc[6], xc[7]);
              *(v4u*)(lds + SC_AT + tl * SC_ATP + c8 * 2) = o; }
            if (s < 15) REC_LOAD(t0 + 32);
            LDS_BARRIER();
#pragma unroll
            for (int mt = 0; mt < 2; ++mt) {
                bf16x8 af[4];
#pragma unroll
                for (int ks = 0; ks < 4; ++ks) af[ks] = *(const bf16x8*)(lds + SC_AT + (mt * 16 + l15) * SC_ATP + (ks * 32 + l4 * 8) * 2);
                f32x4v acc[2][2];
#pragma unroll
                for (int z = 0; z < 2; ++z)
#pragma unroll
                    for (int nt = 0; nt < 2; ++nt) { acc[z][nt] = (f32x4v){0.f, 0.f, 0.f, 0.f};
#pragma unroll
                        for (int ks = 0; ks < 4; ++ks) acc[z][nt] = __builtin_amdgcn_mfma_f32_16x16x32_bf16(af[ks], bfr[z][nt][ks], acc[z][nt], 0, 0, 0); }
#pragma unroll
                for (int nt = 0; nt < 2; ++nt)
#pragma unroll
                    for (int rg = 0; rg < 4; ++rg) { const int tt = mt * 16 + l4 * 4 + rg, chl = wq * 32 + nt * 16 + l15;
                        const float er = __builtin_amdgcn_exp2f(__builtin_fmaf(acc[0][nt][rg], -L2E, brn[nt])), ei = __builtin_amdgcn_exp2f(__builtin_fmaf(acc[1][nt][rg], -L2E, bin[nt]));
                        const float rgate = __builtin_amdgcn_rcpf(1.0f + er), igate = __builtin_amdgcn_rcpf(1.0f + ei);
                        const float l2 = bfl_(pk2r(spn[nt] * rgate, 0.f)), a = __builtin_amdgcn_exp2f(l2), x2 = l2 * LN2x2;
                        float emp = -x2 * (1.0f + x2 * (0.5f + x2 * (0.16666667f + x2 * 0.041666668f))); asm volatile("" : "+v"(emp));
                        const float em = (x2 > -0.1f) ? emp : __builtin_fmaf(-a, a, 1.0f);
                        const float xv = __builtin_bit_cast(float, ((unsigned)*(const unsigned short*)(lds + SC_AT + tt * SC_ATP + chl * 2)) << 16);
                        const unsigned pw = pk2r(l2, __builtin_amdgcn_sqrtf(em) * igate * xv); const float bb = bfh_(pw);
                        if (PASS == 1) R.AB[(size_t)(item * 16 + s) * 8192 + (wd * 32 + tt) * 128 + chl] = pw;
                        *(float*)(lds + SC_AB + ((wd * 2 + 0) * 32 + tt) * 512 + chl * 4) = a;
                        *(float*)(lds + SC_AB + ((wd * 2 + 1) * 32 + tt) * 512 + chl * 4) = bb; }
            }
            LDS_BARRIER();
            if (tid < 256) {
                const float* pa = (const float*)(lds + SC_AB + (sd * 2 + 0) * 16384) + sch; const float* pb = (const float*)(lds + SC_AB + (sd * 2 + 1) * 16384) + sch;
                if (PASS == 1) {
                    float P = 1.f, h = 0.f;
#pragma nounroll
                    for (int k0 = 0; k0 < 32; k0 += 8) { float a8[8], b8[8];
#pragma unroll
                        for (int j = 0; j < 8; ++j) { const int t = sd ? 31 - (k0 + j) : k0 + j; a8[j] = pa[t * 128]; b8[j] = pb[t * 128]; }
#pragma unroll
                        for (int j = 0; j < 8; ++j) { h = a8[j] * h + b8[j]; P *= a8[j]; } }
                    R.aggs[(size_t)((c * 16 + s) * 2 + sd) * DRNN + n * 128 + sch] = make_float2(P, h);
                    if (sd == 0) { aggB = P * aggB + h; aggA = P * aggA; } else { aggB = aggA * h + aggB; aggA = aggA * P; }
                } else {
                    float h = *((const float*)(lds + SC_CR) + (s * 2 + sd) * 128 + sch); float* ph = (float*)(lds + SC_H + sd * 16384) + sch;
#pragma nounroll
                    for (int k0 = 0; k0 < 32; k0 += 8) { float a8[8], b8[8];
#pragma unroll
                        for (int j = 0; j < 8; ++j) { const int t = sd ? 31 - (k0 + j) : k0 + j; a8[j] = pa[t * 128]; b8[j] = pb[t * 128]; }
#pragma unroll
                        for (int j = 0; j < 8; ++j) { const int t = sd ? 31 - (k0 + j) : k0 + j; h = a8[j] * h + b8[j]; ph[t * 128] = h; } }
                }
            }
            if (PASS == 2) {
                LDS_BARRIER();
                const float* hf = (const float*)(lds + SC_H + tl * 512 + c8 * 4); const float* hb = (const float*)(lds + SC_H + 16384 + tl * 512 + c8 * 4);
                const f32x4v f0 = *(const f32x4v*)hf, f1 = *(const f32x4v*)(hf + 4), b0 = *(const f32x4v*)hb, b1 = *(const f32x4v*)(hb + 4);
                const int t = t0 + tl;
                const float gx[8] = {bf_lo(gcur.x), bf_hi(gcur.x), bf_lo(gcur.y), bf_hi(gcur.y), bf_lo(gcur.z), bf_hi(gcur.z), bf_lo(gcur.w), bf_hi(gcur.w)};
                const float hs[8] = {f0.x + b0.x, f0.y + b0.y, f0.z + b0.z, f0.w + b0.w, f1.x + b1.x, f1.y + b1.y, f1.z + b1.z, f1.w + b1.w};
                float y[8];
#pragma unroll
                for (int e = 0; e < 8; ++e) { const float v = gx[e]; const float u = 1.5957691216057308f * (v + 0.044715f * v * v * v); y[e] = v * sigmoid_f(u) * hs[e]; }
                v4u o; o.x = pk2(y[0], y[1]); o.y = pk2(y[2], y[3]); o.z = pk2(y[4], y[5]); o.w = pk2(y[6], y[7]);
                *(GAS v4u*)(R.Y + (size_t)t * DRNN + n * 128 + c8) = o;
            }
        }
#undef REC_LOAD
        if (PASS == 1 && tid < 256) R.aggc[(size_t)(c * 2 + sd) * DRNN + n * 128 + sch] = make_float2(aggA, aggB);
        __syncthreads();
    }
}
__device__ __forceinline__ void rec_pass2s(Frame& F, char* lds, const RecArgs& R) {
    typedef float f32x4v __attribute__((ext_vector_type(4)));
    OPAQUE_LANE();
    const int tid = tid_;
    const int tl = tid >> 4, c8 = (tid & 15) * 8;
    const int sd = tid >> 7, sch = tid & 127;
    for (int item = F.vcu; item < 256; item += F.G) {
        const int n = item & 15, c = item >> 4;
        if (tid < 256) {
            const int ch = n * 128 + sch; float* cr = (float*)(lds + SC_CR);
            const int first = sd ? 15 : 0, step = sd ? -1 : 1, nf = sd ? 15 - c : c;
            float2 vc[16], vs[16];
#pragma unroll
            for (int j = 0; j < 16; ++j) { const int cc = first + step * j; vc[j] = R.aggc[(size_t)(cc * 2 + sd) * DRNN + ch]; vs[j] = R.aggs[(size_t)((c * 16 + cc) * 2 + sd) * DRNN + ch]; }
            float h = 0.f;
#pragma unroll
            for (int j = 0; j < 16; ++j) if (j < nf) h = vc[j].x * h + vc[j].y;
#pragma unroll
            for (int j = 0; j < 16; ++j) { const int ss_ = first + step * j; cr[(ss_ * 2 + sd) * 128 + sch] = h; h = vs[j].x * h + vs[j].y; }
        }
        asm volatile("" ::: "memory");
        const unsigned* abp = R.AB + (size_t)item * 16 * 8192; const bf16* Ugate = R.U + n * 128 + c8;
        v4u pn[4], gn;
#define REC2_LOAD(s_) do { _Pragma("unroll") for (int i = 0; i < 4; ++i) pn[i] = *(const GAS v4u*)(abp + (size_t)(s_) * 8192 + (tid + 512 * i) * 4); \
            gn = *(const GAS v4u*)(Ugate + (size_t)(c * 512 + (s_) * 32 + tl) * (2 * DRNN)); } while (0)
        REC2_LOAD(0);
        for (int s = 0; s < 16; ++s) {
            const int t0 = c * 512 + s * 32;
            const v4u gcur = gn;
#pragma unroll
            for (int i = 0; i < 4; ++i) { const int idx = tid + 512 * i, dir = idx >> 10, t = (idx >> 5) & 31, c4 = (idx & 31) * 4; const v4u p = pn[i];
                const f32x4v a4 = {__builtin_amdgcn_exp2f(bfl_(p.x)), __builtin_amdgcn_exp2f(bfl_(p.y)), __builtin_amdgcn_exp2f(bfl_(p.z)), __builtin_amdgcn_exp2f(bfl_(p.w))};
                const f32x4v b4 = {bfh_(p.x), bfh_(p.y), bfh_(p.z), bfh_(p.w)};
                *(f32x4v*)(lds + SC_AB + ((dir * 2 + 0) * 32 + t) * 512 + c4 * 4) = a4;
                *(f32x4v*)(lds + SC_AB + ((dir * 2 + 1) * 32 + t) * 512 + c4 * 4) = b4; }
            if (s < 15) REC2_LOAD(s + 1);
            LDS_BARRIER();
            if (tid < 256) {
                const float* pa = (const float*)(lds + SC_AB + (sd * 2 + 0) * 16384) + sch; const float* pb = (const float*)(lds + SC_AB + (sd * 2 + 1) * 16384) + sch;
                float h = *((const float*)(lds + SC_CR) + (s * 2 + sd) * 128 + sch); float* ph = (float*)(lds + SC_H + sd * 16384) + sch;
#pragma nounroll
                for (int k0 = 0; k0 < 32; k0 += 8) { float a8[8], b8[8];
#pragma unroll
                    for (int j = 0; j < 8; ++j) { const int t = sd ? 31 - (k0 + j) : k0 + j; a8[j] = pa[t * 128]; b8[j] = pb[t * 128]; }
#pragma unroll
                    for (int j = 0; j < 8; ++j) { const int t = sd ? 31 - (k0 + j) : k0 + j; h = a8[j] * h + b8[j]; ph[t * 128] = h; } }
            }
            LDS_BARRIER();
            { const float* hf = (const float*)(lds + SC_H + tl * 512 + c8 * 4); const float* hb = (const float*)(lds + SC_H + 16384 + tl * 512 + c8 * 4);
              const f32x4v f0 = *(const f32x4v*)hf, f1 = *(const f32x4v*)(hf + 4), b0 = *(const f32x4v*)hb, b1 = *(const f32x4v*)(hb + 4);
              const int t = t0 + tl;
              const float gx[8] = {bf_lo(gcur.x), bf_hi(gcur.x), bf_lo(gcur.y), bf_hi(gcur.y), bf_lo(gcur.z), bf_hi(gcur.z), bf_lo(gcur.w), bf_hi(gcur.w)};
              const float hs[8] = {f0.x + b0.x, f0.y + b0.y, f0.z + b0.z, f0.w + b0.w, f1.x + b1.x, f1.y + b1.y, f1.z + b1.z, f1.w + b1.w};
              float y[8];
#pragma unroll
              for (int e = 0; e < 8; ++e) { const float v = gx[e]; const float u = 1.5957691216057308f * (v + 0.044715f * v * v * v); y[e] = v * sigmoid_f(u) * hs[e]; }
              v4u o; o.x = pk2(y[0], y[1]); o.y = pk2(y[2], y[3]); o.z = pk2(y[4], y[5]); o.w = pk2(y[6], y[7]);
              *(GAS v4u*)(R.Y + (size_t)t * DRNN + n * 128 + c8) = o; }
        }
#undef REC2_LOAD
        LDS_BARRIER();
    }
}
__device__ __forceinline__ void final_norm_phase(Frame& F, const bf16* X, float* out, const pg8::ss_t* ss, const float* g) {
    OPAQUE_LANE();
    const int gw = F.vcu * NWAVES + wave_, NGW = F.G * NWAVES;
    f32x4 gv[4][2];
#pragma unroll
    for (int j = 0; j < 4; ++j) { gv[j][0] = *((const GAS f32x4*)g + 2 * (lane_ + 64 * j)); gv[j][1] = *((const GAS f32x4*)g + 2 * (lane_ + 64 * j) + 1); }
    for (int m = gw; m < S; m += NGW) { const GAS v4u* xr = (const GAS v4u*)(X + (size_t)m * DM) + lane_; GAS f32x4* orow = (GAS f32x4*)(out + (size_t)m * DM);
        const float rs = pg8::rs_from_ss(ss[m]);
        v4u w[4];
#pragma unroll
        for (int j = 0; j < 4; ++j) w[j] = xr[64 * j];
#pragma unroll
        for (int j = 0; j < 4; ++j) { const f32x4 a = (f32x4){bf_lo(w[j].x), bf_hi(w[j].x), bf_lo(w[j].y), bf_hi(w[j].y)}, b = (f32x4){bf_lo(w[j].z), bf_hi(w[j].z), bf_lo(w[j].w), bf_hi(w[j].w)};
            orow[2 * (lane_ + 64 * j)] = a * rs * gv[j][0]; orow[2 * (lane_ + 64 * j) + 1] = b * rs * gv[j][1]; } }
}
__device__ __forceinline__ int opaque_i(int v) { asm volatile("" : "+s"(v)); return v; }
struct Args { const float* in[18]; float* out; unsigned char* ws; int ph_lo, ph_hi; };
static_assert(sizeof(Args) == 18 * 8 + 8 + 8 + 8, "Args has no padding");
__global__ void __launch_bounds__(NWAVES * 64, 2) mega_fwd(Args args) {
    extern __shared__ __attribute__((aligned(16))) unsigned char lds[];
    Frame F;
    F.lds = (LAS unsigned char*)lds;
    F.MISC = (volatile LAS unsigned*)(F.lds + MISC_OFF);
    F.tid = threadIdx.x; F.lane = F.tid & 63; F.wave = __builtin_amdgcn_readfirstlane(F.tid >> 6);
    F.G = gridDim.x; { const int bx = blockIdx.x; F.vcu = (F.G % 8 == 0) ? (bx % 8) * (F.G / 8) + bx / 8 : bx; }
    F.ws = args.ws; F.ctl = (gu32*)(args.ws + WS_CTL); F.in = args.in;
    for (int u = F.tid; u < (LDS_BYTES - LDSCTL_OFF) / 4; u += NWAVES * 64) ((LAS unsigned*)(F.lds + LDSCTL_OFF))[u] = 0u;
    __syncthreads();
    const int lo = args.ph_lo, hi = args.ph_hi;
    const bool use_bar = (hi - lo) > 1;
    XcdBarrier bar; bar.bar = (unsigned*)(F.ctl + CW_BAR); bar.x = 0; bar.st = nullptr;
    if (use_bar) bar = xcd_barrier_post((unsigned*)(F.ctl + CW_BAR), F.MISC + 8);
#define IN(k) (lo <= (k) && (k) < hi)
#define REP(n) for (int rep_ = 0, nrep_ = opaque_i(n); rep_ < nrep_; ++rep_)
#ifdef DBG_BARWAIT
#define SEAM(k) do { if (IN((k) + 1)) { const unsigned long long t0_ = __builtin_amdgcn_s_memrealtime(); xcd_barrier(bar); if (DBG_BW_SEL(k)) barwait += __builtin_amdgcn_s_memrealtime() - t0_; } } while (0)
#else
#define SEAM(k) do { if (IN((k) + 1)) { REP(DUP_BAR) { XcdBarrier b2_ = bar; asm volatile("" : "+s"(b2_.bar)); xcd_barrier(b2_); } } } while (0)
#endif
    unsigned long long barwait = 0; (void)barwait;
    pg8::ss_t* const ssb = (pg8::ss_t*)(args.ws + WS_SS);
    bf16* const XB = (bf16*)(args.ws + WS_XB);

    #if PH_P0
    if (IN(0)) { REP(DUP_P0) p0_prologue(F); SEAM(0); }
#endif

    for (int sb = 0; sb < NSB; ++sb) {
        typedef const __attribute__((address_space(4))) Args* KArgP;
        KArgP ap_ = (KArgP)__builtin_amdgcn_kernarg_segment_ptr(); asm volatile("" : "+s"(ap_));
        struct { const float* in[18]; float* out; unsigned char* ws; } args;
#pragma unroll
        for (int i_ = 0; i_ < 18; ++i_) args.in[i_] = ap_->in[i_];
        args.out = ap_->out; args.ws = ap_->ws;
        pg8::ss_t* const ssb = (pg8::ss_t*)(args.ws + WS_SS);
        bf16* const XB = (bf16*)(args.ws + WS_XB);
        const int p6 = sb / 6, k6 = sb - 6 * p6;
        const int type = (k6 == 1) ? 1 : (k6 == 4) ? 2 : 0;
        const int f = 4 * p6 + (k6 == 0 ? 0 : k6 == 2 ? 1 : k6 == 3 ? 2 : 3);
        const int pb = 1 + 4 * sb;
        const pg8::ss_t* ss_in = ssb + (size_t)sb * S; pg8::ss_t* ss_out = ssb + (size_t)(sb + 1) * S;
        if (IN(pb)) {
#if PH_GU
            if (type == 0) {
                pg8::Gemm g{XB, (const bf16*)(args.ws + WS_WGU + f * SZ_WGU), S, NGU, DM}; pg8::SsOrder So; So.init(S, NGU, F.G, (int)blockIdx.x); So.ss = ss_in; So.raw = F.lds + RSTAB_OFF; So.k = 0;
                pg8::EpiSwiglu E{(bf16*)(args.ws + WS_H), F.lds + RSTAB_OFF};
                REP(DUP_GU) pg8::gemm_phase<pg8::EpiSwiglu, pg8::SsOrder, true, true>(F.lds + RING_OFF, g, So, E);
                { const int rem = ((S / 256) * (NGU / 256)) % F.G, sj = (f < 1) ? 0 : (f < 5) ? f + 1 : f + 2;
                  if (rem != 0 && (int)blockIdx.x >= rem) convert_range(F, CV_SLOT_START[sj], CV_SLOT_START[sj + 1], (int)blockIdx.x - rem, F.G - rem);
                  else if (rem == 0) convert_range(F, CV_SLOT_START[sj], CV_SLOT_START[sj + 1], (int)blockIdx.x, F.G); }
            }
#endif
#if PH_PLAIN
            if (type != 0) {
                const int N = (type == 1) ? QKVD : 2 * DRNN;
                const bf16* Wt = (type == 1) ? (const bf16*)(args.ws + WS_WQKV + p6 * SZ_WQKV) : (const bf16*)(args.ws + WS_WIN + p6 * SZ_WIN);
                bf16* Out = (type == 1) ? (bf16*)(args.ws + WS_QKV) : (bf16*)(args.ws + WS_U);
                pg8::Gemm g{XB, Wt, S, N, DM}; pg8::SsOrder So; So.init(S, N, F.G, (int)blockIdx.x); So.ss = ss_in; So.raw = F.lds + RSTAB_OFF; So.k = 0;
                pg8::EpiPlain E{Out, N, F.lds + RSTAB_OFF, (type == 1) ? 10 : 0, 8, args.in[6] + p6 * 128, args.in[7] + p6 * 128, (const float*)(args.ws + WS_ROPE), (LAS float*)(F.lds + HSTAB_OFF)};
                REP(DUP_PLAIN) pg8::gemm_phase<pg8::EpiPlain, pg8::SsOrder, true, true>(F.lds + RING_OFF, g, So, E);
                if (type == 1) { const int rem = ((S / 256) * (QKVD / 256)) % F.G, sj = p6 ? 6 : 1;
                  if (rem != 0 && (int)blockIdx.x >= rem) convert_range(F, CV_SLOT_START[sj], CV_SLOT_START[sj + 1], (int)blockIdx.x - rem, F.G - rem);
                  else if (rem == 0) convert_range(F, CV_SLOT_START[sj], CV_SLOT_START[sj + 1], (int)blockIdx.x, F.G); }
            }
#endif
            SEAM(pb);
        }
        if (type == 1) {
#if PH_ROPE
#endif
#if PH_ATT
            if (IN(pb + 2)) { REP(DUP_ATT) attn_phase(F, (char*)lds + RING_OFF); SEAM(pb + 2); }
#endif
        } else if (type == 2) {
            const RecArgs R{(const bf16*)(args.ws + WS_U), (const bf16*)(args.ws + WS_WG) + (size_t)p6 * (4 * 16 * 16384), args.in[14] + p6 * 4 * DRNN, args.in[15] + p6 * 2 * DRNN,
                            args.in[11] + p6 * 4 * DRNN, args.in[12] + p6 * DRNN, (float2*)(args.ws + WS_AGGS), (float2*)(args.ws + WS_AGGC), (bf16*)(args.ws + WS_Y), (unsigned*)(args.ws + WS_AB)};
#if PH_REC1
            if (IN(pb + 1)) { REP(DUP_REC) rec_pass<1>(F, (char*)lds + RING_OFF, R); SEAM(pb + 1); }
#endif
#if PH_REC2
            if (IN(pb + 2)) { REP(DUP_REC) rec_pass2s(F, (char*)lds + RING_OFF, R); SEAM(pb + 2); }
#endif
        }
#if PH_RES
        if (IN(pb + 3)) {
            const bf16* A = (type == 0) ? (const bf16*)(args.ws + WS_H) : (type == 1) ? (const bf16*)(args.ws + WS_O) : (const bf16*)(args.ws + WS_Y);
            const bf16* Wt = (type == 0) ? (const bf16*)(args.ws + WS_WD + f * SZ_WD) : (type == 1) ? (const bf16*)(args.ws + WS_WO + p6 * SZ_WO) : (const bf16*)(args.ws + WS_WOUT + p6 * SZ_WOUT);
            const int K = (type == 0) ? DFF : DM;
            pg8::Gemm g{A, Wt, S, DM, K}; pg8::StaticOrder So; So.init(S, DM, F.G, (int)blockIdx.x, RES_WGM);
            REP(DUP_RES) {
                const bool real = (rep_ == nrep_ - 1);
                pg8::EpiResid E{XB, real ? ss_out : ssb + (size_t)13 * S, real ? (type == 0 ? 0.5f : 1.0f) : 0.0f};
                pg8::gemm_phase<pg8::EpiResid, pg8::StaticOrder, false, true>(F.lds + RING_OFF, g, So, E);
            }
            SEAM(pb + 3);
        }
#endif
    }
#ifdef DBG_BARWAIT
    if (threadIdx.x == 0) atomicAdd((unsigned long long*)(args.ws + 2 * MiB - 512), barwait);
    xcd_barrier(bar);
#endif
#if PH_FN
    if (IN(N_PHASES - 1)) final_norm_phase(F, XB, args.out, ssb + (size_t)NSB * S, args.in[17]);
#endif
#ifdef DBG_BARWAIT
    xcd_barrier(bar);
    if (blockIdx.x == 0 && threadIdx.x == 0) { const unsigned long long tot = *(const unsigned long long*)(args.ws + 2 * MiB - 512); const float avg_us = (float)tot * (0.01f / 256.0f); args.out[0] = 1000.0f * __builtin_floorf(avg_us * (1.0f / DBG_BUCKET_US) + DBG_BUCKET_OFF); }
#endif
#undef IN
#undef SEAM
}

extern "C" void kernel_launch(void* const* d_in, const int* in_sizes, int n_in, void* d_out, int out_size, void* d_ws, size_t ws_size, hipStream_t stream) {
    static int grid = 0;
    if (grid == 0) {
        if (n_in != 18 || in_sizes[0] != S * DM || out_size != S * DM || ws_size < WS_END) { fprintf(stderr, "kernel_launch: shape mismatch: n_in %d in0 %d out %d ws %zu (need %zu)\n", n_in, n_in > 0 ? in_sizes[0] : -1, out_size, ws_size, (size_t)WS_END); grid = -1; return; }
        int dev = 0, cus = 0, per_cu = 0;
        if (hipGetDevice(&dev) != hipSuccess || hipDeviceGetAttribute(&cus, hipDeviceAttributeMultiprocessorCount, dev) != hipSuccess) { fprintf(stderr, "kernel_launch: device query failed\n"); grid = -1; return; }
        if (hipFuncSetAttribute((const void*)mega_fwd, hipFuncAttributeMaxDynamicSharedMemorySize, LDS_BYTES) != hipSuccess) { fprintf(stderr, "kernel_launch: hipFuncSetAttribute failed\n"); grid = -1; return; }
        if (hipOccupancyMaxActiveBlocksPerMultiprocessor(&per_cu, (const void*)mega_fwd, NWAVES * 64, LDS_BYTES) != hipSuccess || per_cu < 1) { fprintf(stderr, "kernel_launch: occupancy query says %d blocks per CU\n", per_cu); }
        (void)hipGetLastError();
        grid = cus;
    }
    if (grid < 0) return;
    if (hipMemsetAsync((char*)d_ws + WS_CTL, 0, CTL_ZERO_BYTES, stream) != hipSuccess) { fprintf(stderr, "kernel_launch: memset failed\n"); return; }
    Args a{};
    for (int i = 0; i < 18; ++i) a.in[i] = (const float*)d_in[i];
    a.out = (float*)d_out; a.ws = (unsigned char*)d_ws;
#if MK_MULTI
    for (int ph = 0; ph < N_PHASES; ++ph) {
        if (ph >= 1 && ph < N_PHASES - 1) { const int sb = (ph - 1) / 4, k = (ph - 1) % 4, k6 = sb % 6; if ((k == 1 || k == 2) && !(k6 == 1 || k6 == 4)) continue; if (k == 1 && k6 == 1) continue; }
        a.ph_lo = ph; a.ph_hi = ph + 1;
        hipLaunchKernelGGL(mega_fwd, dim3(grid), dim3(NWAVES * 64), LDS_BYTES, stream, a);
    }
#else
    a.ph_lo = 0; a.ph_hi = N_PHASES;
    hipLaunchKernelGGL(mega_fwd, dim3(grid), dim3(NWAVES * 64), LDS_BYTES, stream, a);
#endif
    const hipError_t le = hipPeekAtLastError();
    if (le != hipSuccess) fprintf(stderr, "kernel_launch: launch failed: %s\n", hipGetErrorName(le));
}
```

```cpp
#include <hip/hip_runtime.h>
#include <hip/hip_bf16.h>
#include <cstdio>
#include <cstdint>
#define MK_MULTI 0
namespace pg8 {
#define PG8_LAS __attribute__((address_space(3)))
typedef unsigned short bf16_t;
typedef short bf16x8 __attribute__((ext_vector_type(8)));
typedef float f32x4 __attribute__((ext_vector_type(4)));
typedef unsigned u32x4 __attribute__((ext_vector_type(4)));
constexpr int BM = 256, BK = 64, HALF = 128, HTB = HALF * BK * 2  , STAGE_BYTES = 8 * HTB, NXCD = 8, WGM = 8;

__host__ __device__ __forceinline__ int lds_byte(int r, int c) { const int st = (r >> 4) * 2 + (c >> 5), rr = r & 15, cc = c & 31, ob = rr * 64 + cc * 2; return st * 1024 + (ob ^ (((ob >> 9) & 1) << 5)); }
__host__ __device__ __forceinline__ void stage_rc(int b, int& R, int& C) { const int st = b / 1024, sb = b % 1024, swz = sb ^ (((sb >> 9) & 1) << 5); R = (st >> 1) * 16 + swz / 64; C = (st & 1) * 32 + (swz % 64) / 2; }
__host__ __device__ __forceinline__ int perm32(int rho) { const int n = rho >> 4, i = rho & 15; return 8 * (i >> 2) + 4 * n + (i & 3); }

struct Unit { int pm, pn; };
struct Gemm { const bf16_t* A; const bf16_t* Bt; int M, N, K; };

struct StaticOrder {
    int nM, nN, nwg, G, c, wgm;
    __host__ __device__ void init(int M, int N, int G_, int c_, int wgm_ = WGM) { nM = M / BM; nN = N / BM; nwg = nM * nN; G = G_; c = c_; wgm = wgm_; }
    __host__ __device__ bool next(int i, Unit& u) const { return unit_of((long)i * G + c, u); }
    __host__ __device__ bool unit_of(long L, Unit& u) const {
        if (L >= nwg) return false;
        int wgid = (int)L; { const int q = nwg / NXCD, r = nwg % NXCD, xcd = wgid % NXCD, off = wgid / NXCD; wgid = (xcd < r ? xcd * (q + 1) : r * (q + 1) + (xcd - r) * q) + off; }
        const int nig = wgm * nN, gid = wgid / nig, fm = gid * wgm, gsz = (nM - fm) < wgm ? (nM - fm) : wgm;
        u.pm = fm + ((wgid % nig) % gsz); u.pn = (wgid % nig) / gsz; return true;
    }
    __device__ __forceinline__ void a_ready(const Unit&) const {}
    __device__ __forceinline__ void done(const Unit&) const {}
};
__device__ __forceinline__ unsigned cvt_pk_bf16(float lo, float hi) { unsigned r; asm volatile("v_cvt_pk_bf16_f32 %0, %1, %2" : "=v"(r) : "v"(lo), "v"(hi)); return r; }
constexpr int DM = 2048, DFF = 5632;
constexpr float RMS_EPS = 1e-6f;
typedef unsigned long long ss_t;
constexpr float SS_SCALE = 16777216.0f;
__device__ __forceinline__ float rs_from_ss(ss_t ss) { return __builtin_amdgcn_rsqf((float)ss * (1.0f / ((float)DM * SS_SCALE)) + RMS_EPS); }
__device__ __forceinline__ float silu_f(float x) { return x * __builtin_amdgcn_rcpf(1.0f + __builtin_amdgcn_exp2f(x * -1.4426950408889634f)); }
__device__ __forceinline__ u32x4 pack8(const f32x4 a, const f32x4 b) { u32x4 w; w.x = cvt_pk_bf16(a[0], a[1]); w.y = cvt_pk_bf16(a[2], a[3]); w.z = cvt_pk_bf16(b[0], b[1]); w.w = cvt_pk_bf16(b[2], b[3]); return w; }

#ifndef EPI_WT
#define EPI_WT 0
#endif
template <typename V> __device__ __forceinline__ void st16(void* p, const V v) {
#if EPI_WT
    asm volatile("global_store_dwordx4 %0, %1, off sc1\n\ts_nop 1" :: "v"(p), "v"(v) : "memory");
#else
    *(V*)p = v;
#endif
}
struct SsOrder : StaticOrder {
    const ss_t* ss; PG8_LAS unsigned char* raw; mutable int k;
    __device__ __forceinline__ void a_ready(const Unit& u) const {
        int t_ = threadIdx.x; asm volatile("" : "+v"(t_));
        const int wid = __builtin_amdgcn_readfirstlane(t_ >> 6), lane = t_ & 63;
        __builtin_amdgcn_global_load_lds((const unsigned*)(ss + u.pm * BM + wid * 32) + lane, (PG8_LAS unsigned*)(raw + (k & 1) * 2048 + wid * 256), 4, 0, 0);
        ++k;
    }
    __device__ __forceinline__ void done(const Unit&) const {}
};
struct DynSsOrder : SsOrder {
    unsigned* ctr; PG8_LAS int* mbox; int x, nper, base; bool dyn; mutable unsigned pend;
    __device__ __forceinline__ void init_dyn(unsigned* ctr_all, PG8_LAS int* mbox_) {
        dyn = (G % NXCD == 0) && (nwg % NXCD == 0); x = c % NXCD; nper = nwg / NXCD; base = 2 * (G / NXCD); ctr = ctr_all + 64 * x; mbox = mbox_; pend = 0u;
    }
    __device__ __forceinline__ bool next(int i, Unit& u) const {
        bool ok;
        if (!dyn || i < 2) ok = unit_of((long)i * G + c, u);
        else { const int m = base + __builtin_amdgcn_readfirstlane(mbox[i & 1]); ok = (m < nper) && unit_of((long)m * NXCD + x, u); }
        if (dyn && i >= 1 && threadIdx.x == 0) pend = __hip_atomic_fetch_add(ctr, 1u, __ATOMIC_RELAXED, __HIP_MEMORY_SCOPE_AGENT);
        return ok;
    }
    __device__ __forceinline__ void a_ready(const Unit& u) const {
        if (dyn && k >= 1 && threadIdx.x == 0) mbox[(k + 1) & 1] = (int)pend;
        SsOrder::a_ready(u);
    }
};
struct EpiSwiglu {
    static constexpr bool PERM = true, AFTER_DRAIN = false;
    bf16_t* H; PG8_LAS const unsigned char* raw;
    __device__ __forceinline__ void operator()(const f32x4 (&acc)[2][2][4][2], const Unit& u, int wr, int wc, int fr_in, int fq_in, int slot) const {
        int fr = fr_in, fq = fq_in; asm volatile("" : "+v"(fr), "+v"(fq));
        const int row0 = u.pm * BM + wr * 64 + fr, col0 = u.pn * HALF + wc * 32 + 8 * fq;
#pragma unroll
        for (int ai = 0; ai < 2; ++ai)
#pragma unroll
            for (int m = 0; m < 4; ++m) { const int r = row0 + ai * HALF + m * 16; const float rs = rs_from_ss(*(PG8_LAS const ss_t*)(raw + slot * 2048 + (wr * 64 + fr + ai * HALF + m * 16) * 8));
                f32x4 h[2];
#pragma unroll
                for (int n = 0; n < 2; ++n) { const f32x4 g = acc[ai][0][m][n] * rs, v = acc[ai][1][m][n] * rs;
                    h[n] = (f32x4){silu_f(g[0]) * v[0], silu_f(g[1]) * v[1], silu_f(g[2]) * v[2], silu_f(g[3]) * v[3]}; }
                st16(H + (size_t)r * DFF + col0, pack8(h[0], h[1])); }
    }
};
struct EpiPlain {
    static constexpr bool PERM = true, AFTER_DRAIN = false;
    bf16_t* O; int ldc; PG8_LAS const unsigned char* raw;
    int rope_tiles, k_tile0; const float* qg; const float* kg; const float* rt; PG8_LAS float* hs;
    __device__ __forceinline__ void operator()(const f32x4 (&acc)[2][2][4][2], const Unit& u, int wr, int wc, int fr_in, int fq_in, int slot) const {
        int fr = fr_in, fq = fq_in; asm volatile("" : "+v"(fr), "+v"(fq));
        const int row0 = u.pm * BM + wr * 64 + fr, col0 = u.pn * BM + wc * 32 + 8 * fq;
        if (u.pn >= rope_tiles) {
#pragma unroll
            for (int ai = 0; ai < 2; ++ai)
#pragma unroll
                for (int m = 0; m < 4; ++m) { const int r = row0 + ai * HALF + m * 16; const float rs = rs_from_ss(*(PG8_LAS const ss_t*)(raw + slot * 2048 + (wr * 64 + fr + ai * HALF + m * 16) * 8)); bf16_t* rowp = O + (size_t)r * ldc + col0;
#pragma unroll
                    for (int bj = 0; bj < 2; ++bj) *(u32x4*)(rowp + bj * HALF) = pack8(acc[ai][bj][m][0] * rs, acc[ai][bj][m][1] * rs); }
            return;
        }
#pragma unroll
        for (int ai = 0; ai < 2; ++ai)
#pragma unroll
            for (int m = 0; m < 4; ++m) { const int rl = wr * 64 + fr + ai * HALF + m * 16; const float rs = rs_from_ss(*(PG8_LAS const ss_t*)(raw + slot * 2048 + rl * 8));
#pragma unroll
                for (int bj = 0; bj < 2; ++bj) { const f32x4 a = acc[ai][bj][m][0] * rs, b = acc[ai][bj][m][1] * rs;
                    float q = (a[0] * a[0] + a[1] * a[1]) + (a[2] * a[2] + a[3] * a[3]) + (b[0] * b[0] + b[1] * b[1]) + (b[2] * b[2] + b[3] * b[3]);
                    q += __shfl_xor(q, 16); q += __shfl_xor(q, 32);
                    if (fq == 0) hs[(rl * 2 + bj) * 4 + wc] = q; } }
        asm volatile("s_waitcnt lgkmcnt(0)" ::: "memory"); __builtin_amdgcn_s_barrier(); asm volatile("" ::: "memory");
        int l7 = (4 * wc + fq) & 7; asm volatile("" : "+v"(l7));
        const int hh = wc >> 1;
        const float* g = (u.pn >= k_tile0) ? kg : qg;
        const f32x4 ga = *(const f32x4*)(g + 64 * hh + 4 * l7), gb = *(const f32x4*)(g + 64 * hh + 32 + 4 * l7);
        const float* ctab = rt + (hh ? 8192 : 0) + 4 * l7; const int sinoff = hh ? 2048 : 4096;
#pragma unroll
        for (int ai = 0; ai < 2; ++ai)
#pragma unroll
            for (int m = 0; m < 4; ++m) { const int rl = wr * 64 + fr + ai * HALF + m * 16, r = u.pm * BM + rl; const float rs = rs_from_ss(*(PG8_LAS const ss_t*)(raw + slot * 2048 + rl * 8));
                const int pos = hh ? (r & 63) : (r >> 6);
                const f32x4 cs = *(const f32x4*)(ctab + pos * 32), sn = *(const f32x4*)(ctab + sinoff + pos * 32);
                bf16_t* rowp = O + (size_t)r * ldc + col0;
#pragma unroll
                for (int bj = 0; bj < 2; ++bj) { const f32x4 p4 = *(PG8_LAS const f32x4*)(hs + (rl * 2 + bj) * 4);
                    const float rh = __builtin_amdgcn_rsqf(((p4[0] + p4[1]) + (p4[2] + p4[3])) * (1.0f / 128.0f) + RMS_EPS) * rs;
                    const f32x4 x1 = acc[ai][bj][m][0] * rh * ga, x2 = acc[ai][bj][m][1] * rh * gb;
                    *(u32x4*)(rowp + bj * HALF) = pack8(x1 * cs - x2 * sn, x2 * cs + x1 * sn); }
                if (m & 1) asm volatile("" ::: "memory"); }
    }
};
__device__ __forceinline__ float bfl(unsigned w) { return __builtin_bit_cast(float, w << 16); }
__device__ __forceinline__ float bfh(unsigned w) { return __builtin_bit_cast(float, w & 0xffff0000u); }
struct EpiResid {
    static constexpr bool PERM = true, AFTER_DRAIN = false;
    bf16_t* xb; ss_t* ssn; float alpha;
    __device__ __forceinline__ void operator()(const f32x4 (&acc)[2][2][4][2], const Unit& u, int wr, int wc, int fr_in, int fq_in, int) const {
        int fr = fr_in, fq = fq_in; asm volatile("" : "+v"(fr), "+v"(fq));
        const int row0 = u.pm * BM + wr * 64 + fr, col0 = u.pn * BM + wc * 32 + 8 * fq;
        u32x4 bv[2][4][2];
#pragma unroll
        for (int ai = 0; ai < 2; ++ai)
#pragma unroll
            for (int m = 0; m < 4; ++m) { const size_t off = (size_t)(row0 + ai * HALF + m * 16) * DM + col0;
#pragma unroll
                for (int bj = 0; bj < 2; ++bj) bv[ai][m][bj] = *(const u32x4*)(xb + off + bj * HALF); }
#pragma unroll
        for (int ai = 0; ai < 2; ++ai)
#pragma unroll
            for (int m = 0; m < 4; ++m) { const int r = row0 + ai * HALF + m * 16; const size_t off = (size_t)r * DM + col0; float q = 0.f;
#pragma unroll
                for (int bj = 0; bj < 2; ++bj) { const u32x4 b = bv[ai][m][bj];
                    const f32x4 x0 = (f32x4){bfl(b.x), bfh(b.x), bfl(b.y), bfh(b.y)} + acc[ai][bj][m][0] * alpha, x1 = (f32x4){bfl(b.z), bfh(b.z), bfl(b.w), bfh(b.w)} + acc[ai][bj][m][1] * alpha;
                    const u32x4 w = pack8(x0, x1);
                    *(u32x4*)(xb + off + bj * HALF) = w;
                    const float r0 = bfl(w.x), r1 = bfh(w.x), r2 = bfl(w.y), r3 = bfh(w.y), r4 = bfl(w.z), r5 = bfh(w.z), r6 = bfl(w.w), r7 = bfh(w.w);
                    q += (r0 * r0 + r1 * r1) + (r2 * r2 + r3 * r3) + (r4 * r4 + r5 * r5) + (r6 * r6 + r7 * r7); }
                q += __shfl_xor(q, 16); q += __shfl_xor(q, 32);
                if (fq == 0) __hip_atomic_fetch_add(ssn + r, (ss_t)(q * SS_SCALE), __ATOMIC_RELAXED, __HIP_MEMORY_SCOPE_AGENT); }
    }
};

template <class Epi, class Sched, bool ALIGN_EPI = false, bool SP2 = false>
__device__ __forceinline__ void gemm_phase(PG8_LAS unsigned char* lds, const Gemm g, const Sched& S, const Epi& E) {
    int tid_ = threadIdx.x; asm volatile("" : "+v"(tid_));
    const int tid = tid_, wid = __builtin_amdgcn_readfirstlane(tid >> 6), lane = tid & 63, wr = wid >> 2, wc = wid & 3, fr = lane & 15, fq = lane >> 4;
    const int K = g.K, nt = K / BK;
    unsigned voffA[2], voffB[2];
#pragma unroll
    for (int i = 0; i < 2; ++i) { int R, C; stage_rc(tid * 16 + i * 8192, R, C); const int Rb = Epi::PERM ? ((R & ~31) + perm32(R & 31)) : R;
        voffA[i] = (unsigned)(R * K + C) * 2u; voffB[i] = (unsigned)(Rb * K + C) * 2u; }
    const size_t kstep = (size_t)(BK * 2);
    const size_t hstep = (size_t)HALF * K * 2;
    const size_t tstep = 2 * hstep;
    const unsigned ldsw = (unsigned)wid * 1024u;
    const int aoff = lds_byte(wr * 64 + fr, fq * 8), boff = lds_byte(wc * 32 + fr, fq * 8);
#define PG8_SA(b, h) (((b) * 2 + (h)) * HTB)
#define PG8_SB(b, h) ((4 + (b) * 2 + (h)) * HTB)
#define PG8_STAGE(bufoff, gbase, voff) do { _Pragma("unroll") for (int _i = 0; _i < 2; ++_i) \
        __builtin_amdgcn_global_load_lds((const unsigned*)((const char*)(gbase) + (voff)[_i]), (PG8_LAS unsigned*)(lds + (bufoff) + ldsw + _i * 8192), 16, 0, 0); } while (0)
#define PG8_LDA(dst, b, h) do { _Pragma("unroll") for (int m = 0; m < 4; ++m) _Pragma("unroll") for (int k = 0; k < 2; ++k) dst[m][k] = *(const PG8_LAS bf16x8*)(lds + PG8_SA(b, h) + aoff + m * 2048 + k * 1024); } while (0)
#define PG8_LDB(dst, b, h) do { _Pragma("unroll") for (int n = 0; n < 2; ++n) _Pragma("unroll") for (int k = 0; k < 2; ++k) dst[n][k] = *(const PG8_LAS bf16x8*)(lds + PG8_SB(b, h) + boff + n * 2048 + k * 1024); } while (0)
#define PG8_MMA(ai, bj, At, Bt) do { __builtin_amdgcn_s_setprio(1); _Pragma("unroll") for (int m = 0; m < 4; ++m) _Pragma("unroll") for (int n = 0; n < 2; ++n) _Pragma("unroll") for (int k = 0; k < 2; ++k) \
        acc[ai][bj][m][n] = __builtin_amdgcn_mfma_f32_16x16x32_bf16(Bt[n][k], At[m][k], acc[ai][bj][m][n], 0, 0, 0); __builtin_amdgcn_s_setprio(0); } while (0)
#define PG8_WAIT_V(n) asm volatile("s_waitcnt vmcnt(" #n ")" ::: "memory")
#define PG8_WAIT_L(n) asm volatile("s_waitcnt lgkmcnt(" #n ")" ::: "memory")
#define PG8_BAR __builtin_amdgcn_s_barrier()
#define PG8_SCHED __builtin_amdgcn_sched_barrier(0)
    Unit cur, nxt; int ui = 0;
    if (!S.next(0, cur)) return;
    f32x4 acc[2][2][4][2];
#pragma unroll
    for (int a = 0; a < 2; ++a)
#pragma unroll
        for (int b = 0; b < 2; ++b)
#pragma unroll
            for (int m = 0; m < 4; ++m)
#pragma unroll
                for (int n = 0; n < 2; ++n) acc[a][b][m][n] = (f32x4){0.f, 0.f, 0.f, 0.f};
    bf16x8 At[4][2], B0[2][2], B1[2][2];
    const char* cA = (const char*)g.A + (size_t)cur.pm * tstep; const char* cB = (const char*)g.Bt + (size_t)cur.pn * tstep;
    S.a_ready(cur);
    if constexpr (SP2) {
        PG8_STAGE(PG8_SB(0, 0), cB, voffB); PG8_STAGE(PG8_SB(0, 1), cB + hstep, voffB); PG8_STAGE(PG8_SA(0, 0), cA, voffA); PG8_STAGE(PG8_SA(0, 1), cA + hstep, voffA);
        if (wr == 1) PG8_BAR;
        PG8_WAIT_V(2); PG8_BAR;
        PG8_STAGE(PG8_SB(1, 0), cB + kstep, voffB); PG8_STAGE(PG8_SA(1, 0), cA + kstep, voffA); PG8_STAGE(PG8_SB(1, 1), cB + hstep + kstep, voffB);
        PG8_WAIT_V(6); PG8_BAR;
    } else {
        PG8_STAGE(PG8_SB(0, 0), cB, voffB); PG8_STAGE(PG8_SA(0, 0), cA, voffA); PG8_STAGE(PG8_SB(0, 1), cB + hstep, voffB); PG8_STAGE(PG8_SA(0, 1), cA + hstep, voffA);
        if (wr == 1) PG8_BAR;
        PG8_WAIT_V(4); PG8_BAR;
        PG8_STAGE(PG8_SB(1, 0), cB + kstep, voffB); PG8_STAGE(PG8_SA(1, 0), cA + kstep, voffA); PG8_STAGE(PG8_SB(1, 1), cB + hstep + kstep, voffB);
        PG8_WAIT_V(6); PG8_BAR;
    }
    for (;;) {
        const bool has_next = S.next(ui + 1, nxt);
        const char* nA = has_next ? (const char*)g.A + (size_t)nxt.pm * tstep : cA; const char* nB = has_next ? (const char*)g.Bt + (size_t)nxt.pn * tstep : cB;
        for (int t = 0; t < nt; t += 2) {
            const bool last = (t == nt - 2);
            const char* a1 = cA + (size_t)(t + 1) * kstep;
            const char* a2 = last ? nA : cA + (size_t)(t + 2) * kstep; const char* b2 = last ? nB : cB + (size_t)(t + 2) * kstep;
            const char* a3 = a2 + kstep; const char* b3 = b2 + kstep;
            if (last && has_next) S.a_ready(nxt);
            if constexpr (SP2) {
            PG8_LDB(B0, 0, 0); PG8_LDB(B1, 0, 1); PG8_SCHED; PG8_LDA(At, 0, 0); PG8_STAGE(PG8_SA(1, 1), a1 + hstep, voffA);
            PG8_WAIT_V(8); PG8_WAIT_L(0); PG8_BAR; PG8_MMA(0, 0, At, B0); PG8_MMA(0, 1, At, B1); PG8_BAR; PG8_SCHED;
            PG8_LDA(At, 0, 1); PG8_STAGE(PG8_SB(0, 0), b2, voffB); PG8_STAGE(PG8_SB(0, 1), b2 + hstep, voffB); PG8_STAGE(PG8_SA(0, 0), a2, voffA);
            PG8_WAIT_V(8); PG8_WAIT_L(0); PG8_BAR; PG8_MMA(1, 0, At, B0); PG8_MMA(1, 1, At, B1); PG8_BAR; PG8_SCHED;
            PG8_LDB(B0, 1, 0); PG8_LDB(B1, 1, 1); PG8_SCHED; PG8_LDA(At, 1, 0); PG8_STAGE(PG8_SA(0, 1), a2 + hstep, voffA);
            PG8_WAIT_V(8); PG8_WAIT_L(0); PG8_BAR; PG8_MMA(0, 0, At, B0); PG8_MMA(0, 1, At, B1); PG8_BAR; PG8_SCHED;
            PG8_LDA(At, 1, 1); PG8_STAGE(PG8_SB(1, 0), b3, voffB); PG8_STAGE(PG8_SB(1, 1), b3 + hstep, voffB); PG8_STAGE(PG8_SA(1, 0), a3, voffA);
            PG8_WAIT_V(8); PG8_WAIT_L(0); PG8_BAR; PG8_MMA(1, 0, At, B0); PG8_MMA(1, 1, At, B1); PG8_BAR; PG8_SCHED;
            } else {
            PG8_LDB(B0, 0, 0); PG8_SCHED; PG8_LDA(At, 0, 0); PG8_STAGE(PG8_SA(1, 1), a1 + hstep, voffA);
            PG8_WAIT_L(8); PG8_BAR; PG8_WAIT_L(0); PG8_MMA(0, 0, At, B0); PG8_BAR; PG8_SCHED;
            PG8_LDB(B1, 0, 1); PG8_STAGE(PG8_SB(0, 0), b2, voffB);
            PG8_BAR; PG8_WAIT_L(0); PG8_MMA(0, 1, At, B1); PG8_BAR;
            PG8_LDA(At, 0, 1); PG8_STAGE(PG8_SA(0, 0), a2, voffA);
            PG8_BAR; PG8_WAIT_L(0); PG8_MMA(1, 0, At, B0); PG8_BAR; PG8_SCHED;
            PG8_STAGE(PG8_SB(0, 1), b2 + hstep, voffB);
            PG8_WAIT_V(6); PG8_BAR; PG8_MMA(1, 1, At, B1); PG8_BAR;
            PG8_LDB(B0, 1, 0); PG8_SCHED; PG8_LDA(At, 1, 0); PG8_STAGE(PG8_SA(0, 1), a2 + hstep, voffA);
            PG8_WAIT_L(8); PG8_BAR; PG8_WAIT_L(0); PG8_MMA(0, 0, At, B0); PG8_BAR; PG8_SCHED;
            PG8_LDB(B1, 1, 1); PG8_STAGE(PG8_SB(1, 0), b3, voffB);
            PG8_BAR; PG8_WAIT_L(0); PG8_MMA(0, 1, At, B1); PG8_BAR;
            PG8_LDA(At, 1, 1); PG8_STAGE(PG8_SA(1, 0), a3, voffA);
            PG8_BAR; PG8_WAIT_L(0); PG8_MMA(1, 0, At, B0); PG8_BAR; PG8_SCHED;
            PG8_STAGE(PG8_SB(1, 1), b3 + hstep, voffB);
            PG8_WAIT_V(6); PG8_BAR; PG8_MMA(1, 1, At, B1); PG8_BAR;
            }
        }
        if constexpr (ALIGN_EPI) { if (wr == 0) PG8_BAR; }
        if constexpr (!Epi::AFTER_DRAIN) { E(acc, cur, wr, wc, fr, fq, ui & 1); S.done(cur); }
        if (!has_next) break;
#pragma unroll
        for (int a = 0; a < 2; ++a)
#pragma unroll
            for (int b = 0; b < 2; ++b)
#pragma unroll
                for (int m = 0; m < 4; ++m)
#pragma unroll
                    for (int n = 0; n < 2; ++n) acc[a][b][m][n] = (f32x4){0.f, 0.f, 0.f, 0.f};
        cur = nxt; cA = nA; cB = nB; ++ui;
        if constexpr (ALIGN_EPI) { if (wr == 1) PG8_BAR; }
    }
    PG8_WAIT_V(0);
    if constexpr (!ALIGN_EPI) { if (wr == 0) PG8_BAR; }
    PG8_BAR;
    if constexpr (Epi::AFTER_DRAIN) { E.fused(acc, cur, wr, wc, fr, fq, lds, wid, lane); S.done(cur); }
#undef PG8_SA
#undef PG8_SB
#undef PG8_STAGE
#undef PG8_LDA
#undef PG8_LDB
#undef PG8_MMA
#undef PG8_WAIT_V
#undef PG8_WAIT_L
#undef PG8_BAR
#undef PG8_SCHED
}
}
namespace att {
using bf16 = __hip_bfloat16;
constexpr int   D = 128, NW = 8, QBLK = 32, KVBLK = 64;
constexpr float SCALE = 0.088388347648318440f;
constexpr float THR = 8.f;
constexpr int   SDEPTH = 2;
constexpr int   LDQ = 3072, LDK = 3072, LDO = 2048;
constexpr size_t SHM_V = KVBLK * D * 2, SHM_K = KVBLK * D * 2, SHM_ATTN = 2 * SHM_V + 2 * SHM_K + NW * 64 * 4;
using bf16x8 = __attribute__((ext_vector_type(8))) short;
using s16x4  = __attribute__((ext_vector_type(4))) short;
using f32x16 = __attribute__((ext_vector_type(16))) float;
using u32x4  = __attribute__((ext_vector_type(4))) unsigned;
#define KSWZ(row, colB) ((row) * 256 + ((colB) ^ (((row) & 7) << 4)))
#define SBAR() __builtin_amdgcn_sched_barrier(0)
__device__ __forceinline__ int crow(int r, int hi) { return (r & 3) + 8 * (r >> 2) + 4 * hi; }
__device__ __forceinline__ unsigned cvtpk(float lo, float hi) {
  unsigned r; asm volatile("v_cvt_pk_bf16_f32 %0, %1, %2" : "=v"(r) : "v"(lo), "v"(hi)); return r;
}

__device__ __forceinline__ void partialSM(f32x16& p0, f32x16& p1, float& m_reg, float& mn, float& alpha) {
  constexpr float C = SCALE * 1.4426950408889634f;
  float pmax = p0[0]; for (int r = 1; r < 16; ++r) pmax = fmaxf(pmax, p0[r]); for (int r = 0; r < 16; ++r) pmax = fmaxf(pmax, p1[r]);
  { auto rr = __builtin_amdgcn_permlane32_swap(__float_as_uint(pmax), __float_as_uint(pmax), false, false);
    pmax = fmaxf(__uint_as_float(rr[0]), __uint_as_float(rr[1])); }
  if (__builtin_expect(__all(pmax - m_reg <= THR / SCALE), 1)) { mn = m_reg; alpha = 1.f; }
  else { mn = fmaxf(m_reg, pmax); alpha = __builtin_amdgcn_exp2f((m_reg - mn) * C); m_reg = mn; }
  float mnC = -mn * C;
  for (int r = 0; r < 16; ++r) p0[r] = fmaf(p0[r], C, mnC); for (int r = 0; r < 16; ++r) p1[r] = fmaf(p1[r], C, mnC);
  for (int r = 0; r < 16; ++r) p0[r] = __builtin_amdgcn_exp2f(p0[r]);
}
__device__ __forceinline__ void finishSM(f32x16& p0, f32x16& p1, float alpha, float& l_reg, bf16x8& pa0, bf16x8& pa1, bf16x8& pa2, bf16x8& pa3) {
  for (int r = 0; r < 16; ++r) p1[r] = __builtin_amdgcn_exp2f(p1[r]);
  float ps = 0; for (int r = 0; r < 16; ++r) ps += p0[r]; for (int r = 0; r < 16; ++r) ps += p1[r];
  { auto rr = __builtin_amdgcn_permlane32_swap(__float_as_uint(ps), __float_as_uint(ps), false, false);
    ps = __uint_as_float(rr[0]) + __uint_as_float(rr[1]); }
  l_reg = l_reg * alpha + ps;
#define PK4(P, BASE, OUT) do { unsigned a0 = cvtpk(P[BASE + 0], P[BASE + 1]), a1 = cvtpk(P[BASE + 2], P[BASE + 3]);   \
    unsigned b0 = cvtpk(P[BASE + 4], P[BASE + 5]), b1 = cvtpk(P[BASE + 6], P[BASE + 7]);                              \
    auto r0 = __builtin_amdgcn_permlane32_swap(a0, b0, false, false); auto r1 = __builtin_amdgcn_permlane32_swap(a1, b1, false, false); \
    u32x4 w = {r0[0], r1[0], r0[1], r1[1]}; OUT = *reinterpret_cast<bf16x8*>(&w); } while (0)
  PK4(p0, 0, pa0); PK4(p0, 8, pa1); PK4(p1, 0, pa2); PK4(p1, 8, pa3);
#undef PK4
}
__device__ __forceinline__ void qkt(f32x16& p0, f32x16& p1, const bf16* Ks, const bf16x8* qr, int r32, int hi) {
  p0 = f32x16{}; p1 = f32x16{};
  for (int d0 = 0; d0 < 8; ++d0) { int cb = (d0 * 16 + hi * 8) * 2;
    bf16x8 b0 = *reinterpret_cast<const bf16x8*>((const char*)Ks + KSWZ(r32, cb));
    bf16x8 b1 = *reinterpret_cast<const bf16x8*>((const char*)Ks + KSWZ(32 + r32, cb));
    p0 = __builtin_amdgcn_mfma_f32_32x32x16_bf16(b0, qr[d0], p0, 0, 0, 0);
    p1 = __builtin_amdgcn_mfma_f32_32x32x16_bf16(b1, qr[d0], p1, 0, 0, 0); }
}
__device__ __forceinline__ int v_st(int k, int c) { const int kk = (k & ~0xC) | ((k & 4) << 1) | ((k & 8) >> 1); return ((kk >> 3) * 4 + (c >> 5)) * 512 + ((kk & 7) * 32 + (c & 31)) * 2; }
__device__ __forceinline__ int v_rd_base(int lane) { return ((lane & 3) << 3) | (((lane >> 2) & 3) << 6) | (((lane >> 4) & 1) << 5) | (((lane >> 5) & 1) << 8); }
constexpr int v_rd_off(int d0, int ks, int half) { return d0 * 512 + ks * 4096 + half * 2048; }
template <int OFF> __device__ __forceinline__ s16x4 tr_read(int vb) {
  s16x4 r; asm volatile("ds_read_b64_tr_b16 %0, %1 offset:%2" : "=&v"(r) : "v"(vb), "i"(OFF) : "memory"); return r;
}
template <int D0> __device__ __forceinline__ void pv_one(f32x16& od, int vb, bf16x8 pa0, bf16x8 pa1, bf16x8 pa2, bf16x8 pa3) {
  const s16x4 l0 = tr_read<v_rd_off(D0, 0, 0)>(vb), h0 = tr_read<v_rd_off(D0, 0, 1)>(vb), l1 = tr_read<v_rd_off(D0, 1, 0)>(vb), h1 = tr_read<v_rd_off(D0, 1, 1)>(vb);
  const s16x4 l2 = tr_read<v_rd_off(D0, 2, 0)>(vb), h2 = tr_read<v_rd_off(D0, 2, 1)>(vb), l3 = tr_read<v_rd_off(D0, 3, 0)>(vb), h3 = tr_read<v_rd_off(D0, 3, 1)>(vb);
  asm volatile("s_waitcnt lgkmcnt(0)" ::: "memory"); SBAR();
#define PK(L, H) (bf16x8){L[0], L[1], L[2], L[3], H[0], H[1], H[2], H[3]}
  od = __builtin_amdgcn_mfma_f32_32x32x16_bf16(pa0, PK(l0, h0), od, 0, 0, 0);
  od = __builtin_amdgcn_mfma_f32_32x32x16_bf16(pa1, PK(l1, h1), od, 0, 0, 0);
  od = __builtin_amdgcn_mfma_f32_32x32x16_bf16(pa2, PK(l2, h2), od, 0, 0, 0);
  od = __builtin_amdgcn_mfma_f32_32x32x16_bf16(pa3, PK(l3, h3), od, 0, 0, 0);
#undef PK
}
__device__ __forceinline__ void pv_d0(f32x16* o, int vb, bf16x8 pa0, bf16x8 pa1, bf16x8 pa2, bf16x8 pa3) {
  pv_one<0>(o[0], vb, pa0, pa1, pa2, pa3); pv_one<1>(o[1], vb, pa0, pa1, pa2, pa3); pv_one<2>(o[2], vb, pa0, pa1, pa2, pa3); pv_one<3>(o[3], vb, pa0, pa1, pa2, pa3);
}
__device__ __forceinline__ void attn_dense_body(const bf16* __restrict__ Qb, const bf16* __restrict__ Kh, const bf16* __restrict__ Vh, bf16* __restrict__ Ob, int seq, char* lds) {
  int tid_ = threadIdx.x; asm volatile("" : "+v"(tid_));
  const int tid = tid_, wid = tid >> 6, lane = tid & 63, r32 = lane & 31, hi = lane >> 5;
  bf16* V_lds = (bf16*)lds; bf16* K_lds = (bf16*)(lds + 2 * SHM_V);
  float* ws = (float*)(lds + 2 * SHM_V + 2 * SHM_K) + wid * 64; float* li_l = ws; float* al_l = ws + 32;
  float m_reg = -1e30f, l_reg = 0; f32x16 o[4] = {}; bf16x8 qr[8];
  const bf16* Qw = Qb + (long)(wid * QBLK + r32) * LDQ + hi * 8;
#pragma unroll
  for (int d0 = 0; d0 < 8; ++d0) qr[d0] = *reinterpret_cast<const bf16x8*>(Qw + d0 * 16);
  const int sr = tid >> 4, sc = (tid & 15) * 8, vst0 = v_st(sr, sc), vst1 = v_st(32 + sr, sc);
  const int vb0 = (int)(uintptr_t)V_lds + v_rd_base(lane);
  struct { bf16x8 vs0, vs1, ks0, ks1; } sr_[SDEPTH];
#define SLOAD(i, k0) do { sr_[i].vs0 = *reinterpret_cast<const bf16x8*>(&Vh[(long)((k0) + sr) * LDK + sc]); sr_[i].vs1 = *reinterpret_cast<const bf16x8*>(&Vh[(long)((k0) + 32 + sr) * LDK + sc]); \
    sr_[i].ks0 = *reinterpret_cast<const bf16x8*>(&Kh[(long)((k0) + sr) * LDK + sc]); sr_[i].ks1 = *reinterpret_cast<const bf16x8*>(&Kh[(long)((k0) + 32 + sr) * LDK + sc]); } while (0)
#define SWRITE(b, i) do { *(bf16x8*)((char*)V_lds + (b) * SHM_V + vst0) = sr_[i].vs0;          \
    *(bf16x8*)((char*)V_lds + (b) * SHM_V + vst1) = sr_[i].vs1; int kc = sc * 2;               \
    *(bf16x8*)((char*)K_lds + (b) * SHM_K + KSWZ(sr, kc)) = sr_[i].ks0;                       \
    *(bf16x8*)((char*)K_lds + (b) * SHM_K + KSWZ(32 + sr, kc)) = sr_[i].ks1; } while (0)
#define SWAIT() do { asm volatile("s_waitcnt vmcnt(4)" ::: "memory"); } while (0)
#define RESC(a) do { if (__any((a) < 1.f)) { if (hi == 0) al_l[r32] = (a); asm volatile("s_waitcnt lgkmcnt(0)" ::: "memory"); \
    for (int d = 0; d < 4; ++d) for (int r = 0; r < 16; ++r) o[d][r] *= al_l[crow(r, hi)]; } } while (0)
  f32x16 pA0, pA1, pB0, pB1; float mnA, mnB, alA, alB; bf16x8 pa0, pa1, pa2, pa3; const int NT = seq / KVBLK;
  constexpr int SE = 0, SO = SDEPTH - 1;
  SLOAD(SE, 0); asm volatile("s_waitcnt vmcnt(0)" ::: "memory"); SWRITE(0, SE); __syncthreads();
  qkt(pA0, pA1, K_lds, qr, r32, hi); partialSM(pA0, pA1, m_reg, mnA, alA);
  SLOAD(SO, KVBLK); if (2 < NT) SLOAD(SE, 2 * KVBLK);
  SWAIT(); SWRITE(1, SO); __syncthreads();
  for (int j = 1; j + 1 < NT; j += 2) {
    SBAR(); qkt(pB0, pB1, (bf16*)((char*)K_lds + SHM_K), qr, r32, hi);
    finishSM(pA0, pA1, alA, l_reg, pa0, pa1, pa2, pa3); SBAR();
    SLOAD(SO, (j + SDEPTH) * KVBLK); SBAR();
    pv_d0(o, vb0, pa0, pa1, pa2, pa3); partialSM(pB0, pB1, m_reg, mnB, alB);
    __syncthreads(); SWAIT(); SWRITE(0, SE);
    RESC(alB); __syncthreads();
    SBAR(); qkt(pA0, pA1, K_lds, qr, r32, hi);
    finishSM(pB0, pB1, alB, l_reg, pa0, pa1, pa2, pa3); SBAR();
    if (j + 3 < NT) SLOAD(SE, (j + 1 + SDEPTH) * KVBLK); SBAR();
    pv_d0(o, vb0 + (int)SHM_V, pa0, pa1, pa2, pa3); partialSM(pA0, pA1, m_reg, mnA, alA);
    __syncthreads(); SWAIT(); SWRITE(1, SO);
    RESC(alA); __syncthreads();
  }
  SBAR(); qkt(pB0, pB1, (bf16*)((char*)K_lds + SHM_K), qr, r32, hi);
  finishSM(pA0, pA1, alA, l_reg, pa0, pa1, pa2, pa3); SBAR();
  pv_d0(o, vb0, pa0, pa1, pa2, pa3); partialSM(pB0, pB1, m_reg, mnB, alB);
  __syncthreads(); RESC(alB);
  finishSM(pB0, pB1, alB, l_reg, pa0, pa1, pa2, pa3); SBAR();
  pv_d0(o, vb0 + (int)SHM_V, pa0, pa1, pa2, pa3);
  if (hi == 0) li_l[r32] = l_reg; asm volatile("s_waitcnt lgkmcnt(0)" ::: "memory");
  float rli[16];
#pragma unroll
  for (int r = 0; r < 16; ++r) rli[r] = __builtin_amdgcn_rcpf(li_l[crow(r, hi)]);
  asm volatile("s_waitcnt vmcnt(0) lgkmcnt(0)" ::: "memory");
  __syncthreads();
  char* ost = lds + wid * 8192;
#pragma unroll
  for (int r = 0; r < 16; r += 2) { const int row_a = crow(r, hi), row_b = crow(r + 1, hi);
#pragma unroll
    for (int d0 = 0; d0 < 4; ++d0) { const unsigned w = cvtpk(o[d0][r] * rli[r], o[d0][r + 1] * rli[r + 1]);
      *(unsigned short*)(ost + row_a * 256 + (d0 * 32 + r32) * 2) = (unsigned short)(w & 0xffffu);
      *(unsigned short*)(ost + row_b * 256 + (d0 * 32 + r32) * 2) = (unsigned short)(w >> 16); } }
  asm volatile("s_waitcnt lgkmcnt(0)" ::: "memory");
  bf16* Ow = Ob + (long)(wid * QBLK) * LDO;
#pragma unroll
  for (int i = 0; i < 8; ++i) { const int idx = lane + 64 * i, row = idx >> 4, c16 = idx & 15;
    const u32x4 v = *(const u32x4*)(ost + row * 256 + c16 * 16); *(u32x4*)(Ow + (long)row * LDO + c16 * 8) = v; }
  asm volatile("s_waitcnt lgkmcnt(0)" ::: "memory");
  __syncthreads();
#undef SLOAD
#undef SWRITE
#undef SWAIT
#undef RESC
}
#undef KSWZ
#undef SBAR
}

constexpr int NWAVES = 8;
#ifndef MK_MULTI
#define MK_MULTI 0
#endif

#ifndef PH_P0
#define PH_P0 1
#endif
#ifndef PH_GU
#define PH_GU 1
#endif
#ifndef PH_PLAIN
#define PH_PLAIN 1
#endif
#ifndef PH_ROPE
#define PH_ROPE 1
#endif
#ifndef PH_ATT
#define PH_ATT 1
#endif
#ifndef PH_REC1
#define PH_REC1 1
#endif
#ifndef PH_REC2
#define PH_REC2 1
#endif
#ifndef PH_RES
#define PH_RES 1
#endif
#ifndef PH_FN
#define PH_FN 1
#endif
#ifndef DUP_P0
#define DUP_P0 1
#endif
#ifndef DUP_GU
#define DUP_GU 1
#endif
#ifndef DUP_PLAIN
#define DUP_PLAIN 1
#endif
#ifndef DUP_ATT
#define DUP_ATT 1
#endif
#ifndef DUP_RES
#define DUP_RES 1
#endif
#ifndef DUP_BAR
#define DUP_BAR 1
#endif
#ifndef DUP_REC
#define DUP_REC 1
#endif
#ifndef GU_CVY
#define GU_CVY 2
#endif
#ifndef GU_CV_NUM
#define GU_CV_NUM 3
#define GU_CV_DEN 4
#endif
#ifndef RES_WGM
#define RES_WGM 8
#endif
constexpr int S = 8192, DM = 2048, DFF = 5632, NGU = 2 * DFF, QKVD = 3072, DRNN = 2048, NFFN = 8, NSB = 12;
constexpr int N_PHASES = 2 + 4 * NSB;
constexpr float NORM_EPS = 1e-6f;

constexpr size_t MiB = 1u << 20;
constexpr size_t WS_CTL = 0, CTL_ZERO_BYTES = 2 * MiB;
constexpr size_t WS_SS = 1 * MiB;
constexpr size_t WS_ROPE = 2 * MiB;
constexpr size_t WS_WG = 3 * MiB;
constexpr size_t WS_AGGS = 7 * MiB;
constexpr size_t WS_AGGC = 15 * MiB;
constexpr size_t WS_WGU = 16 * MiB, SZ_WGU = (size_t)NGU * DM * 2;
constexpr size_t WS_WD = WS_WGU + NFFN * SZ_WGU, SZ_WD = (size_t)DM * DFF * 2;
constexpr size_t WS_WQKV = WS_WD + NFFN * SZ_WD, SZ_WQKV = (size_t)QKVD * DM * 2;
constexpr size_t WS_WO = WS_WQKV + 2 * SZ_WQKV, SZ_WO = (size_t)DM * DM * 2;
constexpr size_t WS_WIN = WS_WO + 2 * SZ_WO, SZ_WIN = (size_t)2 * DRNN * DM * 2;
constexpr size_t WS_WOUT = WS_WIN + 2 * SZ_WIN, SZ_WOUT = (size_t)DM * DRNN * 2;
constexpr size_t WS_XB = WS_WOUT + 2 * SZ_WOUT;
constexpr size_t WS_H = WS_XB + (size_t)S * DM * 2;
constexpr size_t WS_QKV = WS_H + (size_t)S * DFF * 2;
constexpr size_t WS_O = WS_QKV + (size_t)S * QKVD * 2;
constexpr size_t WS_U = WS_O + (size_t)S * DM * 2;
constexpr size_t WS_Y = WS_U + (size_t)S * 2 * DRNN * 2;
constexpr size_t WS_AB = WS_Y + (size_t)S * DRNN * 2;
constexpr size_t WS_END = WS_AB + (size_t)S * DRNN * 2 * 4;
static_assert(WS_WG + 128 * 16384 * 2 <= WS_AGGS && WS_AGGS + 256 * 2 * 2048 * 8 <= WS_AGGC && WS_AGGC + 16 * 2 * 2048 * 8 <= WS_WGU, "small tables do not overlap");
static_assert(WS_SS + 14 * (size_t)S * 8 + 256 <= CTL_ZERO_BYTES, "ss arrays inside the memset region");
static_assert(WS_WGU % 256 == 0 && WS_XB % 256 == 0 && WS_H % 256 == 0 && WS_QKV % 256 == 0 && WS_O % 256 == 0 && WS_U % 256 == 0 && WS_Y % 256 == 0, "alignment");
constexpr int CW_GUQ = 16384;
constexpr int CW_BAR = 4096;

constexpr int RING_OFF = 0, RING_BYTES = 131072;
constexpr int LDSCTL_OFF = RING_BYTES, MISC_OFF = LDSCTL_OFF + 320;
constexpr int MBOX_OFF = LDSCTL_OFF + 512;
constexpr int RSTAB_OFF = LDSCTL_OFF + 1024;
constexpr int HSTAB_OFF = RSTAB_OFF + 4096;
constexpr int LDS_BYTES = 147456;
static_assert(MISC_OFF + 128 <= RSTAB_OFF && HSTAB_OFF + 8192 <= LDS_BYTES, "LDS map");

#define GAS __attribute__((address_space(1)))
#define LAS __attribute__((address_space(3)))
typedef unsigned short bf16;
typedef unsigned v4u __attribute__((ext_vector_type(4)));
typedef float f32x4 __attribute__((ext_vector_type(4)));
typedef short bf16x8 __attribute__((ext_vector_type(8)));
typedef GAS unsigned gu32;
#define RLX_AGENT __ATOMIC_RELAXED, __HIP_MEMORY_SCOPE_AGENT
#define LDS_WAIT() asm volatile("s_waitcnt lgkmcnt(0)" ::: "memory")
#define VM_WAIT() asm volatile("s_waitcnt vmcnt(0)" ::: "memory")
__device__ __forceinline__ unsigned f2bf(float f) { unsigned u = __builtin_bit_cast(unsigned, f); return (u + 0x7fffu + ((u >> 16) & 1u)) >> 16; }
__device__ __forceinline__ unsigned pk2(float lo, float hi) { return f2bf(lo) | (f2bf(hi) << 16); }
__device__ __forceinline__ float bf_lo(unsigned w) { return __builtin_bit_cast(float, w << 16); }
__device__ __forceinline__ float bf_hi(unsigned w) { return __builtin_bit_cast(float, w & 0xffff0000u); }

#define XB_TMO      128
#define XB_XCNT(j)  (256  + 64 * (j))
#define XB_XSUB(j)  (1280 + 64 * (j))
#define XB_XGEN(j)  (2304 + 64 * (j))
#define XB_TOP      3328
#define XB_TOPGEN   3392
#define XCD_BAR_WORDS 3456
#define XB_SPIN_CAP (1u << 18)
#ifndef XB_MID_WB
#define XB_MID_WB 0
#endif

__device__ __forceinline__ unsigned xb_ld(unsigned* p)              { return __hip_atomic_load(p, __ATOMIC_RELAXED, __HIP_MEMORY_SCOPE_AGENT); }
__device__ __forceinline__ unsigned xb_add(unsigned* p, unsigned v) { return __hip_atomic_fetch_add(p, v, __ATOMIC_RELAXED, __HIP_MEMORY_SCOPE_AGENT); }
__device__ __forceinline__ unsigned xb_xcc_id() { return (unsigned)__builtin_amdgcn_s_getreg((3 << 11) | 20) & 0xFu; }
#define XB_SPIN(cond, bar) do { unsigned _sp = 0; while (cond) { __builtin_amdgcn_s_sleep(1); \
    if ((++_sp & 255u) == 0u) { if (xb_ld(&(bar)[XB_TMO])) break; if (_sp > XB_SPIN_CAP) { atomicAdd(&(bar)[XB_TMO], 1u); break; } } } } while (0)

struct XcdBarrier {
    unsigned* bar; unsigned x;
    volatile LAS unsigned* st;
};

__device__ __forceinline__ XcdBarrier xcd_barrier_post(unsigned* bar, volatile LAS unsigned* st) {
    XcdBarrier b; b.bar = bar; b.x = xb_xcc_id(); b.st = st;
    if (threadIdx.x == 0) (void)xb_add(&bar[XB_XCNT(b.x)], 1u);
    return b;
}
__device__ __forceinline__ void xcd_barrier_complete(unsigned* bar, unsigned x, unsigned& nloc, unsigned& nx) {
    const unsigned G = gridDim.x * gridDim.y * gridDim.z;
    unsigned sum, cnt, mine, sp = 0u;
    for (;;) {
        sum = 0u; cnt = 0u; mine = 0u;
#pragma unroll
        for (unsigned j = 0; j < 16; ++j) { const unsigned c = xb_ld(&bar[XB_XCNT(j)]); sum += c; cnt += (c > 0u) ? 1u : 0u; mine = (j == x) ? c : mine; }
        if (sum == G) break;
        __builtin_amdgcn_s_sleep(1);
        if ((++sp & 255u) == 0u) { if (xb_ld(&bar[XB_TMO])) break; if (sp > XB_SPIN_CAP) { atomicAdd(&bar[XB_TMO], 1u); break; } }
    }
    nloc = mine > 0u ? mine : 1u; nx = cnt > 0u ? cnt : 1u;
}

__device__ __forceinline__ void xcd_barrier(const XcdBarrier& b) {
    asm volatile("s_waitcnt vmcnt(0)" ::: "memory");
    __syncthreads();
    if (threadIdx.x == 0) {
        unsigned* bar = b.bar;
        __builtin_amdgcn_s_waitcnt(0);
        unsigned nloc = b.st[0], nx = b.st[1];
        if (nloc == 0u) { xcd_barrier_complete(bar, b.x, nloc, nx); b.st[0] = nloc; b.st[1] = nx; }
        const unsigned old = xb_add(&bar[XB_XSUB(b.x)], 1u);
        const unsigned gen = old / nloc;
#if XB_MID_WB
        if (old - gen * nloc == nloc / 2u) asm volatile("buffer_wbl2 sc1" ::: "memory");
#endif
        if (old + 1u == (gen + 1u) * nloc) {
            __builtin_amdgcn_fence(__ATOMIC_RELEASE, "agent");
            asm volatile("s_waitcnt vmcnt(0)" ::: "memory");
            const unsigned og = xb_add(&bar[XB_TOP], 1u);
            const unsigned tg = og / nx;
            if (og + 1u == (tg + 1u) * nx) xb_add(&bar[XB_TOPGEN], 1u);
            else XB_SPIN(xb_ld(&bar[XB_TOPGEN]) == tg, bar);
            __builtin_amdgcn_fence(__ATOMIC_ACQUIRE, "agent");
            xb_add(&bar[XB_XGEN(b.x)], 1u);
            asm volatile("s_waitcnt vmcnt(0)" ::: "memory");
        } else {
            XB_SPIN(xb_ld(&bar[XB_XGEN(b.x)]) == gen, bar);
            __builtin_amdgcn_fence(__ATOMIC_ACQUIRE, "agent");
            asm volatile("s_waitcnt vmcnt(0)" ::: "memory");
        }
    }
    __syncthreads();
}
#define OPAQUE_LANE() int tid_ = threadIdx.x; asm volatile("" : "+v"(tid_)); const int lane_ = tid_ & 63, wave_ = __builtin_amdgcn_readfirstlane(tid_ >> 6); (void)lane_; (void)wave_
struct Frame {
    LAS unsigned char* lds;
    volatile LAS unsigned* MISC;
    gu32* ctl;
    int tid, lane, wave;
    int vcu, G;
    unsigned char* ws;
    const float* const* in;
};
__device__ __forceinline__ float wave_sum(float v) {
#pragma unroll
    for (int o = 1; o < 64; o <<= 1) v += __shfl_xor(v, o);
    return v;
}
struct CvItem { const char* src; size_t rowstep; const float* gain; bf16* dst; int K, perm; };
__device__ const float CV_ONES[64] = {1.f,1.f,1.f,1.f,1.f,1.f,1.f,1.f,1.f,1.f,1.f,1.f,1.f,1.f,1.f,1.f,1.f,1.f,1.f,1.f,1.f,1.f,1.f,1.f,1.f,1.f,1.f,1.f,1.f,1.f,1.f,1.f,
                                      1.f,1.f,1.f,1.f,1.f,1.f,1.f,1.f,1.f,1.f,1.f,1.f,1.f,1.f,1.f,1.f,1.f,1.f,1.f,1.f,1.f,1.f,1.f,1.f,1.f,1.f,1.f,1.f,1.f,1.f,1.f,1.f};
#ifndef CV_AUX
#define CV_AUX 2
#endif
constexpr int CVB_GAIN = 32 * 264, CVB_BYTES = CVB_GAIN + 256, CV_GROUP = 33;
static_assert(15 * CVB_BYTES <= RING_BYTES && RSTAB_OFF + CVB_BYTES <= LDS_BYTES && CVB_BYTES % 16 == 0 && RSTAB_OFF % 16 == 0, "conversion buffers");
__device__ __forceinline__ CvItem cv_make(const float* W, int K, int N, bf16* WT, const float* gain, int gu_mode, int item, int lane) {
    const int nblk = N / 32, kb = item / nblk, nb = item - kb * nblk, k0 = 64 * kb, n0 = 32 * nb;
    int d0 = n0, perm = 0; if (gu_mode == 1) { const int isu = n0 >= DFF ? 1 : 0, nn = n0 - isu * DFF; d0 = (nn >> 7) * 256 + isu * 128 + (nn & 127); }
    if (gu_mode == 2 && n0 < 2560) { const int d = n0 & 127; d0 = (n0 & ~127) + 64 * (d >> 6) + 4 * ((d >> 5) & 1); perm = 1; }
    CvItem c; c.perm = perm; c.src = (const char*)(W + (size_t)(k0 + (lane >> 5)) * N + n0 + (lane & 31)); c.rowstep = (size_t)8 * N - 264;
    c.gain = (gain ? gain + k0 : CV_ONES) + lane;
    c.dst = WT + (size_t)d0 * K + k0; c.K = K; return c;
}
#define CV16(M) M(0) M(1) M(2) M(3) M(4) M(5) M(6) M(7) M(8) M(9) M(10) M(11) M(12) M(13) M(14) M(15)
__device__ __forceinline__ void cv_issue(const CvItem& c, LAS unsigned char* buf) {
#define CV_LO(i) __builtin_amdgcn_global_load_lds((const unsigned*)(c.src + (size_t)(i) * c.rowstep), (LAS unsigned*)buf, 4, 264 * (i), CV_AUX);
#define CV_HI(i) __builtin_amdgcn_global_load_lds((const unsigned*)(c.src + (size_t)(16 + (i)) * c.rowstep + 16 * 264), (LAS unsigned*)(buf + 16 * 264), 4, 264 * (i), CV_AUX);
    CV16(CV_LO) CV16(CV_HI)
#undef CV_LO
#undef CV_HI
    __builtin_amdgcn_global_load_lds((const unsigned*)c.gain, (LAS unsigned*)(buf + CVB_GAIN), 4, 0, 0);
}
__device__ __forceinline__ void cv_finish(const CvItem& c, LAS unsigned char* buf, int lane) {
    typedef float f2 __attribute__((ext_vector_type(2)));
    const int cc = lane & 7, nq = lane >> 3;
    const unsigned a = (unsigned)(uintptr_t)buf + 4u * (unsigned)(264 * cc + nq), ga = (unsigned)(uintptr_t)buf + (unsigned)(CVB_GAIN + 32 * cc);
    f2 r0, r1, r2, r3, r4, r5, r6, r7, r8, r9, r10, r11, r12, r13, r14, r15; f32x4 g0, g1;
    asm volatile(
        "ds_read2_b32 %0, %18 offset0:0 offset1:32\n\t"
        "ds_read2_b32 %1, %18 offset0:66 offset1:98\n\t"
        "ds_read2_b32 %2, %18 offset0:132 offset1:164\n\t"
        "ds_read2_b32 %3, %18 offset0:198 offset1:230\n\t"
        "ds_read2_b32 %4, %18 offset0:8 offset1:40\n\t"
        "ds_read2_b32 %5, %18 offset0:74 offset1:106\n\t"
        "ds_read2_b32 %6, %18 offset0:140 offset1:172\n\t"
        "ds_read2_b32 %7, %18 offset0:206 offset1:238\n\t"
        "ds_read2_b32 %8, %18 offset0:16 offset1:48\n\t"
        "ds_read2_b32 %9, %18 offset0:82 offset1:114\n\t"
        "ds_read2_b32 %10, %18 offset0:148 offset1:180\n\t"
        "ds_read2_b32 %11, %18 offset0:214 offset1:246\n\t"
        "ds_read2_b32 %12, %18 offset0:24 offset1:56\n\t"
        "ds_read2_b32 %13, %18 offset0:90 offset1:122\n\t"
        "ds_read2_b32 %14, %18 offset0:156 offset1:188\n\t"
        "ds_read2_b32 %15, %18 offset0:222 offset1:254\n\t"
        "ds_read_b128 %16, %19\n\t"
        "ds_read_b128 %17, %19 offset:16\n\t"
        "s_waitcnt lgkmcnt(0)"
        : "=&v"(r0), "=&v"(r1), "=&v"(r2), "=&v"(r3), "=&v"(r4), "=&v"(r5), "=&v"(r6), "=&v"(r7), "=&v"(r8), "=&v"(r9), "=&v"(r10), "=&v"(r11), "=&v"(r12), "=&v"(r13), "=&v"(r14), "=&v"(r15), "=&v"(g0), "=&v"(g1)
        : "v"(a), "v"(ga) : "memory");
#define CV_OUT(j, ra, rb, rc, rd) do { const int n = nq + 8 * (j); v4u o; o.x = pg8::cvt_pk_bf16(ra.x * g0.x, ra.y * g0.y); o.y = pg8::cvt_pk_bf16(rb.x * g0.z, rb.y * g0.w); \
        o.z = pg8::cvt_pk_bf16(rc.x * g1.x, rc.y * g1.y); o.w = pg8::cvt_pk_bf16(rd.x * g1.z, rd.y * g1.w); \
        const int nrow = c.perm ? 8 * (n >> 2) + (n & 3) : n; *(GAS v4u*)(c.dst + (size_t)nrow * c.K + 8 * cc) = o; } while (0)
    CV_OUT(0, r0, r1, r2, r3); CV_OUT(1, r4, r5, r6, r7); CV_OUT(2, r8, r9, r10, r11); CV_OUT(3, r12, r13, r14, r15);
#undef CV_OUT
}
__device__ __forceinline__ void sincos_acc(float ang, float& sn, float& cs) {
    const double a = (double)ang; const double kq = __builtin_rint(a * 0.63661977236758134308);
    double r = __builtin_fma(-kq, 1.5707963267948966192, a); r = __builtin_fma(-kq, 6.123233995736766036e-17, r);
    const double r2 = r * r;
    double ps = -1.0 / 1307674368000.0; ps = ps * r2 + 1.0 / 6227020800.0; ps = ps * r2 - 1.0 / 39916800.0; ps = ps * r2 + 1.0 / 362880.0; ps = ps * r2 - 1.0 / 5040.0; ps = ps * r2 + 1.0 / 120.0; ps = ps * r2 - 1.0 / 6.0; ps = ps * r2 + 1.0;
    const double s = ps * r;
    double pc = 1.0 / 20922789888000.0; pc = pc * r2 - 1.0 / 87178291200.0; pc = pc * r2 + 1.0 / 479001600.0; pc = pc * r2 - 1.0 / 3628800.0; pc = pc * r2 + 1.0 / 40320.0; pc = pc * r2 - 1.0 / 720.0; pc = pc * r2 + 1.0 / 24.0; pc = pc * r2 - 0.5; pc = pc * r2 + 1.0;
    const int q = ((int)kq) & 3;
    const double ss = (q == 0) ? s : (q == 1) ? pc : (q == 2) ? -s : -pc;
    const double cc = (q == 0) ? pc : (q == 1) ? -s : (q == 2) ? -pc : s;
    sn = (float)ss; cs = (float)cc;
}
enum { CK_GU = 0, CK_D, CK_QKV, CK_O, CK_IN, CK_OUT, CK_G };
constexpr int CV_NMAT = 26, CV_TOTAL = 158720, CV_X0 = 13824;
__device__ const int CV_SLOT_START[11] = {13824, 30208, 42496, 58880, 75264, 91648, 108032, 120320, 136704, 153088, 169472};
__device__ const int CV_CUM[CV_NMAT + 1] = {0, 11264, 16896, 19968, 22016, 33280, 38912, 50176, 55808, 59904, 61952, 62464, 73728, 79360, 90624, 96256, 99328, 101376, 112640, 118272, 129536, 135168, 139264, 141312, 141824, 153088, 158720};
__device__ const int CV_KIND[CV_NMAT] = {CK_GU, CK_D, CK_QKV, CK_O, CK_GU, CK_D, CK_GU, CK_D, CK_IN, CK_OUT, CK_G, CK_GU, CK_D, CK_GU, CK_D, CK_QKV, CK_O, CK_GU, CK_D, CK_GU, CK_D, CK_IN, CK_OUT, CK_G, CK_GU, CK_D};
__device__ const int CV_IDX[CV_NMAT]  = {0, 0, 0, 0, 1, 1, 2, 2, 0, 0, 0, 3, 3, 4, 4, 1, 1, 5, 5, 6, 6, 1, 1, 1, 7, 7};
struct CvMat { int lo, hi; const float* W; bf16* WT; const float* gain; int K, N, gm; };
__device__ __forceinline__ CvMat cv_mat(Frame& F, int it) {
    int m = 0; while (it >= CV_CUM[m + 1]) ++m;
    const int kind = CV_KIND[m], ix = CV_IDX[m];
    CvMat M; M.lo = CV_CUM[m]; M.hi = CV_CUM[m + 1]; M.gain = nullptr; M.gm = 0;
    if (kind == CK_GU)       { M.W = F.in[2] + (size_t)ix * DM * NGU; M.K = DM; M.N = NGU; M.WT = (bf16*)(F.ws + WS_WGU + ix * SZ_WGU); M.gain = F.in[1] + ix * DM; M.gm = 1; }
    else if (kind == CK_D)   { M.W = F.in[3] + (size_t)ix * DFF * DM; M.K = DFF; M.N = DM; M.WT = (bf16*)(F.ws + WS_WD + ix * SZ_WD); }
    else if (kind == CK_QKV) { M.W = F.in[5] + (size_t)ix * DM * QKVD; M.K = DM; M.N = QKVD; M.WT = (bf16*)(F.ws + WS_WQKV + ix * SZ_WQKV); M.gain = F.in[4] + ix * DM; M.gm = 2; }
    else if (kind == CK_O)   { M.W = F.in[8] + (size_t)ix * DM * DM; M.K = DM; M.N = DM; M.WT = (bf16*)(F.ws + WS_WO + ix * SZ_WO); }
    else if (kind == CK_IN)  { M.W = F.in[10] + (size_t)ix * DM * 2 * DRNN; M.K = DM; M.N = 2 * DRNN; M.WT = (bf16*)(F.ws + WS_WIN + ix * SZ_WIN); M.gain = F.in[9] + ix * DM; }
    else if (kind == CK_OUT) { M.W = F.in[16] + (size_t)ix * DRNN * DM; M.K = DRNN; M.N = DM; M.WT = (bf16*)(F.ws + WS_WOUT + ix * SZ_WOUT); }
    else { const int r = it - M.lo, b = ix * 64 + (r >> 3); M.lo += r & ~7; M.hi = M.lo + 8; M.W = F.in[13] + (size_t)b * 16384; M.K = 128; M.N = 128; M.WT = (bf16*)(F.ws + WS_WG) + (size_t)b * 16384; }
    return M;
}
#define CV_WAIT(n) asm volatile("s_waitcnt vmcnt(%0)" :: "n"(n) : "memory")
__device__ __forceinline__ void convert_range(Frame& F, int lo, int hi, int rank, int nranks) {
    OPAQUE_LANE();
    __syncthreads();
    const int b0 = 2 * wave_;
    LAS unsigned char* bufA = F.lds + RING_OFF + b0 * CVB_BYTES; LAS unsigned char* bufB = (b0 + 1 < 15) ? F.lds + RING_OFF + (b0 + 1) * CVB_BYTES : F.lds + RSTAB_OFF;
    if (hi > CV_TOTAL) hi = CV_TOTAL;
    const int step = nranks * NWAVES; int it = lo + rank * NWAVES + wave_;
    if (it >= hi) return;
    CvMat M = cv_mat(F, it);
#define CV_ITEM(it_) ({ if ((it_) >= M.hi) M = cv_mat(F, (it_)); cv_make(M.W, M.K, M.N, M.WT, M.gain, M.gm, (it_) - M.lo, lane_); })
    CvItem A = CV_ITEM(it); cv_issue(A, bufA);
    for (;;) {
        const int itb = it + step; const bool mb = itb < hi; CvItem B = A;
        if (mb) { B = CV_ITEM(itb); cv_issue(B, bufB); CV_WAIT(CV_GROUP); } else CV_WAIT(0);
        cv_finish(A, bufA, lane_);
        if (!mb) break;
        it = itb + step; const bool ma = it < hi;
        if (ma) { A = CV_ITEM(it); cv_issue(A, bufA); CV_WAIT(CV_GROUP); } else CV_WAIT(0);
        cv_finish(B, bufB, lane_);
        if (!ma) break;
    }
#undef CV_ITEM
}
__device__ __forceinline__ void p0_prologue(Frame& F) {
    OPAQUE_LANE();
    const int gw = F.vcu * NWAVES + wave_, NGW = F.G * NWAVES;
    convert_range(F, 0, CV_X0, F.vcu, F.G);
    { bf16* XB = (bf16*)(F.ws + WS_XB); pg8::ss_t* ss0 = (pg8::ss_t*)(F.ws + WS_SS);
      for (int m = gw; m < S; m += NGW) {
        const GAS f32x4* xr = (const GAS f32x4*)(F.in[0] + (size_t)m * DM) + lane_; f32x4 v[8]; float s = 0.f;
#pragma unroll
        for (int j = 0; j < 8; ++j) { v[j] = xr[64 * j]; s += (v[j].x * v[j].x + v[j].y * v[j].y) + (v[j].z * v[j].z + v[j].w * v[j].w); }
        s = wave_sum(s); if (lane_ == 0) ss0[m] = (pg8::ss_t)(s * pg8::SS_SCALE);
        GAS unsigned long long* o8 = (GAS unsigned long long*)(XB + (size_t)m * DM) + lane_;
#pragma unroll
        for (int j = 0; j < 8; ++j) o8[64 * j] = (unsigned long long)pk2(v[j].x, v[j].y) | ((unsigned long long)pk2(v[j].z, v[j].w) << 32);
      } }
    { float* rt = (float*)(F.ws + WS_ROPE); const int gt = (F.vcu * NWAVES + wave_) * 64 + lane_;
      for (int e = gt; e < (128 + 64) * 32; e += NGW * 64) { const int f = e & 31, pe = e >> 5; const int isc = pe >= 128 ? 1 : 0, pos = pe - isc * 128;
        double inv = 1.0; for (int k = 0; k < f; ++k) inv *= 0.74989420933245582730;
        const float ang = (float)pos * (float)inv; float sn, cs; sincos_acc(ang, sn, cs);
        float* cst = rt + (isc ? 8192 : 0); const int nel = isc ? 2048 : 4096;
        cst[pos * 32 + f] = cs; cst[nel + pos * 32 + f] = sn; } }
}
__device__ __forceinline__ void rope_phase(Frame& F, const float* qg, const float* kg) {
    OPAQUE_LANE();
    bf16* QKV = (bf16*)(F.ws + WS_QKV); const float* rt = (const float*)(F.ws + WS_ROPE);
    const int gw = F.vcu * NWAVES + wave_, NGW = F.G * NWAVES, g = lane_ >> 4, j = lane_ & 15;
    const int d = 8 * j, axis = d >> 6, first = ((d & 63) < 32) ? 1 : 0, f0 = d & 31;
    const float* gq = qg + d; const float* gk = kg + d;
    const f32x4 gq0 = *(const f32x4*)gq, gq1 = *(const f32x4*)(gq + 4), gk0 = *(const f32x4*)gk, gk1 = *(const f32x4*)(gk + 4);
    for (int row = gw; row < S; row += NGW) {
        bf16* p = QKV + (size_t)row * QKVD + g * 128 + d;
        v4u w[5];
#pragma unroll
        for (int part = 0; part < 5; ++part) w[part] = *(const GAS v4u*)(p + part * 512);
        const int pos = axis ? (row & 63) : (row >> 6);
        const float* ct = rt + (axis ? 8192 : 0) + pos * 32 + f0; const float* st = ct + (axis ? 2048 : 4096);
        const f32x4 c0 = *(const f32x4*)ct, c1 = *(const f32x4*)(ct + 4), s0 = *(const f32x4*)st, s1 = *(const f32x4*)(st + 4);
        const float cs[8] = {c0.x, c0.y, c0.z, c0.w, c1.x, c1.y, c1.z, c1.w}, sn[8] = {s0.x, s0.y, s0.z, s0.w, s1.x, s1.y, s1.z, s1.w};
#pragma unroll
        for (int part = 0; part < 5; ++part) {
            float x[8] = {bf_lo(w[part].x), bf_hi(w[part].x), bf_lo(w[part].y), bf_hi(w[part].y), bf_lo(w[part].z), bf_hi(w[part].z), bf_lo(w[part].w), bf_hi(w[part].w)};
            float ssq = 0.f;
#pragma unroll
            for (int e = 0; e < 8; ++e) ssq += x[e] * x[e];
            ssq += __shfl_xor(ssq, 1); ssq += __shfl_xor(ssq, 2); ssq += __shfl_xor(ssq, 4); ssq += __shfl_xor(ssq, 8);
            const float rstd = __builtin_amdgcn_rsqf(ssq * (1.0f / 128.0f) + NORM_EPS);
            const f32x4 g0 = part < 4 ? gq0 : gk0, g1 = part < 4 ? gq1 : gk1;
            const float gn[8] = {g0.x, g0.y, g0.z, g0.w, g1.x, g1.y, g1.z, g1.w};
            float o[8];
#pragma unroll
            for (int e = 0; e < 8; ++e) { const float xn = x[e] * rstd * gn[e]; const float pn = __shfl_xor(xn, 4);
                o[e] = first ? (xn * cs[e] - pn * sn[e]) : (xn * cs[e] + pn * sn[e]); }
            v4u ow; ow.x = pk2(o[0], o[1]); ow.y = pk2(o[2], o[3]); ow.z = pk2(o[4], o[5]); ow.w = pk2(o[6], o[7]);
            *(GAS v4u*)(p + part * 512) = ow;
        }
    }
}
__device__ __forceinline__ void attn_phase(Frame& F, char* lds) {
    const att::bf16* QKV = (const att::bf16*)(F.ws + WS_QKV); att::bf16* O = (att::bf16*)(F.ws + WS_O);
    for (int u = F.vcu; u < 512; u += F.G) {
        const int i = u >> 8, x = (u & 255) >> 5, l = u & 31, kvh = x >> 1, h = kvh * 4 + (x & 1) * 2 + i, qb = l;
        att::attn_dense_body(QKV + (size_t)(qb * 256) * QKVD + h * 128, QKV + 2048 + kvh * 128, QKV + 2560 + kvh * 128, O + (size_t)(qb * 256) * DM + h * 128, S, lds);
    }
}
constexpr int SC_AT = 0, SC_ATP = 272;
constexpr int SC_AB = 9216;
constexpr int SC_H = SC_AB + 65536;
constexpr int SC_CR = SC_H + 32768;
static_assert(SC_CR + 16384 <= RING_BYTES, "scan LDS map");
#define LDS_BARRIER() do { asm volatile("s_waitcnt lgkmcnt(0)" ::: "memory"); __builtin_amdgcn_s_barrier(); asm volatile("" ::: "memory"); } while (0)
struct RecArgs { const bf16* U; const bf16* Wg; const float* gate_b; const float* lam; const float* conv_w; const float* conv_b; float2* aggs; float2* aggc; bf16* Y; unsigned* AB; };
__device__ __forceinline__ float sigmoid_f(float x) { return __builtin_amdgcn_rcpf(1.0f + __builtin_amdgcn_exp2f(x * -1.4426950408889634f)); }
__device__ __forceinline__ unsigned pk2r(float lo, float hi) { unsigned r; asm volatile("v_cvt_pk_bf16_f32 %0, %1, %2" : "=v"(r) : "v"(lo), "v"(hi)); return r; }
__device__ __forceinline__ float bfl_(unsigned w) { return __builtin_bit_cast(float, w << 16); }
__device__ __forceinline__ float bfh_(unsigned w) { return __builtin_bit_cast(float, w & 0xffff0000u); }
template <int PASS>
__device__ __forceinline__ void rec_pass(Frame& F, char* lds, const RecArgs& R) {
    typedef float f32x4v __attribute__((ext_vector_type(4)));
    OPAQUE_LANE();
    const int tid = tid_, lane = lane_, w = wave_, wd = w >> 2, wq = w & 3, l15 = lane & 15, l4 = lane >> 4;
    const int tl = tid >> 4, c8 = (tid & 15) * 8;
    const int sd = tid >> 7, sch = tid & 127;
    constexpr float L2E = 1.4426950408889634f, LN2x2 = 1.3862943611198906f;
    for (int item = F.vcu; item < 256; item += F.G) {
        const int n = item & 15, c = item >> 4;
        if (PASS == 2 && tid < 256) {
            const int ch = n * 128 + sch; float* cr = (float*)(lds + SC_CR);
            float h = 0.f;
            const int nf = sd ? 15 - c : c, first = sd ? 15 : 0, step = sd ? -1 : 1;
            for (int k0 = 0; k0 < nf; k0 += 4) { float2 v[4];
#pragma unroll
                for (int j = 0; j < 4; ++j) { int cc = first + step * (k0 + j); cc = cc < 0 ? 0 : (cc > 15 ? 15 : cc); v[j] = R.aggc[(size_t)(cc * 2 + sd) * DRNN + ch]; }
#pragma unroll
                for (int j = 0; j < 4; ++j) if (k0 + j < nf) h = v[j].x * h + v[j].y; }
            for (int k0 = 0; k0 < 16; k0 += 4) { float2 v[4];
#pragma unroll
                for (int j = 0; j < 4; ++j) { const int ss_ = first + step * (k0 + j); v[j] = R.aggs[(size_t)((c * 16 + ss_) * 2 + sd) * DRNN + ch]; }
#pragma unroll
                for (int j = 0; j < 4; ++j) { const int ss_ = first + step * (k0 + j); cr[(ss_ * 2 + sd) * 128 + sch] = h; h = v[j].x * h + v[j].y; } }
        }
        asm volatile("" ::: "memory");
        bf16x8 bfr[2][2][4];
#pragma unroll
        for (int z = 0; z < 2; ++z)
#pragma unroll
            for (int nt = 0; nt < 2; ++nt)
#pragma unroll
                for (int ks = 0; ks < 4; ++ks)
                    bfr[z][nt][ks] = *(const GAS bf16x8*)(R.Wg + ((size_t)(((wd * 2 + z) * 16 + n) * 128 + wq * 32 + nt * 16 + l15)) * 128 + ks * 32 + l4 * 8);
        float brn[2], bin[2], spn[2];
#pragma unroll
        for (int nt = 0; nt < 2; ++nt) { const int ch = n * 128 + wq * 32 + nt * 16 + l15; brn[nt] = -L2E * R.gate_b[(wd * 2 + 0) * DRNN + ch]; bin[nt] = -L2E * R.gate_b[(wd * 2 + 1) * DRNN + ch];
            const float lm = R.lam[wd * DRNN + ch]; spn[nt] = -L2E * 8.0f * log1pf(__expf(-lm)); }
        float cw[4][8], cb[8];
        { const int ch0 = n * 128 + c8;
#pragma unroll
          for (int tp = 0; tp < 4; ++tp) { const f32x4v a = *(const f32x4v*)(R.conv_w + tp * DRNN + ch0), b = *(const f32x4v*)(R.conv_w + tp * DRNN + ch0 + 4);
              cw[tp][0] = a.x; cw[tp][1] = a.y; cw[tp][2] = a.z; cw[tp][3] = a.w; cw[tp][4] = b.x; cw[tp][5] = b.y; cw[tp][6] = b.z; cw[tp][7] = b.w; }
          const f32x4v a = *(const f32x4v*)(R.conv_b + ch0), b = *(const f32x4v*)(R.conv_b + ch0 + 4);
          cb[0] = a.x; cb[1] = a.y; cb[2] = a.z; cb[3] = a.w; cb[4] = b.x; cb[5] = b.y; cb[6] = b.z; cb[7] = b.w; }
        float aggA = 1.f, aggB = 0.f;
        const bf16* Urec = R.U + DRNN + n * 128 + c8; const bf16* Ugate = R.U + n * 128 + c8;
        v4u un[4], gn = (v4u){0u, 0u, 0u, 0u};
#define REC_LOAD(t0_) do { const int t_ = (t0_) + tl; _Pragma("unroll") for (int tp = 0; tp < 4; ++tp) { const int tt = t_ + tp - 2; un[tp] = (v4u){0u, 0u, 0u, 0u}; \
            if (tt >= 0 && tt < S) un[tp] = *(const GAS v4u*)(Urec + (size_t)tt * (2 * DRNN)); } if (PASS == 2) gn = *(const GAS v4u*)(Ugate + (size_t)t_ * (2 * DRNN)); } while (0)
        REC_LOAD(c * 512);
        for (int s = 0; s < 16; ++s) {
            const int t0 = c * 512 + s * 32;
            v4u gcur = gn;
            { float xc[8];
#pragma unroll
              for (int e = 0; e < 8; ++e) xc[e] = cb[e];
#pragma unroll
              for (int tp = 0; tp < 4; ++tp) { const v4u wv = un[tp];
                  xc[0] += cw[tp][0] * bf_lo(wv.x); xc[1] += cw[tp][1] * bf_hi(wv.x); xc[2] += cw[tp][2] * bf_lo(wv.y); xc[3] += cw[tp][3] * bf_hi(wv.y);
                  xc[4] += cw[tp][4] * bf_lo(wv.z); xc[5] += cw[tp][5] * bf_hi(wv.z); xc[6] += cw[tp][6] * bf_lo(wv.w); xc[7] += cw[tp][7] * bf_hi(wv.w); }
              v4u o; o.x = pk2(xc[0], xc[1]); o.y = pk2(xc[2], xc[3]); o.z = pk2(xc[4], xc[5]); o.w = pk2(xc[6], xc[7]);
              *(v4u*)(lds + SC_AT + tl * SC_ATP + c8 * 2) = o; }
            if (s < 15) REC_LOAD(t0 + 32);
            LDS_BARRIER();
#pragma unroll
            for (int mt = 0; mt < 2; ++mt) {
                bf16x8 af[4];
#pragma unroll
                for (int ks = 0; ks < 4; ++ks) af[ks] = *(const bf16x8*)(lds + SC_AT + (mt * 16 + l15) * SC_ATP + (ks * 32 + l4 * 8) * 2);
                f32x4v acc[2][2];
#pragma unroll
                for (int z = 0; z < 2; ++z)
#pragma unroll
                    for (int nt = 0; nt < 2; ++nt) { acc[z][nt] = (f32x4v){0.f, 0.f, 0.f, 0.f};
#pragma unroll
                        for (int ks = 0; ks < 4; ++ks) acc[z][nt] = __builtin_amdgcn_mfma_f32_16x16x32_bf16(af[ks], bfr[z][nt][ks], acc[z][nt], 0, 0, 0); }
#pragma unroll
                for (int nt = 0; nt < 2; ++nt)
#pragma unroll
                    for (int rg = 0; rg < 4; ++rg) { const int tt = mt * 16 + l4 * 4 + rg, chl = wq * 32 + nt * 16 + l15;
                        const float er = __builtin_amdgcn_exp2f(__builtin_fmaf(acc[0][nt][rg], -L2E, brn[nt])), ei = __builtin_amdgcn_exp2f(__builtin_fmaf(acc[1][nt][rg], -L2E, bin[nt]));
                        const float rgate = __builtin_amdgcn_rcpf(1.0f + er), igate = __builtin_amdgcn_rcpf(1.0f + ei);
                        const float l2 = bfl_(pk2r(spn[nt] * rgate, 0.f)), a = __builtin_amdgcn_exp2f(l2), x2 = l2 * LN2x2;
                        float emp = -x2 * (1.0f + x2 * (0.5f + x2 * (0.16666667f + x2 * 0.041666668f))); asm volatile("" : "+v"(emp));
                        const float em = (x2 > -0.1f) ? emp : __builtin_fmaf(-a, a, 1.0f);
                        const float xv = __builtin_bit_cast(float, ((unsigned)*(const unsigned short*)(lds + SC_AT + tt * SC_ATP + chl * 2)) << 16);
                        const unsigned pw = pk2r(l2, __builtin_amdgcn_sqrtf(em) * igate * xv); const float bb = bfh_(pw);
                        if (PASS == 1) R.AB[(size_t)(item * 16 + s) * 8192 + (wd * 32 + tt) * 128 + chl] = pw;
                        *(float*)(lds + SC_AB + ((wd * 2 + 0) * 32 + tt) * 512 + chl * 4) = a;
                        *(float*)(lds + SC_AB + ((wd * 2 + 1) * 32 + tt) * 512 + chl * 4) = bb; }
            }
            LDS_BARRIER();
            if (tid < 256) {
                const float* pa = (const float*)(lds + SC_AB + (sd * 2 + 0) * 16384) + sch; const float* pb = (const float*)(lds + SC_AB + (sd * 2 + 1) * 16384) + sch;
                if (PASS == 1) {
                    float P = 1.f, h = 0.f;
#pragma nounroll
                    for (int k0 = 0; k0 < 32; k0 += 8) { float a8[8], b8[8];
#pragma unroll
                        for (int j = 0; j < 8; ++j) { const int t = sd ? 31 - (k0 + j) : k0 + j; a8[j] = pa[t * 128]; b8[j] = pb[t * 128]; }
#pragma unroll
                        for (int j = 0; j < 8; ++j) { h = a8[j] * h + b8[j]; P *= a8[j]; } }
                    R.aggs[(size_t)((c * 16 + s) * 2 + sd) * DRNN + n * 128 + sch] = make_float2(P, h);
                    if (sd == 0) { aggB = P * aggB + h; aggA = P * aggA; } else { aggB = aggA * h + aggB; aggA = aggA * P; }
                } else {
                    float h = *((const float*)(lds + SC_CR) + (s * 2 + sd) * 128 + sch); float* ph = (float*)(lds + SC_H + sd * 16384) + sch;
#pragma nounroll
                    for (int k0 = 0; k0 < 32; k0 += 8) { float a8[8], b8[8];
#pragma unroll
                        for (int j = 0; j < 8; ++j) { const int t = sd ? 31 - (k0 + j) : k0 + j; a8[j] = pa[t * 128]; b8[j] = pb[t * 128]; }
#pragma unroll
                        for (int j = 0; j < 8; ++j) { const int t = sd ? 31 - (k0 + j) : k0 + j; h = a8[j] * h + b8[j]; ph[t * 128] = h; } }
                }
            }
            if (PASS == 2) {
                LDS_BARRIER();
                const float* hf = (const float*)(lds + SC_H + tl * 512 + c8 * 4); const float* hb = (const float*)(lds + SC_H + 16384 + tl * 512 + c8 * 4);
                const f32x4v f0 = *(const f32x4v*)hf, f1 = *(const f32x4v*)(hf + 4), b0 = *(const f32x4v*)hb, b1 = *(const f32x4v*)(hb + 4);
                const int t = t0 + tl;
                const float gx[8] = {bf_lo(gcur.x), bf_hi(gcur.x), bf_lo(gcur.y), bf_hi(gcur.y), bf_lo(gcur.z), bf_hi(gcur.z), bf_lo(gcur.w), bf_hi(gcur.w)};
                const float hs[8] = {f0.x + b0.x, f0.y + b0.y, f0.z + b0.z, f0.w + b0.w, f1.x + b1.x, f1.y + b1.y, f1.z + b1.z, f1.w + b1.w};
                float y[8];
#pragma unroll
                for (int e = 0; e < 8; ++e) { const float v = gx[e]; const float u = 1.5957691216057308f * (v + 0.044715f * v * v * v); y[e] = v * sigmoid_f(u) * hs[e]; }
                v4u o; o.x = pk2(y[0], y[1]); o.y = pk2(y[2], y[3]); o.z = pk2(y[4], y[5]); o.w = pk2(y[6], y[7]);
                *(GAS v4u*)(R.Y + (size_t)t * DRNN + n * 128 + c8) = o;
            }
        }
#undef REC_LOAD
        if (PASS == 1 && tid < 256) R.aggc[(size_t)(c * 2 + sd) * DRNN + n * 128 + sch] = make_float2(aggA, aggB);
        __syncthreads();
    }
}
__device__ __forceinline__ void rec_pass2s(Frame& F, char* lds, const RecArgs& R) {
    typedef float f32x4v __attribute__((ext_vector_type(4)));
    OPAQUE_LANE();
    const int tid = tid_;
    const int tl = tid >> 4, c8 = (tid & 15) * 8;
    const int sd = tid >> 7, sch = tid & 127;
    for (int item = F.vcu; item < 256; item += F.G) {
        const int n = item & 15, c = item >> 4;
        if (tid < 256) {
            const int ch = n * 128 + sch; float* cr = (float*)(lds + SC_CR);
            const int first = sd ? 15 : 0, step = sd ? -1 : 1, nf = sd ? 15 - c : c;
            float2 vc[16], vs[16];
#pragma unroll
            for (int j = 0; j < 16; ++j) { const int cc = first + step * j; vc[j] = R.aggc[(size_t)(cc * 2 + sd) * DRNN + ch]; vs[j] = R.aggs[(size_t)((c * 16 + cc) * 2 + sd) * DRNN + ch]; }
            float h = 0.f;
#pragma unroll
            for (int j = 0; j < 16; ++j) if (j < nf) h = vc[j].x * h + vc[j].y;
#pragma unroll
            for (int j = 0; j < 16; ++j) { const int ss_ = first + step * j; cr[(ss_ * 2 + sd) * 128 + sch] = h; h = vs[j].x * h + vs[j].y; }
        }
        asm volatile("" ::: "memory");
        const unsigned* abp = R.AB + (size_t)item * 16 * 8192; const bf16* Ugate = R.U + n * 128 + c8;
        v4u pn[4], gn;
#define REC2_LOAD(s_) do { _Pragma("unroll") for (int i = 0; i < 4; ++i) pn[i] = *(const GAS v4u*)(abp + (size_t)(s_) * 8192 + (tid + 512 * i) * 4); \
            gn = *(const GAS v4u*)(Ugate + (size_t)(c * 512 + (s_) * 32 + tl) * (2 * DRNN)); } while (0)
        REC2_LOAD(0);
        for (int s = 0; s < 16; ++s) {
            const int t0 = c * 512 + s * 32;
            const v4u gcur = gn;
#pragma unroll
            for (int i = 0; i < 4; ++i) { const int idx = tid + 512 * i, dir = idx >> 10, t = (idx >> 5) & 31, c4 = (idx & 31) * 4; const v4u p = pn[i];
                const f32x4v a4 = {__builtin_amdgcn_exp2f(bfl_(p.x)), __builtin_amdgcn_exp2f(bfl_(p.y)), __builtin_amdgcn_exp2f(bfl_(p.z)), __builtin_amdgcn_exp2f(bfl_(p.w))};
                const f32x4v b4 = {bfh_(p.x), bfh_(p.y), bfh_(p.z), bfh_(p.w)};
                *(f32x4v*)(lds + SC_AB + ((dir * 2 + 0) * 32 + t) * 512 + c4 * 4) = a4;
                *(f32x4v*)(lds + SC_AB + ((dir * 2 + 1) * 32 + t) * 512 + c4 * 4) = b4; }
            if (s < 15) REC2_LOAD(s + 1);
            LDS_BARRIER();
            if (tid < 256) {
                const float* pa = (const float*)(lds + SC_AB + (sd * 2 + 0) * 16384) + sch; const float* pb = (const float*)(lds + SC_AB + (sd * 2 + 1) * 16384) + sch;
                float h = *((const float*)(lds + SC_CR) + (s * 2 + sd) * 128 + sch); float* ph = (float*)(lds + SC_H + sd * 16384) + sch;
#pragma nounroll
                for (int k0 = 0; k0 < 32; k0 += 8) { float a8[8], b8[8];
#pragma unroll
                    for (int j = 0; j < 8; ++j) { const int t = sd ? 31 - (k0 + j) : k0 + j; a8[j] = pa[t * 128]; b8[j] = pb[t * 128]; }
#pragma unroll
                    for (int j = 0; j < 8; ++j) { const int t = sd ? 31 - (k0 + j) : k0 + j; h = a8[j] * h + b8[j]; ph[t * 128] = h; } }
            }
            LDS_BARRIER();
            { const float* hf = (const float*)(lds + SC_H + tl * 512 + c8 * 4); const float* hb = (const float*)(lds + SC_H + 16384 + tl * 512 + c8 * 4);
              const f32x4v f0 = *(const f32x4v*)hf, f1 = *(const f32x4v*)(hf + 4), b0 = *(const f32x4v*)hb, b1 = *(const f32x4v*)(hb + 4);
              const int t = t0 + tl;
              const float gx[8] = {bf_lo(gcur.x), bf_hi(gcur.x), bf_lo(gcur.y), bf_hi(gcur.y), bf_lo(gcur.z), bf_hi(gcur.z), bf_lo(gcur.w), bf_hi(gcur.w)};
              const float hs[8] = {f0.x + b0.x, f0.y + b0.y, f0.z + b0.z, f0.w + b0.w, f1.x + b1.x, f1.y + b1.y, f1.z + b1.z, f1.w + b1.w};
              float y[8];
#pragma unroll
              for (int e = 0; e < 8; ++e) { const float v = gx[e]; const float u = 1.5957691216057308f * (v + 0.044715f * v * v * v); y[e] = v * sigmoid_f(u) * hs[e]; }
              v4u o; o.x = pk2(y[0], y[1]); o.y = pk2(y[2], y[3]); o.z = pk2(y[4], y[5]); o.w = pk2(y[6], y[7]);
              *(GAS v4u*)(R.Y + (size_t)t * DRNN + n * 128 + c8) = o; }
        }
#undef REC2_LOAD
        LDS_BARRIER();
    }
}
__device__ __forceinline__ void final_norm_phase(Frame& F, const bf16* X, float* out, const pg8::ss_t* ss, const float* g) {
    OPAQUE_LANE();
    const int gw = F.vcu * NWAVES + wave_, NGW = F.G * NWAVES;
    f32x4 gv[4][2];
#pragma unroll
    for (int j = 0; j < 4; ++j) { gv[j][0] = *((const GAS f32x4*)g + 2 * (lane_ + 64 * j)); gv[j][1] = *((const GAS f32x4*)g + 2 * (lane_ + 64 * j) + 1); }
    for (int m = gw; m < S; m += NGW) { const GAS v4u* xr = (const GAS v4u*)(X + (size_t)m * DM) + lane_; GAS f32x4* orow = (GAS f32x4*)(out + (size_t)m * DM);
        const float rs = pg8::rs_from_ss(ss[m]);
        v4u w[4];
#pragma unroll
        for (int j = 0; j < 4; ++j) w[j] = xr[64 * j];
#pragma unroll
        for (int j = 0; j < 4; ++j) { const f32x4 a = (f32x4){bf_lo(w[j].x), bf_hi(w[j].x), bf_lo(w[j].y), bf_hi(w[j].y)}, b = (f32x4){bf_lo(w[j].z), bf_hi(w[j].z), bf_lo(w[j].w), bf_hi(w[j].w)};
            orow[2 * (lane_ + 64 * j)] = a * rs * gv[j][0]; orow[2 * (lane_ + 64 * j) + 1] = b * rs * gv[j][1]; } }
}
__device__ __forceinline__ int opaque_i(int v) { asm volatile("" : "+s"(v)); return v; }
struct Args { const float* in[18]; float* out; unsigned char* ws; int ph_lo, ph_hi; };
static_assert(sizeof(Args) == 18 * 8 + 8 + 8 + 8, "Args has no padding");
__global__ void __launch_bounds__(NWAVES * 64, 2) mega_fwd(Args args) {
    extern __shared__ __attribute__((aligned(16))) unsigned char lds[];
    Frame F;
    F.lds = (LAS unsigned char*)lds;
    F.MISC = (volatile LAS unsigned*)(F.lds + MISC_OFF);
    F.tid = threadIdx.x; F.lane = F.tid & 63; F.wave = __builtin_amdgcn_readfirstlane(F.tid >> 6);
    F.G = gridDim.x; { const int bx = blockIdx.x; F.vcu = (F.G % 8 == 0) ? (bx % 8) * (F.G / 8) + bx / 8 : bx; }
    F.ws = args.ws; F.ctl = (gu32*)(args.ws + WS_CTL); F.in = args.in;
    for (int u = F.tid; u < (LDS_BYTES - LDSCTL_OFF) / 4; u += NWAVES * 64) ((LAS unsigned*)(F.lds + LDSCTL_OFF))[u] = 0u;
    __syncthreads();
    const int lo = args.ph_lo, hi = args.ph_hi;
    const bool use_bar = (hi - lo) > 1;
    XcdBarrier bar; bar.bar = (unsigned*)(F.ctl + CW_BAR); bar.x = 0; bar.st = nullptr;
    if (use_bar) bar = xcd_barrier_post((unsigned*)(F.ctl + CW_BAR), F.MISC + 8);
#define IN(k) (lo <= (k) && (k) < hi)
#define REP(n) for (int rep_ = 0, nrep_ = opaque_i(n); rep_ < nrep_; ++rep_)
#ifdef DBG_BARWAIT
#define SEAM(k) do { if (IN((k) + 1)) { const unsigned long long t0_ = __builtin_amdgcn_s_memrealtime(); xcd_barrier(bar); if (DBG_BW_SEL(k)) barwait += __builtin_amdgcn_s_memrealtime() - t0_; } } while (0)
#else
#define SEAM(k) do { if (IN((k) + 1)) { REP(DUP_BAR) { XcdBarrier b2_ = bar; asm volatile("" : "+s"(b2_.bar)); xcd_barrier(b2_); } } } while (0)
#endif
    unsigned long long barwait = 0; (void)barwait;
    pg8::ss_t* const ssb = (pg8::ss_t*)(args.ws + WS_SS);
    bf16* const XB = (bf16*)(args.ws + WS_XB);

    #if PH_P0
    if (IN(0)) { REP(DUP_P0) p0_prologue(F); SEAM(0); }
#endif

    for (int sb = 0; sb < NSB; ++sb) {
        typedef const __attribute__((address_space(4))) Args* KArgP;
        KArgP ap_ = (KArgP)__builtin_amdgcn_kernarg_segment_ptr(); asm volatile("" : "+s"(ap_));
        struct { const float* in[18]; float* out; unsigned char* ws; } args;
#pragma unroll
        for (int i_ = 0; i_ < 18; ++i_) args.in[i_] = ap_->in[i_];
        args.out = ap_->out; args.ws = ap_->ws;
        pg8::ss_t* const ssb = (pg8::ss_t*)(args.ws + WS_SS);
        bf16* const XB = (bf16*)(args.ws + WS_XB);
        const int p6 = sb / 6, k6 = sb - 6 * p6;
        const int type = (k6 == 1) ? 1 : (k6 == 4) ? 2 : 0;
        const int f = 4 * p6 + (k6 == 0 ? 0 : k6 == 2 ? 1 : k6 == 3 ? 2 : 3);
        const int pb = 1 + 4 * sb;
        const pg8::ss_t* ss_in = ssb + (size_t)sb * S; pg8::ss_t* ss_out = ssb + (size_t)(sb + 1) * S;
        if (IN(pb)) {
#if PH_GU
            if (type == 0) {
                pg8::Gemm g{XB, (const bf16*)(args.ws + WS_WGU + f * SZ_WGU), S, NGU, DM}; pg8::SsOrder So; So.init(S, NGU, F.G, (int)blockIdx.x); So.ss = ss_in; So.raw = F.lds + RSTAB_OFF; So.k = 0;
                pg8::EpiSwiglu E{(bf16*)(args.ws + WS_H), F.lds + RSTAB_OFF};
                REP(DUP_GU) pg8::gemm_phase<pg8::EpiSwiglu, pg8::SsOrder, true, true>(F.lds + RING_OFF, g, So, E);
                { const int rem = ((S / 256) * (NGU / 256)) % F.G, sj = (f < 1) ? 0 : (f < 5) ? f + 1 : f + 2;
                  if (rem != 0 && (int)blockIdx.x >= rem) convert_range(F, CV_SLOT_START[sj], CV_SLOT_START[sj + 1], (int)blockIdx.x - rem, F.G - rem);
                  else if (rem == 0) convert_range(F, CV_SLOT_START[sj], CV_SLOT_START[sj + 1], (int)blockIdx.x, F.G); }
            }
#endif
#if PH_PLAIN
            if (type != 0) {
                const int N = (type == 1) ? QKVD : 2 * DRNN;
                const bf16* Wt = (type == 1) ? (const bf16*)(args.ws + WS_WQKV + p6 * SZ_WQKV) : (const bf16*)(args.ws + WS_WIN + p6 * SZ_WIN);
                bf16* Out = (type == 1) ? (bf16*)(args.ws + WS_QKV) : (bf16*)(args.ws + WS_U);
                pg8::Gemm g{XB, Wt, S, N, DM}; pg8::SsOrder So; So.init(S, N, F.G, (int)blockIdx.x); So.ss = ss_in; So.raw = F.lds + RSTAB_OFF; So.k = 0;
                pg8::EpiPlain E{Out, N, F.lds + RSTAB_OFF, (type == 1) ? 10 : 0, 8, args.in[6] + p6 * 128, args.in[7] + p6 * 128, (const float*)(args.ws + WS_ROPE), (LAS float*)(F.lds + HSTAB_OFF)};
                REP(DUP_PLAIN) pg8::gemm_phase<pg8::EpiPlain, pg8::SsOrder, true, true>(F.lds + RING_OFF, g, So, E);
                if (type == 1) { const int rem = ((S / 256) * (QKVD / 256)) % F.G, sj = p6 ? 6 : 1;
                  if (rem != 0 && (int)blockIdx.x >= rem) convert_range(F, CV_SLOT_START[sj], CV_SLOT_START[sj + 1], (int)blockIdx.x - rem, F.G - rem);
                  else if (rem == 0) convert_range(F, CV_SLOT_START[sj], CV_SLOT_START[sj + 1], (int)blockIdx.x, F.G); }
            }
#endif
            SEAM(pb);
        }
        if (type == 1) {
#if PH_ROPE
#endif
#if PH_ATT
            if (IN(pb + 2)) { REP(DUP_ATT) attn_phase(F, (char*)lds + RING_OFF); SEAM(pb + 2); }
#endif
        } else if (type == 2) {
            const RecArgs R{(const bf16*)(args.ws + WS_U), (const bf16*)(args.ws + WS_WG) + (size_t)p6 * (4 * 16 * 16384), args.in[14] + p6 * 4 * DRNN, args.in[15] + p6 * 2 * DRNN,
                            args.in[11] + p6 * 4 * DRNN, args.in[12] + p6 * DRNN, (float2*)(args.ws + WS_AGGS), (float2*)(args.ws + WS_AGGC), (bf16*)(args.ws + WS_Y), (unsigned*)(args.ws + WS_AB)};
#if PH_REC1
            if (IN(pb + 1)) { REP(DUP_REC) rec_pass<1>(F, (char*)lds + RING_OFF, R); SEAM(pb + 1); }
#endif
#if PH_REC2
            if (IN(pb + 2)) { REP(DUP_REC) rec_pass2s(F, (char*)lds + RING_OFF, R); SEAM(pb + 2); }
#endif
        }
#if PH_RES
        if (IN(pb + 3)) {
            const bf16* A = (type == 0) ? (const bf16*)(args.ws + WS_H) : (type == 1) ? (const bf16*)(args.ws + WS_O) : (const bf16*)(args.ws + WS_Y);
            const bf16* Wt = (type == 0) ? (const bf16*)(args.ws + WS_WD + f * SZ_WD) : (type == 1) ? (const bf16*)(args.ws + WS_WO + p6 * SZ_WO) : (const bf16*)(args.ws + WS_WOUT + p6 * SZ_WOUT);
            const int K = (type == 0) ? DFF : DM;
            pg8::Gemm g{A, Wt, S, DM, K}; pg8::StaticOrder So; So.init(S, DM, F.G, (int)blockIdx.x, RES_WGM);
            REP(DUP_RES) {
                const bool real = (rep_ == nrep_ - 1);
                pg8::EpiResid E{XB, real ? ss_out : ssb + (size_t)13 * S, real ? (type == 0 ? 0.5f : 1.0f) : 0.0f};
                pg8::gemm_phase<pg8::EpiResid, pg8::StaticOrder, false, true>(F.lds + RING_OFF, g, So, E);
            }
            SEAM(pb + 3);
        }
#endif
    }
#ifdef DBG_BARWAIT
    if (threadIdx.x == 0) atomicAdd((unsigned long long*)(args.ws + 2 * MiB - 512), barwait);
    xcd_barrier(bar);
#endif
#if PH_FN
    if (IN(N_PHASES - 1)) final_norm_phase(F, XB, args.out, ssb + (size_t)NSB * S, args.in[17]);
#endif
#ifdef DBG_BARWAIT
    xcd_barrier(bar);
    if (blockIdx.x == 0 && threadIdx.x == 0) { const unsigned long long tot = *(const unsigned long long*)(args.ws + 2 * MiB - 512); const float avg_us = (float)tot * (0.01f / 256.0f); args.out[0] = 1000.0f * __builtin_floorf(avg_us * (1.0f / DBG_BUCKET_US) + DBG_BUCKET_OFF); }
#endif
#undef IN
#undef SEAM
}

extern "C" void kernel_launch(void* const* d_in, const int* in_sizes, int n_in, void* d_out, int out_size, void* d_ws, size_t ws_size, hipStream_t stream) {
    static int grid = 0;
    if (grid == 0) {
        if (n_in != 18 || in_sizes[0] != S * DM || out_size != S * DM || ws_size < WS_END) { fprintf(stderr, "kernel_launch: shape mismatch: n_in %d in0 %d out %d ws %zu (need %zu)\n", n_in, n_in > 0 ? in_sizes[0] : -1, out_size, ws_size, (size_t)WS_END); grid = -1; return; }
        int dev = 0, cus = 0, per_cu = 0;
        if (hipGetDevice(&dev) != hipSuccess || hipDeviceGetAttribute(&cus, hipDeviceAttributeMultiprocessorCount, dev) != hipSuccess) { fprintf(stderr, "kernel_launch: device query failed\n"); grid = -1; return; }
        if (hipFuncSetAttribute((const void*)mega_fwd, hipFuncAttributeMaxDynamicSharedMemorySize, LDS_BYTES) != hipSuccess) { fprintf(stderr, "kernel_launch: hipFuncSetAttribute failed\n"); grid = -1; return; }
        if (hipOccupancyMaxActiveBlocksPerMultiprocessor(&per_cu, (const void*)mega_fwd, NWAVES * 64, LDS_BYTES) != hipSuccess || per_cu < 1) { fprintf(stderr, "kernel_launch: occupancy query says %d blocks per CU\n", per_cu); }
        (void)hipGetLastError();
        grid = cus;
    }
    if (grid < 0) return;
    if (hipMemsetAsync((char*)d_ws + WS_CTL, 0, CTL_ZERO_BYTES, stream) != hipSuccess) { fprintf(stderr, "kernel_launch: memset failed\n"); return; }
    Args a{};
    for (int i = 0; i < 18; ++i) a.in[i] = (const float*)d_in[i];
    a.out = (float*)d_out; a.ws = (unsigned char*)d_ws;
#if MK_MULTI
    for (int ph = 0; ph < N_PHASES; ++ph) {
        if (ph >= 1 && ph < N_PHASES - 1) { const int sb = (ph - 1) / 4, k = (ph - 1) % 4, k6 = sb % 6; if ((k == 1 || k == 2) && !(k6 == 1 || k6 == 4)) continue; if (k == 1 && k6 == 1) continue; }
        a.ph_lo = ph; a.ph_hi = ph + 1;
        hipLaunchKernelGGL(mega_fwd, dim3(grid), dim3(NWAVES * 64), LDS_BYTES, stream, a);
    }
#else
    a.ph_lo = 0; a.ph_hi = N_PHASES;
    hipLaunchKernelGGL(mega_fwd, dim3(grid), dim3(NWAVES * 64), LDS_BYTES, stream, a);
#endif
    const hipError_t le = hipPeekAtLastError();
    if (le != hipSuccess) fprintf(stderr, "kernel_launch: launch failed: %s\n", hipGetErrorName(le));
}
```
